# Optimizing an MI355X kernel written in HIP

```python
import math
import jax
import jax.numpy as jnp
from jax import lax
import numpy as np

D_MODEL = 1024
BATCH = 16
SEQ = 2048
DEPTH = 4

GRID_W = 64
CTX_LEN = 256
N_MIXERS = 4
N_MOD = 9
BLOCK_Q = 128
ROPE_BASE = 10000.0
EPS = 1e-6
NEG_INF = -1e30
D_FF = 2816

GQA_HEADS = 16
GQA_KV_HEADS = 4
GQA_HEAD_DIM = 64
GQA_WINDOW = 128

DIFF_HEADS = 8
DIFF_HEAD_DIM = 64

HGRN_HEADS = 8
HGRN_KEY_DIM = 128
HGRN_VAL_DIM = D_MODEL // HGRN_HEADS
HGRN_CHUNK = 64

MLA_HEADS = 16
MLA_Q_LORA = 256
MLA_KV_LORA = 256
MLA_NOPE = 64
MLA_ROPE = 32
MLA_V_DIM = 64

kernel_name = 'hybrid_interleaved_diffusion_block'


def _rmsnorm(x, w):
    xf = x.astype(jnp.float32)
    y = xf * lax.rsqrt(jnp.mean(xf * xf, axis=-1, keepdims=True) + EPS)
    return (y * w.astype(jnp.float32)).astype(x.dtype)


def _pre(h, gain, shift, scale):
    return _rmsnorm(h, gain) * (1.0 + scale) + shift


def _swiglu(h, w_gate, w_up, w_down):
    return (jax.nn.silu(h @ w_gate) * (h @ w_up)) @ w_down


def _axial_rope_tables(n_tokens, rot_dim):
    rows = n_tokens // GRID_W
    row = jnp.repeat(jnp.arange(rows, dtype=jnp.float32), GRID_W)
    col = jnp.tile(jnp.arange(GRID_W, dtype=jnp.float32), rows)
    axis_dim = rot_dim // 2
    inv_freq = ROPE_BASE ** (-jnp.arange(0, axis_dim, 2, dtype=jnp.float32) / axis_dim)
    ang_r = row[:, None] * inv_freq[None, :]
    ang_c = col[:, None] * inv_freq[None, :]
    ang = jnp.concatenate([ang_r, ang_r, ang_c, ang_c], axis=-1)
    return jnp.cos(ang), jnp.sin(ang)


def _apply_rope(x, cos, sin):
    a = x.shape[-1] // 2
    f = a // 2
    rot = jnp.concatenate([-x[..., f:a], x[..., :f], -x[..., a + f:], x[..., a:a + f]], axis=-1)
    out = x.astype(jnp.float32) * cos[None, :, None, :] + rot.astype(jnp.float32) * sin[None, :, None, :]
    return out.astype(x.dtype)


def _to_blocks(a):
    b, s = a.shape[:2]
    return jnp.moveaxis(a.reshape((b, s // BLOCK_Q, BLOCK_Q) + a.shape[2:]), 1, 0)


def _from_blocks(o):
    nb, b, bq = o.shape[:3]
    return jnp.moveaxis(o, 0, 1).reshape((b, nb * bq) + o.shape[3:])


def _gqa_window_mixer(hx, hc, w_in, w_out, sinks, cos, sin, with_ctx_out):
    B, S, _ = hx.shape
    H, KV, HD = GQA_HEADS, GQA_KV_HEADS, GQA_HEAD_DIM
    G = H // KV
    QD, KD = H * HD, KV * HD
    scale = HD ** -0.5
    sink = sinks.astype(jnp.float32).reshape(1, KV, G, 1, 1)

    def proj_q(h):
        return (h @ w_in[:, :QD]).reshape(h.shape[0], h.shape[1], H, HD)

    def proj_kv(h):
        p = h @ w_in[:, QD:]
        return (p[..., :KD].reshape(h.shape[0], h.shape[1], KV, HD),
                p[..., KD:].reshape(h.shape[0], h.shape[1], KV, HD))

    def sink_softmax(s):
        m = jnp.maximum(jnp.max(s, axis=-1, keepdims=True), sink)
        e = jnp.exp(s - m)
        return e / (jnp.sum(e, axis=-1, keepdims=True) + jnp.exp(sink - m))

    kx, vx = proj_kv(hx)
    kc, vc = proj_kv(hc)
    kx = _apply_rope(kx, cos, sin)
    qx = _apply_rope(proj_q(hx), cos, sin).reshape(B, S, KV, G, HD)

    span = BLOCK_Q + 2 * GQA_WINDOW
    pad = ((0, 0), (GQA_WINDOW, GQA_WINDOW), (0, 0), (0, 0))
    kxp, vxp = jnp.pad(kx, pad), jnp.pad(vx, pad)
    k_off = jnp.arange(span) - GQA_WINDOW
    band = jnp.abs(jnp.arange(BLOCK_Q)[:, None] - k_off[None, :]) <= GQA_WINDOW

    def block(args):
        start, qb = args
        kb = lax.dynamic_slice_in_dim(kxp, start, span, axis=1)
        vb = lax.dynamic_slice_in_dim(vxp, start, span, axis=1)
        k_abs = start + k_off
        mask = band & ((k_abs >= 0) & (k_abs < S))[None, :]
        s_loc = jnp.where(mask, jnp.einsum('bqkgd,bskd->bkgqs', qb, kb).astype(jnp.float32) * scale, NEG_INF)
        s_ctx = jnp.einsum('bqkgd,bckd->bkgqc', qb, kc).astype(jnp.float32) * scale
        p = sink_softmax(jnp.concatenate([s_loc, s_ctx], axis=-1)).astype(vb.dtype)
        return (jnp.einsum('bkgqs,bskd->bqkgd', p[..., :span], vb)
                + jnp.einsum('bkgqc,bckd->bqkgd', p[..., span:], vc))

    starts = jnp.arange(S // BLOCK_Q, dtype=jnp.int32) * BLOCK_Q
    ox = _from_blocks(lax.map(block, (starts, _to_blocks(qx))))
    ox = ox.reshape(B, S, QD) @ w_out
    oc = None
    if with_ctx_out:
        bc, nc = hc.shape[:2]
        qc = proj_q(hc).reshape(bc, nc, KV, G, HD)
        s = jnp.einsum('bqkgd,bckd->bkgqc', qc, kc).astype(jnp.float32) * scale
        p = sink_softmax(s).astype(vc.dtype)
        oc = jnp.einsum('bkgqc,bckd->bqkgd', p, vc).reshape(bc, nc, QD) @ w_out
    return ox, oc


def _diff_attn_mixer(hx, hc, w_in, w_out, lam_params, subln_w, lambda_init, cos, sin, with_ctx_out):
    B, S, _ = hx.shape
    H, HD = DIFF_HEADS, DIFF_HEAD_DIM
    QK = H * 2 * HD
    scale = HD ** -0.5
    lp = lam_params.astype(jnp.float32)
    lam = jnp.exp(jnp.sum(lp[0] * lp[1])) - jnp.exp(jnp.sum(lp[2] * lp[3])) + lambda_init

    def proj_q(h):
        return (h @ w_in[:, :QK]).reshape(h.shape[0], h.shape[1], H, 2, HD)

    def proj_kv(h):
        p = h @ w_in[:, QK:]
        return (p[..., :QK].reshape(h.shape[0], h.shape[1], H, 2, HD),
                p[..., QK:].reshape(h.shape[0], h.shape[1], H, 2 * HD))

    def rope(t):
        return _apply_rope(t.reshape(B, S, H * 2, HD), cos, sin).reshape(B, S, H, 2, HD)

    def diff_probs(s):
        p = jax.nn.softmax(s * scale, axis=-1)
        return p[:, :, 0] - lam * p[:, :, 1]

    def head_out(o):
        o = _rmsnorm(o, subln_w) * (1.0 - lambda_init)
        return o.reshape(o.shape[0], o.shape[1], H * 2 * HD) @ w_out

    kx, vx = proj_kv(hx)
    kc, vc = proj_kv(hc)
    kx = rope(kx)
    qx = rope(proj_q(hx))

    def block(qb):
        s_lat = jnp.einsum('bqhjd,bkhjd->bhjqk', qb, kx)
        s_ctx = jnp.einsum('bqhjd,bchjd->bhjqc', qb, kc)
        p = diff_probs(jnp.concatenate([s_lat, s_ctx], axis=-1).astype(jnp.float32)).astype(vx.dtype)
        return (jnp.einsum('bhqk,bkhe->bqhe', p[..., :S], vx)
                + jnp.einsum('bhqc,bche->bqhe', p[..., S:], vc))

    ox = head_out(_from_blocks(lax.map(block, _to_blocks(qx))))
    oc = None
    if with_ctx_out:
        qc = proj_q(hc)
        p = diff_probs(jnp.einsum('bqhjd,bchjd->bhjqc', qc, kc).astype(jnp.float32)).astype(vc.dtype)
        oc = head_out(jnp.einsum('bhqc,bche->bqhe', p, vc))
    return ox, oc


def _hgrn2_chunk_scan(q, k, v, logf, s0):
    B, T, H, DK = q.shape
    DV = v.shape[-1]
    C = HGRN_CHUNK
    N = T // C

    def chunks(a):
        return a.reshape(B, N, C, H, a.shape[-1]).transpose(1, 0, 3, 2, 4)

    q, k, v, logf = chunks(q), chunks(k), chunks(v), chunks(logf)
    g = jnp.cumsum(logf, axis=3)
    g_mid = g[:, :, :, C // 2:C // 2 + 1, :]
    g_last = g[:, :, :, C - 1:, :]
    a = jnp.einsum('nbhtd,nbhsd->nbhts', q * jnp.exp(g - g_mid), k * jnp.exp(g_mid - g))
    lower = jnp.arange(C)[:, None] >= jnp.arange(C)[None, :]
    a = jnp.where(lower, a, 0.0)
    o_intra = jnp.einsum('nbhts,nbhse->nbhte', a, v)

    def step(state, inp):
        q_in, k_out, v_c, decay = inp
        o = jnp.einsum('bhtd,bhde->bhte', q_in, state)
        state = state * decay[..., None] + jnp.einsum('bhsd,bhse->bhde', k_out, v_c)
        return state, o

    s_fin, o_inter = lax.scan(step, s0, (q * jnp.exp(g), k * jnp.exp(g_last - g), v, jnp.exp(g_last[:, :, :, 0, :])))
    o = (o_intra + o_inter).transpose(1, 0, 3, 2, 4).reshape(B, T, H, DV)
    return o, s_fin


def _hgrn2_mixer(hx, hc, w_in, w_out, norm_w, lb, with_ctx_out):
    H, DK, DV = HGRN_HEADS, HGRN_KEY_DIM, HGRN_VAL_DIM
    KD, VD = H * DK, H * DV

    def proj(h):
        b, t = h.shape[:2]
        p = (h @ w_in).astype(jnp.float32)
        q = jax.nn.silu(p[..., :KD]).reshape(b, t, H, DK)

        def forget(z):
            f = lb + (1.0 - lb) * jax.nn.sigmoid(z)
            return jnp.log(f).reshape(b, t, H, DK), (1.0 - f).reshape(b, t, H, DK)

        fwd = forget(p[..., KD:2 * KD])
        bwd = forget(p[..., 2 * KD:3 * KD])
        v = p[..., 3 * KD:3 * KD + VD].reshape(b, t, H, DV)
        gate = p[..., 3 * KD + VD:]
        return q, fwd, bwd, v, gate

    def flip(a):
        return jnp.flip(a, axis=1)

    def readout(o, gate, dtype):
        b, t = o.shape[:2]
        y = _rmsnorm(o, norm_w).reshape(b, t, VD) * jax.nn.silu(gate)
        return y.astype(dtype) @ w_out

    qc, (lfc, kfc), (lbc, kbc), vc, gc = proj(hc)
    qx, (lfx, kfx), (lbx, kbx), vx, gx = proj(hx)
    zero = jnp.zeros((hx.shape[0], H, DK, DV), jnp.float32)
    oc_f, sc_f = _hgrn2_chunk_scan(qc, kfc, vc, lfc, zero)
    oc_b, sc_b = _hgrn2_chunk_scan(flip(qc), flip(kbc), flip(vc), flip(lbc), zero)
    ox_f, _ = _hgrn2_chunk_scan(qx, kfx, vx, lfx, sc_f)
    ox_b, _ = _hgrn2_chunk_scan(flip(qx), flip(kbx), flip(vx), flip(lbx), sc_b)
    ox = readout(ox_f + flip(ox_b), gx, hx.dtype)
    oc = readout(oc_f + flip(oc_b), gc, hc.dtype) if with_ctx_out else None
    return ox, oc


def _mla_mixer(hx, hc, w_down, q_norm_w, kv_norm_w, w_uq, w_ukv, w_out, cos, sin, with_ctx_out):
    B, S, _ = hx.shape
    H, NOPE, R, VD = MLA_HEADS, MLA_NOPE, MLA_ROPE, MLA_V_DIM
    scale = (NOPE + R) ** -0.5

    def proj_q(h, rotate):
        b, t = h.shape[:2]
        cq = _rmsnorm(h @ w_down[:, :MLA_Q_LORA], q_norm_w)
        q = (cq @ w_uq).reshape(b, t, H, NOPE + R)
        qn, qr = q[..., :NOPE], q[..., NOPE:]
        if rotate:
            qr = _apply_rope(qr, cos, sin)
        return qn, qr

    def proj_kv(h, rotate):
        b, t = h.shape[:2]
        p = h @ w_down[:, MLA_Q_LORA:]
        ckv = _rmsnorm(p[..., :MLA_KV_LORA], kv_norm_w)
        kr = p[..., MLA_KV_LORA:]
        if rotate:
            kr = _apply_rope(kr[:, :, None, :], cos, sin)[:, :, 0, :]
        kv = (ckv @ w_ukv).reshape(b, t, H, NOPE + VD)
        return kv[..., :NOPE], kr, kv[..., NOPE:]

    def logits(qn, qr, kn, kr):
        s = jnp.einsum('bqhd,bkhd->bhqk', qn, kn) + jnp.einsum('bqhr,bkr->bhqk', qr, kr)
        return s.astype(jnp.float32) * scale

    knx, krx, vx = proj_kv(hx, True)
    knc, krc, vc = proj_kv(hc, False)
    qnx, qrx = proj_q(hx, True)

    def block(args):
        qn, qr = args
        s = jnp.concatenate([logits(qn, qr, knx, krx), logits(qn, qr, knc, krc)], axis=-1)
        p = jax.nn.softmax(s, axis=-1).astype(vx.dtype)
        return (jnp.einsum('bhqk,bkhe->bqhe', p[..., :S], vx)
                + jnp.einsum('bhqc,bche->bqhe', p[..., S:], vc))

    ox = _from_blocks(lax.map(block, (_to_blocks(qnx), _to_blocks(qrx))))
    ox = ox.reshape(B, S, H * VD) @ w_out
    oc = None
    if with_ctx_out:
        qnc, qrc = proj_q(hc, False)
        p = jax.nn.softmax(logits(qnc, qrc, knc, krc), axis=-1).astype(vc.dtype)
        oc = jnp.einsum('bhqc,bche->bqhe', p, vc)
        oc = oc.reshape(oc.shape[0], oc.shape[1], H * VD) @ w_out
    return ox, oc


def _layers_of(kind):
    return len(range(kind, DEPTH, N_MIXERS))


def setup_inputs(seed: int = 0) -> dict:
    key = jax.random.key(seed)
    keys = iter(jax.random.split(key, 40))

    def nrm(shape, std):
        return jax.random.normal(next(keys), shape, jnp.float32) * std

    D = D_MODEL
    n_gqa, n_diff, n_hgrn, n_mla = (_layers_of(k) for k in range(N_MIXERS))
    gqa_in = (GQA_HEADS + 2 * GQA_KV_HEADS) * GQA_HEAD_DIM
    gqa_o = GQA_HEADS * GQA_HEAD_DIM
    diff_o = DIFF_HEADS * 2 * DIFF_HEAD_DIM
    hk, hv = HGRN_HEADS * HGRN_KEY_DIM, HGRN_HEADS * HGRN_VAL_DIM
    mla_down = MLA_Q_LORA + MLA_KV_LORA + MLA_ROPE
    mla_o = MLA_HEADS * MLA_V_DIM
    return {
        'x': nrm((BATCH, SEQ, D), 1.0),
        'c': nrm((BATCH, D), 1.0),
        'ctx': nrm((BATCH, CTX_LEN, D), 1.0),
        'c_ctx': nrm((D,), 1.0),
        'ada_w': nrm((DEPTH, D, N_MOD * D), 0.5 * D ** -0.5),
        'ada_b': nrm((DEPTH, N_MOD * D), 0.02),
        'norm_w': 1.0 + nrm((DEPTH, 3, D), 0.05),
        'final_norm_w': 1.0 + nrm((D,), 0.05),
        'ffn_w_gate': nrm((DEPTH, 2, D, D_FF), D ** -0.5),
        'ffn_w_up': nrm((DEPTH, 2, D, D_FF), D ** -0.5),
        'ffn_w_down': nrm((DEPTH, 2, D_FF, D), D_FF ** -0.5),
        'gqa_w_in': nrm((n_gqa, D, gqa_in), D ** -0.5),
        'gqa_w_out': nrm((n_gqa, gqa_o, D), gqa_o ** -0.5),
        'gqa_sinks': nrm((n_gqa, GQA_HEADS), 0.5),
        'diff_w_in': nrm((n_diff, D, 3 * diff_o), D ** -0.5),
        'diff_w_out': nrm((n_diff, diff_o, D), diff_o ** -0.5),
        'diff_lambda': nrm((n_diff, 4, DIFF_HEAD_DIM), 0.1),
        'diff_subln_w': 1.0 + nrm((n_diff, 2 * DIFF_HEAD_DIM), 0.05),
        'hgrn_w_in': nrm((n_hgrn, D, 3 * hk + 2 * hv), D ** -0.5),
        'hgrn_w_out': nrm((n_hgrn, hv, D), hv ** -0.5),
        'hgrn_norm_w': 1.0 + nrm((n_hgrn, HGRN_VAL_DIM), 0.05),
        'hgrn_lower_bounds': nrm((DEPTH, hk), 0.5),
        'mla_w_down': nrm((n_mla, D, mla_down), D ** -0.5),
        'mla_q_norm_w': 1.0 + nrm((n_mla, MLA_Q_LORA), 0.05),
        'mla_kv_norm_w': 1.0 + nrm((n_mla, MLA_KV_LORA), 0.05),
        'mla_w_uq': nrm((n_mla, MLA_Q_LORA, MLA_HEADS * (MLA_NOPE + MLA_ROPE)), MLA_Q_LORA ** -0.5),
        'mla_w_ukv': nrm((n_mla, MLA_KV_LORA, MLA_HEADS * (MLA_NOPE + MLA_V_DIM)), MLA_KV_LORA ** -0.5),
        'mla_w_out': nrm((n_mla, mla_o, D), mla_o ** -0.5),
    }


def reference(x, c, ctx, c_ctx, ada_w, ada_b, norm_w, final_norm_w, ffn_w_gate, ffn_w_up, ffn_w_down,
              gqa_w_in, gqa_w_out, gqa_sinks, diff_w_in, diff_w_out, diff_lambda, diff_subln_w,
              hgrn_w_in, hgrn_w_out, hgrn_norm_w, hgrn_lower_bounds,
              mla_w_down, mla_q_norm_w, mla_kv_norm_w, mla_w_uq, mla_w_ukv, mla_w_out):
    B, S, D = x.shape
    cos_h, sin_h = _axial_rope_tables(S, GQA_HEAD_DIM)
    cos_m, sin_m = _axial_rope_tables(S, MLA_ROPE)
    lb_soft = jax.nn.softmax(hgrn_lower_bounds.astype(jnp.float32), axis=0)
    lb_all = jnp.cumsum(lb_soft, axis=0) - lb_soft[0:1]
    silu_c = jax.nn.silu(c)
    silu_cc = jax.nn.silu(c_ctx)
    hx, hc = x, ctx
    for i in range(DEPTH):
        kind, j = i % N_MIXERS, i // N_MIXERS
        with_ctx_out = i < DEPTH - 1
        mx = (silu_c @ ada_w[i] + ada_b[i]).reshape(B, N_MOD, 1, D)
        mc = (silu_cc @ ada_w[i] + ada_b[i]).reshape(N_MOD, D)
        fx = _swiglu(_pre(hx, norm_w[i, 0], mx[:, 0], mx[:, 1]), ffn_w_gate[i, 0], ffn_w_up[i, 0], ffn_w_down[i, 0])
        fc = _swiglu(_pre(hc, norm_w[i, 0], mc[0], mc[1]), ffn_w_gate[i, 0], ffn_w_up[i, 0], ffn_w_down[i, 0])
        hx = hx + 0.5 * mx[:, 2] * fx
        hc = hc + 0.5 * mc[2] * fc
        ax = _pre(hx, norm_w[i, 1], mx[:, 3], mx[:, 4])
        ac = _pre(hc, norm_w[i, 1], mc[3], mc[4])
        if kind == 0:
            ox, oc = _gqa_window_mixer(ax, ac, gqa_w_in[j], gqa_w_out[j], gqa_sinks[j], cos_h, sin_h, with_ctx_out)
        elif kind == 1:
            lambda_init = 0.8 - 0.6 * math.exp(-0.3 * i)
            ox, oc = _diff_attn_mixer(ax, ac, diff_w_in[j], diff_w_out[j], diff_lambda[j], diff_subln_w[j],
                                      lambda_init, cos_h, sin_h, with_ctx_out)
        elif kind == 2:
            ox, oc = _hgrn2_mixer(ax, ac, hgrn_w_in[j], hgrn_w_out[j], hgrn_norm_w[j], lb_all[i], with_ctx_out)
        else:
            ox, oc = _mla_mixer(ax, ac, mla_w_down[j], mla_q_norm_w[j], mla_kv_norm_w[j], mla_w_uq[j],
                                mla_w_ukv[j], mla_w_out[j], cos_m, sin_m, with_ctx_out)
        hx = hx + mx[:, 5] * ox
        fx = _swiglu(_pre(hx, norm_w[i, 2], mx[:, 6], mx[:, 7]), ffn_w_gate[i, 1], ffn_w_up[i, 1], ffn_w_down[i, 1])
        hx = hx + 0.5 * mx[:, 8] * fx
        if with_ctx_out:
            hc = hc + mc[5] * oc
            fc = _swiglu(_pre(hc, norm_w[i, 2], mc[6], mc[7]), ffn_w_gate[i, 1], ffn_w_up[i, 1], ffn_w_down[i, 1])
            hc = hc + 0.5 * mc[8] * fc
    return _rmsnorm(hx, final_norm_w)
```

```cpp
#include <hip/hip_runtime.h>
#include <hip/hip_cooperative_groups.h>
#include <cstdio>
#include <cstdint>
namespace cg = cooperative_groups;
namespace pg8 {
#define PG8_LAS __attribute__((address_space(3)))
typedef unsigned short bf16_t;
typedef short bf16x8 __attribute__((ext_vector_type(8)));
typedef float f32x4 __attribute__((ext_vector_type(4)));
typedef unsigned u32x4 __attribute__((ext_vector_type(4)));
constexpr int BM = 256, BK = 64, HALF = 128, HTB = HALF * BK * 2  , STAGE_BYTES = 8 * HTB, NXCD = 8, WGM = 8;

__host__ __device__ __forceinline__ int lds_byte(int r, int c) { const int st = (r >> 4) * 2 + (c >> 5), rr = r & 15, cc = c & 31, ob = rr * 64 + cc * 2; return st * 1024 + (ob ^ (((ob >> 9) & 1) << 5)); }
__host__ __device__ __forceinline__ void stage_rc(int b, int& R, int& C) { const int st = b / 1024, sb = b % 1024, swz = sb ^ (((sb >> 9) & 1) << 5); R = (st >> 1) * 16 + swz / 64; C = (st & 1) * 32 + (swz % 64) / 2; }
__host__ __device__ __forceinline__ int perm32(int rho) { const int n = rho >> 4, i = rho & 15; return 8 * (i >> 2) + 4 * n + (i & 3); }

struct Unit { int pm, pn, k0, nk, part; };
struct Gemm { const bf16_t* A; const bf16_t* Bt; int M, N, K; };

struct StaticOrder {
    int nN, nwg, G, c, nt, nfull, S, nMf; bool lat;
    __host__ __device__ void init(int M, int N, int G_, int c_, int nt_, bool split, bool lat_) {
        const int nM = M / BM; nN = N / BM; nwg = nM * nN; G = G_; c = c_; nt = nt_; lat = lat_; nfull = nwg; S = 1;
        if (split) { const int rem = nwg % G; if (rem > 0 && rem * 2 <= G && ((nwg - rem) % nN) == 0) { S = G / rem; if (S > 4) S = 4; if (S > nt / 2) S = nt / 2; nfull = nwg - rem; } }
        nMf = nfull / nN;
    }
    __host__ __device__ bool next(int i, Unit& u) const {
        const long L = (long)i * G + c;
        int pm, pn, k0 = 0, nk = nt, part = -1; bool ok = true;
        if (L < nfull) {
            int wgid = (int)L;
            { const int q = nfull / NXCD, r = nfull % NXCD, xcd = wgid % NXCD, off = wgid / NXCD; wgid = (xcd < r ? xcd * (q + 1) : r * (q + 1) + (xcd - r) * q) + off; }
            const int nig = WGM * nN, gid = wgid / nig, fm = gid * WGM, gsz = (nMf - fm) < WGM ? (nMf - fm) : WGM;
            pm = fm + ((wgid % nig) % gsz); pn = (wgid % nig) / gsz;
        } else {
            const long q = L - nfull; const int t = (int)(q / S); part = (int)(q % S); ok = (nfull + t < nwg);
            pm = nMf + t / nN; pn = t % nN;
            const int pairs = nt / 2, base = pairs / S, extra = pairs % S; const int p0 = part * base + (part < extra ? part : extra), np = base + (part < extra ? 1 : 0); k0 = 2 * p0; nk = 2 * np;
        }
        if (lat) pm = (pm >> 3) * 9 + 1 + (pm & 7);
        u.pm = pm; u.pn = pn; u.k0 = k0; u.nk = nk; u.part = part;
        return ok;
    }
    __device__ __forceinline__ void a_ready(const Unit&) const {}
    __device__ __forceinline__ void done(const Unit&) const {}
};
template <class Epi, class Sched, bool ALIGN_EPI = false, bool SP2 = false>
__device__ __forceinline__ void gemm_phase(PG8_LAS unsigned char* lds, const Gemm g, const Sched& S, const Epi& E) {
    int tid_ = threadIdx.x; asm volatile("" : "+v"(tid_));
    const int tid = tid_, wid = __builtin_amdgcn_readfirstlane(tid >> 6), lane = tid & 63, wr = wid >> 2, wc = wid & 3, fr = lane & 15, fq = lane >> 4;
    const int K = g.K;
    unsigned voffA[2], voffB[2];
#pragma unroll
    for (int i = 0; i < 2; ++i) { int R, C; stage_rc(tid * 16 + i * 8192, R, C); const int Rb = Epi::PERM ? ((R & ~31) + perm32(R & 31)) : R;
        voffA[i] = (unsigned)(R * K + C) * 2u; voffB[i] = (unsigned)(Rb * K + C) * 2u; }
    const size_t kstep = (size_t)(BK * 2);
    const size_t hstep = (size_t)HALF * K * 2;
    const size_t tstep = 2 * hstep;
    const unsigned ldsw = (unsigned)wid * 1024u;
    const int aoff = lds_byte(wr * 64 + fr, fq * 8), boff = lds_byte(wc * 32 + fr, fq * 8);
#define PG8_SA(b, h) (((b) * 2 + (h)) * HTB)
#define PG8_SB(b, h) ((4 + (b) * 2 + (h)) * HTB)
#define PG8_STAGE(bufoff, gbase, voff) do { _Pragma("unroll") for (int _i = 0; _i < 2; ++_i) \
        __builtin_amdgcn_global_load_lds((const unsigned*)((const char*)(gbase) + (voff)[_i]), (PG8_LAS unsigned*)(lds + (bufoff) + ldsw + _i * 8192), 16, 0, 0); } while (0)
#define PG8_LDA(dst, b, h) do { _Pragma("unroll") for (int m = 0; m < 4; ++m) _Pragma("unroll") for (int k = 0; k < 2; ++k) dst[m][k] = *(const PG8_LAS bf16x8*)(lds + PG8_SA(b, h) + aoff + m * 2048 + k * 1024); } while (0)
#define PG8_LDB(dst, b, h) do { _Pragma("unroll") for (int n = 0; n < 2; ++n) _Pragma("unroll") for (int k = 0; k < 2; ++k) dst[n][k] = *(const PG8_LAS bf16x8*)(lds + PG8_SB(b, h) + boff + n * 2048 + k * 1024); } while (0)
#define PG8_MMA(ai, bj, At, Bt) do { __builtin_amdgcn_s_setprio(1); _Pragma("unroll") for (int m = 0; m < 4; ++m) _Pragma("unroll") for (int n = 0; n < 2; ++n) _Pragma("unroll") for (int k = 0; k < 2; ++k) \
        acc[ai][bj][m][n] = __builtin_amdgcn_mfma_f32_16x16x32_bf16(Bt[n][k], At[m][k], acc[ai][bj][m][n], 0, 0, 0); __builtin_amdgcn_s_setprio(0); } while (0)
#define PG8_WAIT_V(n) asm volatile("s_waitcnt vmcnt(" #n ")" ::: "memory")
#define PG8_WAIT_L(n) asm volatile("s_waitcnt lgkmcnt(" #n ")" ::: "memory")
#define PG8_BAR __builtin_amdgcn_s_barrier()
#define PG8_SCHED __builtin_amdgcn_sched_barrier(0)
    Unit cur, nxt; int ui = 0;
    if (!S.next(0, cur)) return;
    f32x4 acc[2][2][4][2];
#pragma unroll
    for (int a = 0; a < 2; ++a)
#pragma unroll
        for (int b = 0; b < 2; ++b)
#pragma unroll
            for (int m = 0; m < 4; ++m)
#pragma unroll
                for (int n = 0; n < 2; ++n) acc[a][b][m][n] = (f32x4){0.f, 0.f, 0.f, 0.f};
    bf16x8 At[4][2], B0[2][2], B1[2][2];
    const char* cA = (const char*)g.A + (size_t)cur.pm * tstep + (size_t)cur.k0 * kstep; const char* cB = (const char*)g.Bt + (size_t)cur.pn * tstep + (size_t)cur.k0 * kstep;
    S.a_ready(cur);
    if constexpr (SP2) {
        PG8_STAGE(PG8_SB(0, 0), cB, voffB); PG8_STAGE(PG8_SB(0, 1), cB + hstep, voffB); PG8_STAGE(PG8_SA(0, 0), cA, voffA); PG8_STAGE(PG8_SA(0, 1), cA + hstep, voffA);
        if (wr == 1) PG8_BAR;
        PG8_WAIT_V(2); PG8_BAR;
        PG8_STAGE(PG8_SB(1, 0), cB + kstep, voffB); PG8_STAGE(PG8_SA(1, 0), cA + kstep, voffA); PG8_STAGE(PG8_SB(1, 1), cB + hstep + kstep, voffB);
        PG8_WAIT_V(6); PG8_BAR;
    } else {
        PG8_STAGE(PG8_SB(0, 0), cB, voffB); PG8_STAGE(PG8_SA(0, 0), cA, voffA); PG8_STAGE(PG8_SB(0, 1), cB + hstep, voffB); PG8_STAGE(PG8_SA(0, 1), cA + hstep, voffA);
        if (wr == 1) PG8_BAR;
        PG8_WAIT_V(4); PG8_BAR;
        PG8_STAGE(PG8_SB(1, 0), cB + kstep, voffB); PG8_STAGE(PG8_SA(1, 0), cA + kstep, voffA); PG8_STAGE(PG8_SB(1, 1), cB + hstep + kstep, voffB);
        PG8_WAIT_V(6); PG8_BAR;
    }
    for (;;) {
        const bool has_next = S.next(ui + 1, nxt);
        const char* nA = has_next ? (const char*)g.A + (size_t)nxt.pm * tstep + (size_t)nxt.k0 * kstep : cA; const char* nB = has_next ? (const char*)g.Bt + (size_t)nxt.pn * tstep + (size_t)nxt.k0 * kstep : cB;
        const int nt = cur.nk;
#pragma unroll 1
        for (int t = 0; t < nt; t += 2) {
            const bool last = (t == nt - 2);
            const char* a1 = cA + (size_t)(t + 1) * kstep;
            const char* a2 = last ? nA : cA + (size_t)(t + 2) * kstep; const char* b2 = last ? nB : cB + (size_t)(t + 2) * kstep;
            const char* a3 = a2 + kstep; const char* b3 = b2 + kstep;
            if (last && has_next) S.a_ready(nxt);
            if constexpr (SP2) {
            PG8_LDB(B0, 0, 0); PG8_LDB(B1, 0, 1); PG8_SCHED; PG8_LDA(At, 0, 0); PG8_STAGE(PG8_SA(1, 1), a1 + hstep, voffA);
            PG8_WAIT_V(8); PG8_WAIT_L(0); PG8_BAR; PG8_MMA(0, 0, At, B0); PG8_MMA(0, 1, At, B1); PG8_BAR; PG8_SCHED;
            PG8_LDA(At, 0, 1); PG8_STAGE(PG8_SB(0, 0), b2, voffB); PG8_STAGE(PG8_SB(0, 1), b2 + hstep, voffB); PG8_STAGE(PG8_SA(0, 0), a2, voffA);
            PG8_WAIT_V(8); PG8_WAIT_L(0); PG8_BAR; PG8_MMA(1, 0, At, B0); PG8_MMA(1, 1, At, B1); PG8_BAR; PG8_SCHED;
            PG8_LDB(B0, 1, 0); PG8_LDB(B1, 1, 1); PG8_SCHED; PG8_LDA(At, 1, 0); PG8_STAGE(PG8_SA(0, 1), a2 + hstep, voffA);
            PG8_WAIT_V(8); PG8_WAIT_L(0); PG8_BAR; PG8_MMA(0, 0, At, B0); PG8_MMA(0, 1, At, B1); PG8_BAR; PG8_SCHED;
            PG8_LDA(At, 1, 1); PG8_STAGE(PG8_SB(1, 0), b3, voffB); PG8_STAGE(PG8_SB(1, 1), b3 + hstep, voffB); PG8_STAGE(PG8_SA(1, 0), a3, voffA);
            PG8_WAIT_V(8); PG8_WAIT_L(0); PG8_BAR; PG8_MMA(1, 0, At, B0); PG8_MMA(1, 1, At, B1); PG8_BAR; PG8_SCHED;
            } else {
            PG8_LDB(B0, 0, 0); PG8_SCHED; PG8_LDA(At, 0, 0); PG8_STAGE(PG8_SA(1, 1), a1 + hstep, voffA);
            PG8_WAIT_L(8); PG8_BAR; PG8_WAIT_L(0); PG8_MMA(0, 0, At, B0); PG8_BAR; PG8_SCHED;
            PG8_LDB(B1, 0, 1); PG8_STAGE(PG8_SB(0, 0), b2, voffB);
            PG8_BAR; PG8_WAIT_L(0); PG8_MMA(0, 1, At, B1); PG8_BAR;
            PG8_LDA(At, 0, 1); PG8_STAGE(PG8_SA(0, 0), a2, voffA);
            PG8_BAR; PG8_WAIT_L(0); PG8_MMA(1, 0, At, B0); PG8_BAR; PG8_SCHED;
            PG8_STAGE(PG8_SB(0, 1), b2 + hstep, voffB);
            PG8_WAIT_V(6); PG8_BAR; PG8_MMA(1, 1, At, B1); PG8_BAR;
            PG8_LDB(B0, 1, 0); PG8_SCHED; PG8_LDA(At, 1, 0); PG8_STAGE(PG8_SA(0, 1), a2 + hstep, voffA);
            PG8_WAIT_L(8); PG8_BAR; PG8_WAIT_L(0); PG8_MMA(0, 0, At, B0); PG8_BAR; PG8_SCHED;
            PG8_LDB(B1, 1, 1); PG8_STAGE(PG8_SB(1, 0), b3, voffB);
            PG8_BAR; PG8_WAIT_L(0); PG8_MMA(0, 1, At, B1); PG8_BAR;
            PG8_LDA(At, 1, 1); PG8_STAGE(PG8_SA(1, 0), a3, voffA);
            PG8_BAR; PG8_WAIT_L(0); PG8_MMA(1, 0, At, B0); PG8_BAR; PG8_SCHED;
            PG8_STAGE(PG8_SB(1, 1), b3 + hstep, voffB);
            PG8_WAIT_V(6); PG8_BAR; PG8_MMA(1, 1, At, B1); PG8_BAR;
            }
        }
        if constexpr (ALIGN_EPI) { if (wr == 0) PG8_BAR; }
        if constexpr (!Epi::AFTER_DRAIN) { E(acc, cur, wr, wc, fr, fq); S.done(cur); }
        if (!has_next) break;
#pragma unroll
        for (int a = 0; a < 2; ++a)
#pragma unroll
            for (int b = 0; b < 2; ++b)
#pragma unroll
                for (int m = 0; m < 4; ++m)
#pragma unroll
                    for (int n = 0; n < 2; ++n) acc[a][b][m][n] = (f32x4){0.f, 0.f, 0.f, 0.f};
        cur = nxt; cA = nA; cB = nB; ++ui;
        if constexpr (ALIGN_EPI) { if (wr == 1) PG8_BAR; }
    }
    PG8_WAIT_V(0);
    if constexpr (!ALIGN_EPI) { if (wr == 0) PG8_BAR; }
    PG8_BAR;
    if constexpr (Epi::AFTER_DRAIN) { E.fused(acc, cur, wr, wc, fr, fq, lds, wid, lane); S.done(cur); }
#undef PG8_SA
#undef PG8_SB
#undef PG8_STAGE
#undef PG8_LDA
#undef PG8_LDB
#undef PG8_MMA
#undef PG8_WAIT_V
#undef PG8_WAIT_L
#undef PG8_BAR
#undef PG8_SCHED
}
}

#define LAS __attribute__((address_space(3)))
#define GAS __attribute__((address_space(1)))
using pg8::bf16_t; using pg8::bf16x8; using pg8::f32x4; using pg8::u32x4;
typedef float f32x16 __attribute__((ext_vector_type(16)));
typedef unsigned u32x2 __attribute__((ext_vector_type(2)));
typedef float f32x2v __attribute__((ext_vector_type(2)));
typedef __bf16 bf16x2v __attribute__((ext_vector_type(2)));

constexpr int NB = 16, SQ = 2048, CL = 256, TB = SQ + CL, TT = NB * TB, DM = 1024, FF = 2816, NMODV = 9216;
constexpr int NTHR = 512, GRID = 256;
constexpr size_t MiB = (size_t)1 << 20;
constexpr size_t U72 = 72 * MiB;
constexpr size_t WS_MOD = 0;
constexpr size_t WS_ROPEH = 3 * MiB;
constexpr size_t WS_ROPEM = 3 * MiB + 512 * 1024;
constexpr size_t WS_LB = 3 * MiB + 768 * 1024;
constexpr size_t WS_LAM = WS_LB + 4096;
constexpr size_t WS_BAR = 4 * MiB - 64 * 1024;
constexpr size_t WS_HX = 4 * MiB;
constexpr size_t WS_BIG = 148 * MiB;
constexpr size_t WS_END = 508 * MiB;
constexpr size_t DO_A = 0;
constexpr size_t DO_W = 72 * MiB;
constexpr size_t W_F1GU = DO_W, W_F1D = DO_W + 11 * MiB, W_F2GU = DO_W + 33 * MiB / 2, W_F2D = DO_W + 55 * MiB / 2;
constexpr size_t W_MIN = DO_W + 33 * MiB, W_MOUT = DO_W + 43 * MiB, W_UQ = DO_W + 45 * MiB, W_UKV = DO_W + 46 * MiB;
constexpr int LDS_BYTES = 147456;
constexpr float LOG2E = 1.4426950408889634f;

struct Params {
    const float *x, *c, *ctx, *c_ctx, *ada_w, *ada_b, *norm_w, *final_norm_w, *ffn_g, *ffn_u, *ffn_d,
        *gqa_in, *gqa_out, *gqa_sinks, *diff_in, *diff_out, *diff_lambda, *diff_subln,
        *hgrn_in, *hgrn_out, *hgrn_norm, *hgrn_lb, *mla_down, *mla_qn, *mla_kvn, *mla_uq, *mla_ukv, *mla_out;
    float* out; unsigned char* ws; int ph_lo, ph_hi;
};

__device__ __forceinline__ int fresh_bid() { int t = blockIdx.x; asm volatile("" : "+s"(t)); return t; }
__device__ __forceinline__ int fresh_gdim() { int t = gridDim.x; asm volatile("" : "+s"(t)); return t; }
__device__ __forceinline__ int fresh_tid() { int t = threadIdx.x; asm volatile("" : "+v"(t)); return t; }
__device__ __forceinline__ unsigned pk2(float lo, float hi) { f32x2v v = {lo, hi}; bf16x2v b = __builtin_convertvector(v, bf16x2v); return __builtin_bit_cast(unsigned, b); }
__device__ __forceinline__ unsigned short f2bf(float f) { return (unsigned short)(pk2(f, 0.f) & 0xffffu); }
__device__ __forceinline__ float bf2f(unsigned short u) { return __uint_as_float((unsigned)u << 16); }
__device__ __forceinline__ float bflo(unsigned w) { return __uint_as_float(w << 16); }
__device__ __forceinline__ float bfhi(unsigned w) { return __uint_as_float(w & 0xffff0000u); }
__device__ __forceinline__ unsigned short f2h(float f) { _Float16 h = (_Float16)f; return __builtin_bit_cast(unsigned short, h); }
__device__ __forceinline__ float h2f(unsigned short u) { return (float)__builtin_bit_cast(_Float16, u); }
__device__ __forceinline__ float silu_f(float v) { return v * __builtin_amdgcn_rcpf(1.f + __expf(-v)); }
__device__ __forceinline__ float wave_sum(float v) {
#pragma unroll
    for (int o = 1; o < 64; o <<= 1) v += __shfl_xor(v, o);
    return v;
}
__device__ __forceinline__ int crow(int r, int hi) { return (r & 3) + 8 * (r >> 2) + 4 * hi; }
__device__ __forceinline__ void store4bf(bf16_t* p, f32x4 v) { u32x2 w; w.x = pk2(v[0], v[1]); w.y = pk2(v[2], v[3]); *(GAS u32x2*)p = w; }
__device__ __forceinline__ f32x4 ldg4(const float* p) { return *(const GAS f32x4*)p; }
__device__ __forceinline__ void stg4(float* p, f32x4 v) { *(GAS f32x4*)p = v; }

template <class F> __device__ __forceinline__ void epi_loop(const f32x4 (&acc)[2][2][4][2], const pg8::Unit& u, int wr, int wc, int fr, int fq, const F& f) {
#pragma unroll
    for (int ai = 0; ai < 2; ++ai)
#pragma unroll
        for (int m = 0; m < 4; ++m) {
            const int row = u.pm * 256 + ai * 128 + wr * 64 + m * 16 + fr;
#pragma unroll
            for (int bj = 0; bj < 2; ++bj) f.item(row, u.pn * 256 + bj * 128 + wc * 32 + 4 * fq, acc[ai][bj][m][0], acc[ai][bj][m][1]);
        }
}
struct EpiSwiglu {
    static constexpr bool PERM = true, AFTER_DRAIN = false;
    bf16_t* H;
    __device__ __forceinline__ void operator()(const f32x4 (&acc)[2][2][4][2], const pg8::Unit& u, int wr, int wc, int fr, int fq) const {
        const int row0 = u.pm * 256 + wr * 64 + fr, col0 = u.pn * 128 + wc * 32 + 8 * fq;
#pragma unroll
        for (int ai = 0; ai < 2; ++ai)
#pragma unroll
            for (int m = 0; m < 4; ++m) {
                bf16_t* rp = H + (size_t)(row0 + ai * 128 + m * 16) * FF + col0;
                const f32x4 g0 = acc[ai][0][m][0], g1 = acc[ai][0][m][1], u0 = acc[ai][1][m][0], u1 = acc[ai][1][m][1];
                u32x4 w;
                w.x = pk2(silu_f(g0[0]) * u0[0], silu_f(g0[1]) * u0[1]); w.y = pk2(silu_f(g0[2]) * u0[2], silu_f(g0[3]) * u0[3]);
                w.z = pk2(silu_f(g1[0]) * u1[0], silu_f(g1[1]) * u1[1]); w.w = pk2(silu_f(g1[2]) * u1[2], silu_f(g1[3]) * u1[3]);
                *(GAS u32x4*)rp = w;
                asm volatile("" ::: "memory");
            }
    }
};
constexpr int SPLIT_PM0 = 128, SPLIT_ROWS = 4096;
struct EpiResid {
    static constexpr bool PERM = false, AFTER_DRAIN = false;
    float* HX; const float* modl; int midx; float coef; float* P;
    __device__ __forceinline__ void operator()(const f32x4 (&acc)[2][2][4][2], const pg8::Unit& u, int wr, int wc, int fr, int fq) const {
        const int bi = u.pm / 9, mr = (u.pm - bi * 9) == 0 ? 16 : bi;
        const int col0 = u.pn * 256 + wc * 32 + 4 * fq;
        const float* g = modl + (size_t)mr * NMODV + midx * 1024 + col0;
        f32x4 gv[2][2];
#pragma unroll
        for (int bj = 0; bj < 2; ++bj)
#pragma unroll
            for (int n = 0; n < 2; ++n) gv[bj][n] = coef * ldg4(g + bj * 128 + n * 16);
        if (u.part < 0) {
#pragma unroll
            for (int ai = 0; ai < 2; ++ai)
#pragma unroll
                for (int m = 0; m < 4; ++m) {
                    float* hp = HX + (size_t)(u.pm * 256 + ai * 128 + wr * 64 + m * 16 + fr) * DM + col0;
#pragma unroll
                    for (int bj = 0; bj < 2; ++bj)
#pragma unroll
                        for (int n = 0; n < 2; ++n) { float* h = hp + bj * 128 + n * 16; stg4(h, ldg4(h) + gv[bj][n] * acc[ai][bj][m][n]); }
                }
        } else {
#pragma unroll
            for (int ai = 0; ai < 2; ++ai)
#pragma unroll
                for (int m = 0; m < 4; ++m) {
                    float* hp = P + ((size_t)u.part * SPLIT_ROWS + (size_t)((u.pm - SPLIT_PM0) * 256 + ai * 128 + wr * 64 + m * 16 + fr)) * DM + col0;
#pragma unroll
                    for (int bj = 0; bj < 2; ++bj)
#pragma unroll
                        for (int n = 0; n < 2; ++n) stg4(hp + bj * 128 + n * 16, gv[bj][n] * acc[ai][bj][m][n]);
                    if (m & 1) asm volatile("" ::: "memory");
                }
        }
    }
};
__device__ __forceinline__ void rope64(f32x4& a, f32x4& b, const float* tab, int s, int col) {
    const int half = (col >> 5) & 1, i0 = col & 31;
    const GAS f32x4* tp = (const GAS f32x4*)(tab + ((size_t)s * 32 + half * 16 + i0) * 2);
    const f32x4 t0 = tp[0], t1 = tp[1];
    f32x4 na, nb;
    na[0] = a[0] * t0[0] - b[0] * t0[1]; nb[0] = b[0] * t0[0] + a[0] * t0[1];
    na[1] = a[1] * t0[2] - b[1] * t0[3]; nb[1] = b[1] * t0[2] + a[1] * t0[3];
    na[2] = a[2] * t1[0] - b[2] * t1[1]; nb[2] = b[2] * t1[0] + a[2] * t1[1];
    na[3] = a[3] * t1[2] - b[3] * t1[3]; nb[3] = b[3] * t1[2] + a[3] * t1[3];
    a = na; b = nb;
}
__device__ __forceinline__ void store_vt(bf16_t* vt, const f32x4& a, const f32x4& b) {
#pragma unroll
    for (int j = 0; j < 4; ++j) ((GAS bf16_t*)vt)[(size_t)j * TB] = f2bf(a[j]);
    asm volatile("" ::: "memory");
    GAS bf16_t* v2 = (GAS bf16_t*)vt + (size_t)16 * TB;
#pragma unroll
    for (int j = 0; j < 4; ++j) v2[(size_t)j * TB] = f2bf(b[j]);
    asm volatile("" ::: "memory");
}
struct EpiGqaIn {
    static constexpr bool PERM = false, AFTER_DRAIN = false;
    bf16_t *Q, *K, *Vt; const float* ropeH;
    __device__ __forceinline__ void item(int row, int col, const f32x4& a_, const f32x4& b_) const {
        f32x4 a = a_, b = b_; const int bi = row / TB, t = row - bi * TB;
        if (col < 1280) {
            if (t >= CL) rope64(a, b, ropeH, t - CL, col);
            if (col < 1024) { const float c2 = 0.125f * LOG2E; a = a * c2; b = b * c2; bf16_t* q = Q + (size_t)row * 1024 + col; store4bf(q, a); store4bf(q + 16, b); }
            else { bf16_t* k = K + (size_t)row * 256 + (col - 1024); store4bf(k, a); store4bf(k + 16, b); }
        } else { const int cv = col - 1280, head = cv >> 6, dv = cv & 63; store_vt(Vt + ((size_t)(bi * 4 + head) * 64 + dv) * TB + t, a, b); }
    }
    __device__ __forceinline__ void operator()(const f32x4 (&acc)[2][2][4][2], const pg8::Unit& u, int wr, int wc, int fr, int fq) const { epi_loop(acc, u, wr, wc, fr, fq, *this); }
};
struct EpiDiffIn {
    static constexpr bool PERM = false, AFTER_DRAIN = false;
    bf16_t *Q, *K, *Vt; const float* ropeH;
    __device__ __forceinline__ void item(int row, int col, const f32x4& a_, const f32x4& b_) const {
        f32x4 a = a_, b = b_; const int bi = row / TB, t = row - bi * TB;
        if (col < 2048) {
            if (t >= CL) rope64(a, b, ropeH, t - CL, col);
            if (col < 1024) { const float c2 = 0.125f * LOG2E; a = a * c2; b = b * c2; bf16_t* q = Q + (size_t)row * 1024 + col; store4bf(q, a); store4bf(q + 16, b); }
            else { bf16_t* k = K + (size_t)row * 1024 + (col - 1024); store4bf(k, a); store4bf(k + 16, b); }
        } else { const int cv = col - 2048, head = cv >> 7, dv = cv & 127; store_vt(Vt + ((size_t)(bi * 8 + head) * 128 + dv) * TB + t, a, b); }
    }
    __device__ __forceinline__ void operator()(const f32x4 (&acc)[2][2][4][2], const pg8::Unit& u, int wr, int wc, int fr, int fq) const { epi_loop(acc, u, wr, wc, fr, fq, *this); }
};
struct EpiHgrnIn {
    static constexpr bool PERM = false, AFTER_DRAIN = false;
    bf16_t* Qh; unsigned short *LF, *LB; bf16_t *V, *Gt; const float* lb;
    __device__ __forceinline__ void item(int row, int col, const f32x4& a, const f32x4& b) const {
        const int sec = col >> 10, cc = col & 1023; const size_t o = (size_t)row * 1024 + cc;
        if (sec == 0 || sec == 4) { f32x4 x, y;
#pragma unroll
            for (int j = 0; j < 4; ++j) { x[j] = silu_f(a[j]); y[j] = silu_f(b[j]); }
            bf16_t* d = (sec == 0 ? Qh : Gt) + o; store4bf(d, x); store4bf(d + 16, y);
        } else if (sec == 3) { store4bf(V + o, a); store4bf(V + o + 16, b); }
        else { unsigned short* d = (sec == 1 ? LF : LB) + o; const f32x4 la = ldg4(lb + cc), lbb = ldg4(lb + cc + 16);
            unsigned short ha[4], hb[4];
#pragma unroll
            for (int j = 0; j < 4; ++j) { const float fa = la[j] + (1.f - la[j]) * __builtin_amdgcn_rcpf(1.f + __expf(-a[j])), fb = lbb[j] + (1.f - lbb[j]) * __builtin_amdgcn_rcpf(1.f + __expf(-b[j]));
                ha[j] = f2h(__builtin_amdgcn_logf(fa) * 0.6931471805599453f); hb[j] = f2h(__builtin_amdgcn_logf(fb) * 0.6931471805599453f); }
            u32x2 w; w.x = ha[0] | ((unsigned)ha[1] << 16); w.y = ha[2] | ((unsigned)ha[3] << 16); *(GAS u32x2*)d = w;
            w.x = hb[0] | ((unsigned)hb[1] << 16); w.y = hb[2] | ((unsigned)hb[3] << 16); *(GAS u32x2*)(d + 16) = w; }
    }
    __device__ __forceinline__ void operator()(const f32x4 (&acc)[2][2][4][2], const pg8::Unit& u, int wr, int wc, int fr, int fq) const { epi_loop(acc, u, wr, wc, fr, fq, *this); }
};
struct EpiF32 {
    static constexpr bool PERM = false, AFTER_DRAIN = false;
    float* O; int ld;
    __device__ __forceinline__ void item(int row, int col, const f32x4& a, const f32x4& b) const { float* d = O + (size_t)row * ld + col; stg4(d, a); stg4(d + 16, b); }
    __device__ __forceinline__ void operator()(const f32x4 (&acc)[2][2][4][2], const pg8::Unit& u, int wr, int wc, int fr, int fq) const { epi_loop(acc, u, wr, wc, fr, fq, *this); }
};
struct EpiMlaUq {
    static constexpr bool PERM = false, AFTER_DRAIN = false;
    bf16_t* Q; const float* ropeM;
    __device__ __forceinline__ void half(f32x4& a, const float* tp, bool first) const {
        const f32x4 t0 = ldg4(tp), t1 = ldg4(tp + 4);
        f32x4 pa;
#pragma unroll
        for (int j = 0; j < 4; ++j) { pa[j] = __shfl_xor(a[j], 32); if (first) pa[j] = -pa[j]; }
        a[0] = a[0] * t0[0] + pa[0] * t0[1]; a[1] = a[1] * t0[2] + pa[1] * t0[3]; a[2] = a[2] * t1[0] + pa[2] * t1[1]; a[3] = a[3] * t1[2] + pa[3] * t1[3];
    }
    __device__ __forceinline__ void item(int row, int col, const f32x4& a_, const f32x4& b_) const {
        f32x4 a = a_, b = b_; const int bi = row / TB, t = row - bi * TB; const int g32 = col >> 5;
        const float c2 = 0.10206207261596577f * LOG2E;
        bf16_t* q = Q + (size_t)row * 1536 + col;
        const bool rot = (g32 % 3) == 2 && t >= CL;
        const int fq = (col & 15) >> 2; const bool first = fq < 2; const int i0 = 4 * (fq & 1);
        const float* tp = ropeM + ((size_t)(rot ? t - CL : 0) * 16 + i0) * 2;
        if (rot) half(a, tp, first);
        a = a * c2; store4bf(q, a);
        asm volatile("" ::: "memory");
        if (rot) half(b, tp + 16, first);
        b = b * c2; store4bf(q + 16, b);
        asm volatile("" ::: "memory");
    }
    __device__ __forceinline__ void operator()(const f32x4 (&acc)[2][2][4][2], const pg8::Unit& u, int wr, int wc, int fr, int fq) const { epi_loop(acc, u, wr, wc, fr, fq, *this); }
};
struct EpiMlaUkv {
    static constexpr bool PERM = false, AFTER_DRAIN = false;
    bf16_t *K, *Vt;
    __device__ __forceinline__ void item(int row, int col, const f32x4& a, const f32x4& b) const {
        const int bi = row / TB, t = row - bi * TB; const int head = col >> 7, x = col & 127;
        if (x < 64) { bf16_t* k = K + (size_t)row * 1536 + head * 96 + x; store4bf(k, a); store4bf(k + 16, b); }
        else store_vt(Vt + ((size_t)(bi * 16 + head) * 64 + (x - 64)) * TB + t, a, b);
    }
    __device__ __forceinline__ void operator()(const f32x4 (&acc)[2][2][4][2], const pg8::Unit& u, int wr, int wc, int fr, int fq) const { epi_loop(acc, u, wr, wc, fr, fq, *this); }
};

template <class Epi> __device__ __forceinline__ void run_gemm(LAS unsigned char* lds, const bf16_t* A, const bf16_t* Bt, int N, int K, const Epi& E, bool split = false, bool lat = false) {
    pg8::Gemm g{A, Bt, lat ? NB * SQ : TT, N, K}; pg8::StaticOrder S; S.init(lat ? NB * SQ : TT, N, GRID, fresh_bid(), K / 64, split, lat);
    pg8::gemm_phase<Epi, pg8::StaticOrder, true, true>(lds, g, S, E);
}

__device__ __forceinline__ void transpose_item(const float* W, int K, int N, bf16_t* WT, int mode, LAS float* scr, int item, int lane) {
    const int nblk = N / 32, kb = item / nblk, nb = item - kb * nblk, k0 = 64 * kb, n0 = 32 * nb;
#pragma unroll 8
    for (int i = 0; i < 32; ++i) { const int kk = 2 * i + (lane >> 5); scr[kk * 33 + (lane & 31)] = W[(size_t)(k0 + kk) * N + n0 + (lane & 31)]; }
    asm volatile("s_waitcnt lgkmcnt(0)" ::: "memory");
    const int drow0 = mode == 0 ? n0 : (n0 >> 7) * 256 + (n0 & 127) + (mode == 2 ? 128 : 0);
    const int c = lane & 7;
#pragma unroll
    for (int j = 0; j < 4; ++j) { const int n = (lane >> 3) + 8 * j; const LAS float* s = scr + (8 * c) * 33 + n;
        u32x4 o; o.x = pk2(s[0 * 33], s[1 * 33]); o.y = pk2(s[2 * 33], s[3 * 33]); o.z = pk2(s[4 * 33], s[5 * 33]); o.w = pk2(s[6 * 33], s[7 * 33]);
        *(u32x4*)(WT + (size_t)(drow0 + n) * K + k0 + 8 * c) = o; }
    asm volatile("s_waitcnt lgkmcnt(0)" ::: "memory");
}
__device__ __forceinline__ void conv_job(const float* W, int K, int N, bf16_t* WT, int mode, LAS float* scr, int gw, int NGW, int lane, int& base) {
    const int n = (K / 64) * (N / 32);
    int it = gw - (base % NGW); if (it < 0) it += NGW;
    for (; it < n; it += NGW) transpose_item(W, K, N, WT, mode, scr, it, lane);
    base += n;
}
__device__ __forceinline__ void convert_weights(const Params& p, int layer, LAS unsigned char* lds, unsigned char* dout) {
    const int tid = fresh_tid(), lane = tid & 63, wave = tid >> 6;
    const int gw = fresh_bid() * 8 + wave, NGW = fresh_gdim() * 8;
    LAS float* scr = (LAS float*)(lds + wave * 16384);
    int base = 0;
    const size_t fgu = (size_t)DM * FF;
    for (int f = 0; f < 2; ++f) {
        const size_t off = ((size_t)layer * 2 + f) * fgu;
        bf16_t* gu = (bf16_t*)(dout + (f == 0 ? W_F1GU : W_F2GU)); bf16_t* dn = (bf16_t*)(dout + (f == 0 ? W_F1D : W_F2D));
        conv_job(p.ffn_g + off, DM, FF, gu, 1, scr, gw, NGW, lane, base);
        conv_job(p.ffn_u + off, DM, FF, gu, 2, scr, gw, NGW, lane, base);
        conv_job(p.ffn_d + off, FF, DM, dn, 0, scr, gw, NGW, lane, base);
    }
    bf16_t* win = (bf16_t*)(dout + W_MIN); bf16_t* wout = (bf16_t*)(dout + W_MOUT);
    if (layer == 0) { conv_job(p.gqa_in, DM, 1536, win, 0, scr, gw, NGW, lane, base); conv_job(p.gqa_out, DM, DM, wout, 0, scr, gw, NGW, lane, base); }
    else if (layer == 1) { conv_job(p.diff_in, DM, 3072, win, 0, scr, gw, NGW, lane, base); conv_job(p.diff_out, DM, DM, wout, 0, scr, gw, NGW, lane, base); }
    else if (layer == 2) { conv_job(p.hgrn_in, DM, 5120, win, 0, scr, gw, NGW, lane, base); conv_job(p.hgrn_out, DM, DM, wout, 0, scr, gw, NGW, lane, base); }
    else {
        conv_job(p.mla_down, DM, 544, win, 0, scr, gw, NGW, lane, base);
        conv_job(p.mla_uq, 256, 1536, (bf16_t*)(dout + W_UQ), 0, scr, gw, NGW, lane, base);
        conv_job(p.mla_ukv, 256, 2048, (bf16_t*)(dout + W_UKV), 0, scr, gw, NGW, lane, base);
        conv_job(p.mla_out, DM, DM, wout, 0, scr, gw, NGW, lane, base);
    }
}

__device__ __forceinline__ void prologue(const Params& p, LAS unsigned char* lds) {
    const int tid = fresh_tid(), G = fresh_gdim(), bid = fresh_bid();
    float* ropeH = (float*)(p.ws + WS_ROPEH); float* ropeM = (float*)(p.ws + WS_ROPEM);
    for (int i = bid * NTHR + tid; i < 2048 * 32; i += G * NTHR) { const int s = i >> 5, e = i & 31; const float pos = (e < 16) ? (float)(s >> 6) : (float)(s & 63);
        const float inv = powf(10000.f, -(float)(2 * (e & 15)) / 32.f); const float ang = pos * inv; ropeH[2 * i] = cosf(ang); ropeH[2 * i + 1] = sinf(ang); }
    for (int i = bid * NTHR + tid; i < 2048 * 16; i += G * NTHR) { const int s = i >> 4, e = i & 15; const float pos = (e < 8) ? (float)(s >> 6) : (float)(s & 63);
        const float inv = powf(10000.f, -(float)(2 * (e & 7)) / 16.f); const float ang = pos * inv; ropeM[2 * i] = cosf(ang); ropeM[2 * i + 1] = sinf(ang); }
    if (bid == 0) {
        float* lbv = (float*)(p.ws + WS_LB);
        for (int d = tid; d < 1024; d += NTHR) { const float a0 = p.hgrn_lb[d], a1 = p.hgrn_lb[1024 + d], a2 = p.hgrn_lb[2048 + d], a3 = p.hgrn_lb[3072 + d];
            const float mx = fmaxf(fmaxf(a0, a1), fmaxf(a2, a3)); const float e0 = expf(a0 - mx), e1 = expf(a1 - mx), e2 = expf(a2 - mx), e3 = expf(a3 - mx);
            lbv[d] = (e1 + e2) / (e0 + e1 + e2 + e3); }
        if (tid == 0) { float s1 = 0.f, s2 = 0.f; for (int d = 0; d < 64; ++d) { s1 += p.diff_lambda[d] * p.diff_lambda[64 + d]; s2 += p.diff_lambda[128 + d] * p.diff_lambda[192 + d]; }
            const float lambda_init = 0.8f - 0.6f * expf(-0.3f);
            ((float*)(p.ws + WS_LAM))[0] = expf(s1) - expf(s2) + lambda_init; ((float*)(p.ws + WS_LAM))[1] = lambda_init; }
    }
    LAS float* sS = (LAS float*)lds; LAS float* red = (LAS float*)(lds + 17 * 1024 * 4);
    for (int i = tid; i < 17 * 1024; i += NTHR) { const int r = i >> 10, k = i & 1023; const float v = r < 16 ? p.c[r * 1024 + k] : p.c_ctx[k]; sS[i] = v / (1.f + expf(-v)); }
    __syncthreads();
    float* mod = (float*)(p.ws + WS_MOD);
    for (int item = bid; item < 4 * 144; item += G) {
        const int l = item / 144, n0 = (item - l * 144) * 64, col = tid & 63, kq = tid >> 6;
        const float* W = p.ada_w + (size_t)l * 1024 * NMODV + n0 + col;
        float acc[17];
#pragma unroll
        for (int r = 0; r < 17; ++r) acc[r] = 0.f;
        for (int k = kq * 128; k < kq * 128 + 128; k += 8) {
            float w[8];
#pragma unroll
            for (int i = 0; i < 8; ++i) w[i] = *(const GAS float*)(W + (size_t)(k + i) * NMODV);
#pragma unroll
            for (int i = 0; i < 8; i += 4)
#pragma unroll
                for (int r = 0; r < 17; ++r) { const f32x4 s4 = *(const LAS f32x4*)(sS + r * 1024 + k + i); acc[r] += (s4[0] * w[i] + s4[1] * w[i + 1]) + (s4[2] * w[i + 2] + s4[3] * w[i + 3]); }
        }
#pragma unroll
        for (int r = 0; r < 17; ++r) red[(kq * 17 + r) * 64 + col] = acc[r];
        __syncthreads();
        for (int o = tid; o < 17 * 64; o += NTHR) { const int r = o >> 6, cc = o & 63;
            float s = 0.f;
#pragma unroll
            for (int q = 0; q < 8; ++q) s += red[(q * 17 + r) * 64 + cc];
            mod[((size_t)l * 17 + r) * NMODV + n0 + cc] = s + p.ada_b[(size_t)l * NMODV + n0 + cc]; }
        __syncthreads();
    }
}

__device__ __forceinline__ void norm_phase(float* HX, const float* nw, const float* modl, int shift_idx, int scale_idx, bf16_t* A, const float* P, bool skip_ctx = false, const float* srcx = nullptr, const float* srcc = nullptr) {
    const int tid = fresh_tid(), lane = tid & 63, gw = fresh_bid() * 8 + (tid >> 6), NGW = fresh_gdim() * 8;
    f32x4 w4[4];
#pragma unroll
    for (int j = 0; j < 4; ++j) w4[j] = *(const f32x4*)(nw + lane * 4 + 256 * j);
    for (int row = gw; row < TT; row += NGW) {
        const int b = row / TB, t = row - b * TB, mr = t < CL ? 16 : b;
        if (skip_ctx && t < CL) continue;
        f32x4* xr = (f32x4*)(HX + (size_t)row * DM) + lane;
        f32x4 v[4]; float ss = 0.f;
        if (srcx != nullptr) {
            const f32x4* sr = (const f32x4*)(t < CL ? srcc + ((size_t)(b * CL + t)) * DM : srcx + ((size_t)(b * SQ + t - CL)) * DM) + lane;
#pragma unroll
            for (int j = 0; j < 4; ++j) { v[j] = sr[64 * j]; xr[64 * j] = v[j]; }
        } else {
#pragma unroll
            for (int j = 0; j < 4; ++j) v[j] = xr[64 * j];
        }
        if (P != nullptr && row >= SPLIT_PM0 * 256) {
            const f32x4* pr = (const f32x4*)(P + (size_t)(row - SPLIT_PM0 * 256) * DM) + lane;
#pragma unroll
            for (int j = 0; j < 4; ++j) { v[j] = v[j] + ((pr[64 * j] + pr[(size_t)SPLIT_ROWS * 256 + 64 * j]) + (pr[(size_t)2 * SPLIT_ROWS * 256 + 64 * j] + pr[(size_t)3 * SPLIT_ROWS * 256 + 64 * j])); xr[64 * j] = v[j]; }
        }
#pragma unroll
        for (int j = 0; j < 4; ++j) ss += (v[j][0] * v[j][0] + v[j][1] * v[j][1]) + (v[j][2] * v[j][2] + v[j][3] * v[j][3]);
        const float rstd = rsqrtf(wave_sum(ss) * (1.f / 1024.f) + 1e-6f);
        const float* sh = modl + (size_t)mr * NMODV + shift_idx * 1024 + lane * 4; const float* sc = modl + (size_t)mr * NMODV + scale_idx * 1024 + lane * 4;
        bf16_t* ar = A + (size_t)row * DM + lane * 4;
#pragma unroll
        for (int j = 0; j < 4; ++j) { const f32x4 s4 = *(const f32x4*)(sc + 256 * j), h4 = *(const f32x4*)(sh + 256 * j);
            const f32x4 y = v[j] * rstd * w4[j] * (1.f + s4) + h4; store4bf(ar + 256 * j, y); }
    }
}
__device__ __forceinline__ void final_phase(const float* HX, const float* nw, float* out) {
    const int tid = fresh_tid(), lane = tid & 63, gw = fresh_bid() * 8 + (tid >> 6), NGW = fresh_gdim() * 8;
    f32x4 w4[4];
#pragma unroll
    for (int j = 0; j < 4; ++j) w4[j] = *(const f32x4*)(nw + lane * 4 + 256 * j);
    for (int r = gw; r < NB * SQ; r += NGW) {
        const int b = r >> 11, s = r & 2047; const int row = b * TB + CL + s;
        const f32x4* xr = (const f32x4*)(HX + (size_t)row * DM) + lane;
        f32x4 v[4]; float ss = 0.f;
#pragma unroll
        for (int j = 0; j < 4; ++j) { v[j] = xr[64 * j]; ss += (v[j][0] * v[j][0] + v[j][1] * v[j][1]) + (v[j][2] * v[j][2] + v[j][3] * v[j][3]); }
        const float rstd = rsqrtf(wave_sum(ss) * (1.f / 1024.f) + 1e-6f);
        f32x4* o = (f32x4*)(out + (size_t)r * DM) + lane;
#pragma unroll
        for (int j = 0; j < 4; ++j) o[64 * j] = v[j] * rstd * w4[j];
    }
}
__device__ __forceinline__ void diff_combine(const bf16_t* O16, const float* subln, const float* lamp, bf16_t* A) {
    const int tid = fresh_tid(), lane = tid & 63, gw = fresh_bid() * 8 + (tid >> 6), NGW = fresh_gdim() * 8;
    const float lam = lamp[0], om = 1.f - lamp[1];
    const int h = lane >> 3, e0 = (lane & 7) * 16;
    float sw[16];
#pragma unroll
    for (int j = 0; j < 16; ++j) sw[j] = subln[e0 + j] * om;
    for (int row = gw; row < TT; row += NGW) {
        const u32x4* o1 = (const u32x4*)(O16 + (size_t)row * 2048 + (2 * h) * 128 + e0); const u32x4* o2 = (const u32x4*)(O16 + (size_t)row * 2048 + (2 * h + 1) * 128 + e0);
        float v[16]; float ss = 0.f;
#pragma unroll
        for (int q = 0; q < 2; ++q) { const u32x4 a = o1[q], b = o2[q];
#pragma unroll
            for (int k = 0; k < 4; ++k) { v[q * 8 + 2 * k] = bflo(a[k]) - lam * bflo(b[k]); v[q * 8 + 2 * k + 1] = bfhi(a[k]) - lam * bfhi(b[k]); } }
#pragma unroll
        for (int j = 0; j < 16; ++j) ss += v[j] * v[j];
        ss += __shfl_xor(ss, 1); ss += __shfl_xor(ss, 2); ss += __shfl_xor(ss, 4);
        const float rstd = rsqrtf(ss * (1.f / 128.f) + 1e-6f);
        u32x4 w0, w1;
        w0.x = pk2(v[0] * rstd * sw[0], v[1] * rstd * sw[1]); w0.y = pk2(v[2] * rstd * sw[2], v[3] * rstd * sw[3]); w0.z = pk2(v[4] * rstd * sw[4], v[5] * rstd * sw[5]); w0.w = pk2(v[6] * rstd * sw[6], v[7] * rstd * sw[7]);
        w1.x = pk2(v[8] * rstd * sw[8], v[9] * rstd * sw[9]); w1.y = pk2(v[10] * rstd * sw[10], v[11] * rstd * sw[11]); w1.z = pk2(v[12] * rstd * sw[12], v[13] * rstd * sw[13]); w1.w = pk2(v[14] * rstd * sw[14], v[15] * rstd * sw[15]);
        u32x4* d = (u32x4*)(A + (size_t)row * 1024 + h * 128 + e0); d[0] = w0; d[1] = w1;
    }
}
__device__ __forceinline__ void hgrn_combine(const bf16_t* OF, const bf16_t* OB, const bf16_t* Gt, const float* nw, bf16_t* A) {
    const int tid = fresh_tid(), lane = tid & 63, gw = fresh_bid() * 8 + (tid >> 6), NGW = fresh_gdim() * 8;
    const int e0 = (lane & 7) * 16;
    float sw[16];
#pragma unroll
    for (int j = 0; j < 16; ++j) sw[j] = nw[e0 + j];
    for (int row = gw; row < TT; row += NGW) {
        const size_t off = (size_t)row * 1024 + lane * 16;
        const u32x4* pf = (const u32x4*)(OF + off); const u32x4* pb = (const u32x4*)(OB + off); const u32x4* pg = (const u32x4*)(Gt + off);
        float v[16], g[16]; float ss = 0.f;
#pragma unroll
        for (int q = 0; q < 2; ++q) { const u32x4 a = pf[q], b = pb[q], c = pg[q];
#pragma unroll
            for (int k = 0; k < 4; ++k) { v[q * 8 + 2 * k] = bflo(a[k]) + bflo(b[k]); v[q * 8 + 2 * k + 1] = bfhi(a[k]) + bfhi(b[k]); g[q * 8 + 2 * k] = bflo(c[k]); g[q * 8 + 2 * k + 1] = bfhi(c[k]); } }
#pragma unroll
        for (int j = 0; j < 16; ++j) ss += v[j] * v[j];
        ss += __shfl_xor(ss, 1); ss += __shfl_xor(ss, 2); ss += __shfl_xor(ss, 4);
        const float rstd = rsqrtf(ss * (1.f / 128.f) + 1e-6f);
        u32x4 w0, w1;
#define HC(j) (v[j] * rstd * sw[j] * g[j])
        w0.x = pk2(HC(0), HC(1)); w0.y = pk2(HC(2), HC(3)); w0.z = pk2(HC(4), HC(5)); w0.w = pk2(HC(6), HC(7));
        w1.x = pk2(HC(8), HC(9)); w1.y = pk2(HC(10), HC(11)); w1.z = pk2(HC(12), HC(13)); w1.w = pk2(HC(14), HC(15));
#undef HC
        u32x4* d = (u32x4*)(A + off); d[0] = w0; d[1] = w1;
    }
}
__device__ __forceinline__ void mla_rows(const float* DN, const float* qn, const float* kvn, const float* ropeM, bf16_t* CQ, bf16_t* CKV, bf16_t* K) {
    const int tid = fresh_tid(), lane = tid & 63, gw = fresh_bid() * 8 + (tid >> 6), NGW = fresh_gdim() * 8;
    const f32x4 wq = *(const f32x4*)(qn + lane * 4), wk = *(const f32x4*)(kvn + lane * 4);
    for (int row = gw; row < TT; row += NGW) {
        const int b = row / TB, t = row - b * TB;
        const float* dr = DN + (size_t)row * 768;
        const f32x4 a = *(const f32x4*)(dr + lane * 4), c = *(const f32x4*)(dr + 256 + lane * 4);
        const float kr = dr[512 + (lane & 31)];
        float sa = (a[0] * a[0] + a[1] * a[1]) + (a[2] * a[2] + a[3] * a[3]), sc = (c[0] * c[0] + c[1] * c[1]) + (c[2] * c[2] + c[3] * c[3]);
        sa = wave_sum(sa); sc = wave_sum(sc);
        const float ra = rsqrtf(sa * (1.f / 256.f) + 1e-6f), rc = rsqrtf(sc * (1.f / 256.f) + 1e-6f);
        store4bf(CQ + (size_t)row * 256 + lane * 4, a * ra * wq); store4bf(CKV + (size_t)row * 256 + lane * 4, c * rc * wk);
        const int d = lane & 31; float kv = kr;
        const float part = __shfl_xor(kr, 8);
        if (t >= CL) { const int e = (d >> 4) * 8 + (d & 7); const float cs = ropeM[((size_t)(t - CL) * 16 + e) * 2], sn = ropeM[((size_t)(t - CL) * 16 + e) * 2 + 1];
            kv = kr * cs + ((d & 8) ? part : -part) * sn; }
        float o8[8];
#pragma unroll
        for (int j = 0; j < 8; ++j) o8[j] = __shfl(kv, (lane & 3) * 8 + j);
        u32x4 w; w.x = pk2(o8[0], o8[1]); w.y = pk2(o8[2], o8[3]); w.z = pk2(o8[4], o8[5]); w.w = pk2(o8[6], o8[7]);
        *(u32x4*)(K + (size_t)row * 1536 + (lane >> 2) * 96 + 64 + (lane & 3) * 8) = w;
    }
}

template <int DQK, int DV>
__device__ __forceinline__ void attn_unit(LAS unsigned char* lds, const bf16_t* Qr, int qs, const bf16_t* Kb, int ks, const bf16_t* Vtb, bf16_t* Or, int os,
                                          int lt0, int lt1, bool windowed, int qpos0, float m_init, float l_init,
                                          const bf16_t* Oprev = nullptr, float lam = 0.f, float om = 0.f, const float* subw = nullptr) {
    constexpr int KST = DQK * 2 + 16, VST = 144, KBUF = 64 * KST, VBUF = DV * VST, KCH = DQK / 8, NKC = 64 * KCH, KPT = (NKC + NTHR - 1) / NTHR, VPT = DV / 64, ND = DQK / 16, NO = DV / 32;
    const int tid = fresh_tid(), lane = tid & 63, r32 = lane & 31, hi = lane >> 5, wid = tid >> 6;
    LAS unsigned char* Kl = lds; LAS unsigned char* Vl = lds + 2 * KBUF;
    const int ntiles = 4 + (lt1 - lt0);
    const GAS bf16_t* Qg = (const GAS bf16_t*)Qr; const GAS bf16_t* Kg = (const GAS bf16_t*)Kb; const GAS bf16_t* Vg = (const GAS bf16_t*)Vtb; GAS bf16_t* Og = (GAS bf16_t*)Or;
    bf16x8 qf[ND];
#pragma unroll
    for (int d0 = 0; d0 < ND; ++d0) qf[d0] = *(const GAS bf16x8*)(Qg + (size_t)(wid * 32 + r32) * qs + d0 * 16 + hi * 8);
    f32x16 o[NO];
#pragma unroll
    for (int nb = 0; nb < NO; ++nb)
#pragma unroll
        for (int r = 0; r < 16; ++r) o[nb][r] = 0.f;
    const bool have_ref = l_init > 0.f;
    float m = have_ref ? m_init : 0.f, l = (hi == 0) ? l_init : 0.f;
    u32x4 kreg[KPT], vreg[VPT];
#define ATT_KT(tt_) ((tt_) < 4 ? (tt_) : lt0 + (tt_) - 4)
#define ATT_LOADK(tt_) do { const int kt_ = ATT_KT(tt_); \
        _Pragma("unroll") for (int i_ = 0; i_ < KPT; ++i_) { const int c_ = tid + NTHR * i_; if (c_ < NKC) { const int key_ = c_ / KCH, part_ = c_ - key_ * KCH; kreg[i_] = *(const GAS u32x4*)(Kg + (size_t)(kt_ * 64 + key_) * ks + part_ * 8); } } } while (0)
#define ATT_LOADV(tt_) do { const int kt_ = ATT_KT(tt_); \
        _Pragma("unroll") for (int i_ = 0; i_ < VPT; ++i_) { const int c_ = tid + NTHR * i_; const int dv_ = c_ >> 3, part_ = c_ & 7; vreg[i_] = *(const GAS u32x4*)(Vg + (size_t)dv_ * TB + kt_ * 64 + part_ * 8); } } while (0)
#define ATT_STOREK(buf_) do { \
        _Pragma("unroll") for (int i_ = 0; i_ < KPT; ++i_) { const int c_ = tid + NTHR * i_; if (c_ < NKC) { const int key_ = c_ / KCH, part_ = c_ - key_ * KCH; *(LAS u32x4*)(Kl + (buf_) * KBUF + key_ * KST + part_ * 16) = kreg[i_]; } } } while (0)
#define ATT_STOREV(buf_) do { \
        _Pragma("unroll") for (int i_ = 0; i_ < VPT; ++i_) { const int c_ = tid + NTHR * i_; const int dv_ = c_ >> 3, part_ = c_ & 7; LAS unsigned char* d_ = Vl + (buf_) * VBUF + dv_ * VST + (part_ >> 1) * 32 + (part_ & 1) * 8;     \
            *(LAS u32x2*)d_ = (u32x2){vreg[i_].x, vreg[i_].y}; *(LAS u32x2*)(d_ + 16) = (u32x2){vreg[i_].z, vreg[i_].w}; } } while (0)
#define SCHED_FENCE() __builtin_amdgcn_sched_barrier(0)
#define ATT_KFRAG(buf_) do { const LAS unsigned char* kb_ = Kl + (buf_) * KBUF + r32 * KST + hi * 16; \
        _Pragma("unroll") for (int d0 = 0; d0 < ND; ++d0) { kf[2 * d0] = *(const LAS bf16x8*)(kb_ + d0 * 32); kf[2 * d0 + 1] = *(const LAS bf16x8*)(kb_ + 32 * KST + d0 * 32); } } while (0)
#define ATT_QKM(P0_, P1_) do { \
        _Pragma("unroll") for (int d0 = 0; d0 < ND; ++d0) { \
            if (d0 == 0) { const f32x16 z_ = {0.f, 0.f, 0.f, 0.f, 0.f, 0.f, 0.f, 0.f, 0.f, 0.f, 0.f, 0.f, 0.f, 0.f, 0.f, 0.f}; P0_ = __builtin_amdgcn_mfma_f32_32x32x16_bf16(kf[0], qf[0], z_, 0, 0, 0); P1_ = __builtin_amdgcn_mfma_f32_32x32x16_bf16(kf[1], qf[0], z_, 0, 0, 0); } \
            else { P0_ = __builtin_amdgcn_mfma_f32_32x32x16_bf16(kf[2 * d0], qf[d0], P0_, 0, 0, 0); P1_ = __builtin_amdgcn_mfma_f32_32x32x16_bf16(kf[2 * d0 + 1], qf[d0], P1_, 0, 0, 0); } } } while (0)
#define ATT_VFRAG(dst_, nb_) do { _Pragma("unroll") for (int j_ = 0; j_ < 4; ++j_) dst_[j_] = *(const LAS u32x4*)(vb + (nb_) * 32 * VST + j_ * 32); } while (0)
    bf16x8 kf[2 * ND];
    f32x16 n0, n1;
    ATT_LOADK(0); ATT_LOADV(0); ATT_STOREK(0); ATT_STOREV(0);
    __syncthreads();
    ATT_LOADK(1); ATT_KFRAG(0); ATT_QKM(n0, n1); ATT_STOREK(1);
    __syncthreads();
    for (int tt = 0; tt < ntiles; ++tt) {
        const int cur = tt & 1;
        f32x16 p0 = n0, p1 = n1;
        if (tt + 2 < ntiles) ATT_LOADK(tt + 2);
        if (tt + 1 < ntiles) ATT_LOADV(tt + 1);
#define ATT_OUTSIDE(t_) (windowed && (t_) >= 4 && (((lt0 + (t_) - 4) * 64 - CL) > qhi_w + 128 || ((lt0 + (t_) - 4) * 64 - CL + 63) < qlo_w - 128))
        const int qlo_w = qpos0 + __builtin_amdgcn_readfirstlane(wid) * 32, qhi_w = qlo_w + 31;
        const bool skip_cur = ATT_OUTSIDE(tt), skip_next = ATT_OUTSIDE(tt + 1);
        u32x4 pw[4];
        if (!skip_cur) {
        if (windowed && tt >= 4) {
            const int kt = lt0 + tt - 4; const int kbase = kt * 64 - CL, qp = qpos0 + wid * 32 + r32;
#pragma unroll
            for (int r = 0; r < 16; ++r) { const int d0 = qp - (kbase + crow(r, hi)); if (d0 > 128 || d0 < -128) p0[r] = -1e30f; const int d1 = d0 - 32; if (d1 > 128 || d1 < -128) p1[r] = -1e30f; }
        }
        float mx = __builtin_fmaxf(__builtin_fmaxf(p0[0], p1[0]), p0[1]);
#pragma unroll
        for (int r = 1; r < 16; ++r) { if (r > 1) mx = __builtin_fmaxf(__builtin_fmaxf(mx, p0[r]), p1[r]); else mx = __builtin_fmaxf(mx, p1[1]); }
        mx = __builtin_fmaxf(mx, __shfl_xor(mx, 32)) - m;
        const bool force = (tt == 0) && !have_ref;
        if (force || __any(mx > 8.f)) {
            const float delta = force ? mx : __builtin_fmaxf(mx, 0.f);
            m += delta;
            if (!force) { const float alpha = __builtin_amdgcn_exp2f(-delta); l *= alpha;
#pragma unroll
                for (int nb = 0; nb < NO; ++nb)
#pragma unroll
                    for (int r = 0; r < 16; ++r) o[nb][r] *= alpha; }
        }
        float ls = 0.f;
#pragma unroll
        for (int r = 0; r < 16; ++r) { p0[r] = __builtin_amdgcn_exp2f(p0[r] - m); p1[r] = __builtin_amdgcn_exp2f(p1[r] - m); ls += p0[r] + p1[r]; }
        l += ls;
        pw[0] = (u32x4){pk2(p0[0], p0[1]), pk2(p0[2], p0[3]), pk2(p0[4], p0[5]), pk2(p0[6], p0[7])};
        pw[1] = (u32x4){pk2(p0[8], p0[9]), pk2(p0[10], p0[11]), pk2(p0[12], p0[13]), pk2(p0[14], p0[15])};
        pw[2] = (u32x4){pk2(p1[0], p1[1]), pk2(p1[2], p1[3]), pk2(p1[4], p1[5]), pk2(p1[6], p1[7])};
        pw[3] = (u32x4){pk2(p1[8], p1[9]), pk2(p1[10], p1[11]), pk2(p1[12], p1[13]), pk2(p1[14], p1[15])};
        SCHED_FENCE();
        }
        const LAS unsigned char* vb = Vl + cur * VBUF + r32 * VST + hi * 16;
        u32x4 vf[2][4];
        if (!skip_next) ATT_KFRAG(cur ^ 1);
        if (!skip_cur) ATT_VFRAG(vf[0], 0);
        SCHED_FENCE();
        if (!skip_next) ATT_QKM(n0, n1);
        if (!skip_cur) {
#pragma unroll
        for (int nb = 0; nb < NO; ++nb) {
            if (nb + 1 < NO) ATT_VFRAG(vf[(nb + 1) & 1], nb + 1);
            SCHED_FENCE();
#pragma unroll
            for (int j = 0; j < 4; ++j) o[nb] = __builtin_amdgcn_mfma_f32_32x32x16_bf16(__builtin_bit_cast(bf16x8, vf[nb & 1][j]), __builtin_bit_cast(bf16x8, pw[j]), o[nb], 0, 0, 0);
            SCHED_FENCE();
        }
        }
#undef ATT_OUTSIDE
        if (tt + 2 < ntiles) ATT_STOREK(cur);
        if (tt + 1 < ntiles) ATT_STOREV(cur ^ 1);
        __syncthreads();
    }
#undef SCHED_FENCE
#undef ATT_KFRAG
#undef ATT_QKM
#undef ATT_VFRAG
#undef ATT_KT
#undef ATT_LOADK
#undef ATT_LOADV
#undef ATT_STOREK
#undef ATT_STOREV
    l += __shfl_xor(l, 32);
    const float inv = 1.f / l;
    GAS bf16_t* orow = Og + (size_t)(wid * 32 + r32) * os + 4 * hi;
    if (DV == 128 && Oprev != nullptr) {
        const GAS bf16_t* prow = (const GAS bf16_t*)Oprev + (size_t)(wid * 32 + r32) * os + 4 * hi;
        const float li = lam * inv; float ss = 0.f;
#pragma unroll
        for (int nb = 0; nb < NO; ++nb)
#pragma unroll
            for (int g = 0; g < 4; ++g) { const u32x2 a = *(const GAS u32x2*)(prow + nb * 32 + 8 * g);
                const float x0 = bflo(a.x) - li * o[nb][4 * g], x1 = bfhi(a.x) - li * o[nb][4 * g + 1], x2 = bflo(a.y) - li * o[nb][4 * g + 2], x3 = bfhi(a.y) - li * o[nb][4 * g + 3];
                o[nb][4 * g] = x0; o[nb][4 * g + 1] = x1; o[nb][4 * g + 2] = x2; o[nb][4 * g + 3] = x3; ss += (x0 * x0 + x1 * x1) + (x2 * x2 + x3 * x3); }
        ss += __shfl_xor(ss, 32);
        const float rs = rsqrtf(ss * (1.f / 128.f) + 1e-6f) * om;
#pragma unroll
        for (int nb = 0; nb < NO; ++nb)
#pragma unroll
            for (int g = 0; g < 4; ++g) { const f32x4 w4 = ldg4(subw + nb * 32 + 8 * g + 4 * hi); u32x2 w;
                w.x = pk2(o[nb][4 * g] * rs * w4[0], o[nb][4 * g + 1] * rs * w4[1]); w.y = pk2(o[nb][4 * g + 2] * rs * w4[2], o[nb][4 * g + 3] * rs * w4[3]); *(GAS u32x2*)(orow + nb * 32 + 8 * g) = w; }
    } else {
#pragma unroll
    for (int nb = 0; nb < NO; ++nb)
#pragma unroll
        for (int g = 0; g < 4; ++g) { u32x2 w; w.x = pk2(o[nb][4 * g] * inv, o[nb][4 * g + 1] * inv); w.y = pk2(o[nb][4 * g + 2] * inv, o[nb][4 * g + 3] * inv); *(GAS u32x2*)(orow + nb * 32 + 8 * g) = w; }
    }
}

template <int KIND>
__device__ __forceinline__ void attn_phase(unsigned char* big, bf16_t* Abuf, const float* sinks  , const float* lamp, LAS unsigned char* lds, bool with_ctx) {
    constexpr int NHU = (KIND == 1) ? 8 : 16;
    const int NLAT = NB * NHU * 8, NU = NLAT + (with_ctx ? NB * NHU : 0);
    const int bid_ = fresh_bid(), vb_ = (bid_ & 7) * (GRID / 8) + (bid_ >> 3);
    for (int u = vb_; u < NU; u += GRID) {
        int b, head, j;
        if (u < NLAT) { j = 1 + (u & 7); head = (u >> 3) % NHU; b = (u >> 3) / NHU; } else { const int v = u - NLAT; j = 0; head = v % NHU; b = v / NHU; }
        const size_t row0 = (size_t)b * TB + j * 256;
        int lt0 = 4, lt1 = 4; const int qpos0 = (j - 1) * 256;
        if (j > 0) { if (KIND == 0) { int lo = qpos0 - 128; if (lo < 0) lo = 0; int hi = qpos0 + 255 + 128; if (hi > SQ - 1) hi = SQ - 1; lt0 = 4 + lo / 64; lt1 = 4 + hi / 64 + 1; } else { lt0 = 4; lt1 = 36; } }
        if (KIND == 0) {
            const bf16_t* Q = (const bf16_t*)big; const bf16_t* K = (const bf16_t*)(big + U72); const bf16_t* Vt = (const bf16_t*)(big + U72 + 18 * MiB);
            const float sink = sinks[head] * LOG2E;
            attn_unit<64, 64>(lds, Q + row0 * 1024 + head * 64, 1024, K + (size_t)b * TB * 256 + (head >> 2) * 64, 256, Vt + (size_t)(b * 4 + (head >> 2)) * 64 * TB,
                              Abuf + row0 * 1024 + head * 64, 1024, lt0, lt1, true, qpos0, sink, 1.f);
        } else if (KIND == 1) {
            const bf16_t* Q = (const bf16_t*)big; const bf16_t* K = (const bf16_t*)(big + U72); const bf16_t* Vt = (const bf16_t*)(big + 2 * U72); bf16_t* Otmp = (bf16_t*)(big + 3 * U72);
            const float lam = lamp[0], om = 1.f - lamp[1];
            attn_unit<64, 128>(lds, Q + row0 * 1024 + (2 * head) * 64, 1024, K + (size_t)b * TB * 1024 + (2 * head) * 64, 1024, Vt + (size_t)(b * 8 + head) * 128 * TB,
                               Otmp + row0 * 1024 + head * 128, 1024, lt0, lt1, false, qpos0, -1e30f, 0.f);
            attn_unit<64, 128>(lds, Q + row0 * 1024 + (2 * head + 1) * 64, 1024, K + (size_t)b * TB * 1024 + (2 * head + 1) * 64, 1024, Vt + (size_t)(b * 8 + head) * 128 * TB,
                               Abuf + row0 * 1024 + head * 128, 1024, lt0, lt1, false, qpos0, -1e30f, 0.f, Otmp + row0 * 1024 + head * 128, lam, om, sinks);
        } else {
            const bf16_t* Vt = (const bf16_t*)big; const bf16_t* Q = (const bf16_t*)(big + 2 * U72); const bf16_t* K = (const bf16_t*)(big + 2 * U72 + 108 * MiB);
            attn_unit<96, 64>(lds, Q + row0 * 1536 + head * 96, 1536, K + (size_t)b * TB * 1536 + head * 96, 1536, Vt + (size_t)(b * 16 + head) * 64 * TB,
                              Abuf + row0 * 1024 + head * 64, 1024, lt0, lt1, false, qpos0, -1e30f, 0.f);
        }
    }
}

__device__ __forceinline__ void hgrn_scan(unsigned char* big, bf16_t* OF, bf16_t* OB, LAS unsigned char* lds) {
    constexpr int GST = 132;
    constexpr int O_G = 0, O_QT = 34816, O_KT = O_QT + 17408, O_KTT = O_KT + 17408, O_VT = O_KTT + 18432, O_AB = O_VT + 18432, O_SEG = O_AB + 9216, O_GM = O_SEG + 2048, O_GL = O_GM + 512;
    const bf16_t* Qh = (const bf16_t*)big; const bf16_t* Vv = (const bf16_t*)(big + 3 * U72);
    const int tid = fresh_tid(), lane = tid & 63, r32 = lane & 31, hi = lane >> 5, wid = tid >> 6;
    LAS float* Gs = (LAS float*)(lds + O_G); LAS unsigned char* STb = lds + O_G;
    LAS unsigned char* QTb = lds + O_QT; LAS unsigned char* KTb = lds + O_KT; LAS unsigned short* KTT = (LAS unsigned short*)(lds + O_KTT); LAS unsigned short* VT = (LAS unsigned short*)(lds + O_VT);
    LAS unsigned short* AB = (LAS unsigned short*)(lds + O_AB); LAS float* SEG = (LAS float*)(lds + O_SEG); LAS float* GM = (LAS float*)(lds + O_GM); LAS float* GL = (LAS float*)(lds + O_GL);
    for (int u = fresh_bid(); u < 256; u += fresh_gdim()) {
        const int dir = u & 1, h = (u >> 1) & 7, b = u >> 4;
        const unsigned short* LFd = (const unsigned short*)(big + (dir == 0 ? U72 : 2 * U72));
        bf16_t* Od = dir == 0 ? OF : OB;
        f32x16 S[2];
#pragma unroll
        for (int nb = 0; nb < 2; ++nb)
#pragma unroll
            for (int r = 0; r < 16; ++r) S[nb][r] = 0.f;
        const int db = wid >> 1, eh = wid & 1, ti = wid >> 2, ei = wid & 3;
        u32x4 q8[2], lf8[2], v8[2];
#define HG_TOK(ci_, tp_) ((size_t)b * TB + (size_t)((dir == 0) ? (ci_) : ((ci_) < 4 ? 3 - (ci_) : 39 - (ci_))) * 64 + ((dir == 0) ? (tp_) : 63 - (tp_)))
#define HG_LOAD(ci_) do { _Pragma("unroll") for (int i_ = 0; i_ < 2; ++i_) { const int ch_ = tid + NTHR * i_; const int tp_ = ch_ & 63, dc_ = ch_ >> 6; const size_t o_ = HG_TOK(ci_, tp_) * 1024 + h * 128 + dc_ * 8; \
            q8[i_] = *(const GAS u32x4*)((const GAS bf16_t*)Qh + o_); lf8[i_] = *(const GAS u32x4*)((const GAS unsigned short*)LFd + o_); v8[i_] = *(const GAS u32x4*)((const GAS bf16_t*)Vv + o_); } } while (0)
        HG_LOAD(0);
        for (int ci = 0; ci < 36; ++ci) {
#pragma unroll
            for (int i = 0; i < 2; ++i) { const int ch = tid + NTHR * i, tp = ch & 63, dc = ch >> 6; LAS float* g = Gs + tp * GST + dc * 8;
#pragma unroll
                for (int k = 0; k < 4; ++k) { g[2 * k] = h2f((unsigned short)(lf8[i][k] & 0xffffu)); g[2 * k + 1] = h2f((unsigned short)(lf8[i][k] >> 16)); } }
            __syncthreads();
            { const int d = tid & 127, seg = tid >> 7; float run = 0.f;
#pragma unroll
              for (int t = 0; t < 16; ++t) { LAS float* g = Gs + (seg * 16 + t) * GST + d; run += *g; *g = run; }
              SEG[seg * 128 + d] = run; }
            __syncthreads();
#pragma unroll
            for (int i = 0; i < 2; ++i) { const int ch = tid + NTHR * i, tp = ch & 63, dc = ch >> 6, seg = tp >> 4;
                float qt[8], kt[8];
#pragma unroll
                for (int k = 0; k < 8; ++k) { const int d = dc * 8 + k; const float s0 = SEG[d], s1 = SEG[128 + d], s2 = SEG[256 + d];
                    const float off = (seg > 0 ? s0 : 0.f) + (seg > 1 ? s1 : 0.f) + (seg > 2 ? s2 : 0.f);
                    const float g = Gs[tp * GST + d] + off, gm = s0 + s1 + Gs[32 * GST + d];
                    const unsigned lw = lf8[i][k >> 1], qw = q8[i][k >> 1], vw = v8[i][k >> 1];
                    const float lf = h2f((unsigned short)((k & 1) ? (lw >> 16) : (lw & 0xffffu)));
                    const float qv = (k & 1) ? bfhi(qw) : bflo(qw);
                    const float kk = 1.f - __expf(lf);
                    qt[k] = qv * __expf(g - gm); kt[k] = kk * __expf(gm - g);
                    KTT[d * 72 + tp] = f2bf(kt[k]); VT[d * 72 + tp] = (unsigned short)((k & 1) ? (vw >> 16) : (vw & 0xffffu)); }
                *(LAS u32x4*)(QTb + tp * 272 + dc * 16) = (u32x4){pk2(qt[0], qt[1]), pk2(qt[2], qt[3]), pk2(qt[4], qt[5]), pk2(qt[6], qt[7])};
                *(LAS u32x4*)(KTb + tp * 272 + dc * 16) = (u32x4){pk2(kt[0], kt[1]), pk2(kt[2], kt[3]), pk2(kt[4], kt[5]), pk2(kt[6], kt[7])}; }
            if (tid < 128) { const float s0 = SEG[tid], s1 = SEG[128 + tid], s2 = SEG[256 + tid], s3 = SEG[384 + tid]; GM[tid] = s0 + s1 + Gs[32 * GST + tid]; GL[tid] = (s0 + s1) + (s2 + s3); }
            if (ci + 1 < 36) HG_LOAD(ci + 1);
            __syncthreads();
#pragma unroll
            for (int nb = 0; nb < 2; ++nb)
#pragma unroll
                for (int g4 = 0; g4 < 4; ++g4) { const int d0 = 32 * db + 8 * g4 + 4 * hi; const f32x4 gm4 = *(const LAS f32x4*)(GM + d0);
#pragma unroll
                    for (int k = 0; k < 4; ++k) S[nb][4 * g4 + k] *= __expf(gm4[k]);
                    *(LAS u32x2*)(STb + (64 * eh + 32 * nb + r32) * 272 + d0 * 2) = (u32x2){pk2(S[nb][4 * g4], S[nb][4 * g4 + 1]), pk2(S[nb][4 * g4 + 2], S[nb][4 * g4 + 3])}; }
            __syncthreads();
            f32x16 o;
#pragma unroll
            for (int r = 0; r < 16; ++r) o[r] = 0.f;
#pragma unroll
            for (int kk = 0; kk < 8; ++kk) { const bf16x8 a = *(const LAS bf16x8*)(QTb + (32 * ti + r32) * 272 + kk * 32 + hi * 16), bb = *(const LAS bf16x8*)(STb + (32 * ei + r32) * 272 + kk * 32 + hi * 16);
                o = __builtin_amdgcn_mfma_f32_32x32x16_bf16(a, bb, o, 0, 0, 0); }
            if (wid < 4) { const int ti2 = wid >> 1, si = wid & 1; f32x16 a2;
#pragma unroll
                for (int r = 0; r < 16; ++r) a2[r] = 0.f;
#pragma unroll
                for (int kk = 0; kk < 8; ++kk) { const bf16x8 a = *(const LAS bf16x8*)(QTb + (32 * ti2 + r32) * 272 + kk * 32 + hi * 16), bb = *(const LAS bf16x8*)(KTb + (32 * si + r32) * 272 + kk * 32 + hi * 16);
                    a2 = __builtin_amdgcn_mfma_f32_32x32x16_bf16(a, bb, a2, 0, 0, 0); }
#pragma unroll
                for (int r = 0; r < 16; ++r) { const int t = 32 * ti2 + crow(r, hi), s = 32 * si + r32; AB[t * 72 + s] = (t >= s) ? f2bf(a2[r]) : (unsigned short)0; } }
            __syncthreads();
#pragma unroll
            for (int kk = 0; kk < 4; ++kk) { const bf16x8 a = *(const LAS bf16x8*)((LAS unsigned char*)AB + (32 * ti + r32) * 144 + kk * 32 + hi * 16), bb = *(const LAS bf16x8*)((LAS unsigned char*)VT + (32 * ei + r32) * 144 + kk * 32 + hi * 16);
                o = __builtin_amdgcn_mfma_f32_32x32x16_bf16(a, bb, o, 0, 0, 0); }
#pragma unroll
            for (int r = 0; r < 16; ++r) { const int t = 32 * ti + crow(r, hi); ((GAS bf16_t*)Od)[HG_TOK(ci, t) * 1024 + h * 128 + 32 * ei + r32] = f2bf(o[r]); }
#pragma unroll
            for (int nb = 0; nb < 2; ++nb)
#pragma unroll
                for (int kk = 0; kk < 4; ++kk) { const bf16x8 a = *(const LAS bf16x8*)((LAS unsigned char*)KTT + (32 * db + r32) * 144 + kk * 32 + hi * 16), bb = *(const LAS bf16x8*)((LAS unsigned char*)VT + (64 * eh + 32 * nb + r32) * 144 + kk * 32 + hi * 16);
                    S[nb] = __builtin_amdgcn_mfma_f32_32x32x16_bf16(a, bb, S[nb], 0, 0, 0); }
#pragma unroll
            for (int g4 = 0; g4 < 4; ++g4) { const int d0 = 32 * db + 8 * g4 + 4 * hi; const f32x4 gm4 = *(const LAS f32x4*)(GM + d0), gl4 = *(const LAS f32x4*)(GL + d0);
#pragma unroll
                for (int k = 0; k < 4; ++k) { const float sc = __expf(gl4[k] - gm4[k]); S[0][4 * g4 + k] *= sc; S[1][4 * g4 + k] *= sc; } }
            __syncthreads();
        }
#undef HG_LOAD
#undef HG_TOK
    }
}


#define XB_TMO      128
#define XB_XCNT(j)  (256  + 64 * (j))
#define XB_XSUB(j)  (1280 + 64 * (j))
#define XB_XGEN(j)  (2304 + 64 * (j))
#define XB_TOP      3328
#define XB_TOPGEN   3392
#define XCD_BAR_WORDS 3456
#define XB_SPIN_CAP (1u << 18)

__device__ __forceinline__ unsigned xb_ld(unsigned* p)              { return __hip_atomic_load(p, __ATOMIC_RELAXED, __HIP_MEMORY_SCOPE_AGENT); }
__device__ __forceinline__ unsigned xb_add(unsigned* p, unsigned v) { return __hip_atomic_fetch_add(p, v, __ATOMIC_RELAXED, __HIP_MEMORY_SCOPE_AGENT); }
__device__ __forceinline__ unsigned xb_xcc_id() { return (unsigned)__builtin_amdgcn_s_getreg((3 << 11) | 20) & 0xFu; }
#define XB_SPIN(cond, bar) do { unsigned _sp = 0; while (cond) { __builtin_amdgcn_s_sleep(1); \
    if ((++_sp & 255u) == 0u) { if (xb_ld(&(bar)[XB_TMO])) break; if (_sp > XB_SPIN_CAP) { atomicAdd(&(bar)[XB_TMO], 1u); break; } } } } while (0)

struct XcdBarrier {
    unsigned* bar; unsigned x;
    volatile LAS unsigned* st;
};

__device__ __forceinline__ XcdBarrier xcd_barrier_post(unsigned* bar, volatile LAS unsigned* st) {
    XcdBarrier b; b.bar = bar; b.x = xb_xcc_id(); b.st = st;
    if (threadIdx.x == 0) (void)xb_add(&bar[XB_XCNT(b.x)], 1u);
    return b;
}
__device__ __forceinline__ void xcd_barrier_complete(unsigned* bar, unsigned x, unsigned& nloc, unsigned& nx) {
    const unsigned G = gridDim.x * gridDim.y * gridDim.z;
    unsigned sum, cnt, mine, sp = 0u;
    for (;;) {
        sum = 0u; cnt = 0u; mine = 0u;
#pragma unroll
        for (unsigned j = 0; j < 16; ++j) { const unsigned c = xb_ld(&bar[XB_XCNT(j)]); sum += c; cnt += (c > 0u) ? 1u : 0u; mine = (j == x) ? c : mine; }
        if (sum == G) break;
        __builtin_amdgcn_s_sleep(1);
        if ((++sp & 255u) == 0u) { if (xb_ld(&bar[XB_TMO])) break; if (sp > XB_SPIN_CAP) { atomicAdd(&bar[XB_TMO], 1u); break; } }
    }
    nloc = mine > 0u ? mine : 1u; nx = cnt > 0u ? cnt : 1u;
}

__device__ __forceinline__ void xcd_barrier(const XcdBarrier& b) {
    asm volatile("s_waitcnt vmcnt(0)" ::: "memory");
    __syncthreads();
    if (threadIdx.x == 0) {
        unsigned* bar = b.bar;
        __builtin_amdgcn_s_waitcnt(0);
        unsigned nloc = b.st[0], nx = b.st[1];
        if (nloc == 0u) { xcd_barrier_complete(bar, b.x, nloc, nx); b.st[0] = nloc; b.st[1] = nx; }
        const unsigned old = xb_add(&bar[XB_XSUB(b.x)], 1u);
        const unsigned gen = old / nloc;
        if (old + 1u == (gen + 1u) * nloc) {
            __builtin_amdgcn_fence(__ATOMIC_RELEASE, "agent");
            asm volatile("s_waitcnt vmcnt(0)" ::: "memory");
            const unsigned og = xb_add(&bar[XB_TOP], 1u);
            const unsigned tg = og / nx;
            if (og + 1u == (tg + 1u) * nx) xb_add(&bar[XB_TOPGEN], 1u);
            else XB_SPIN(xb_ld(&bar[XB_TOPGEN]) == tg, bar);
            __builtin_amdgcn_fence(__ATOMIC_ACQUIRE, "agent");
            xb_add(&bar[XB_XGEN(b.x)], 1u);
            asm volatile("s_waitcnt vmcnt(0)" ::: "memory");
        } else {
            XB_SPIN(xb_ld(&bar[XB_XGEN(b.x)]) == gen, bar);
            __builtin_amdgcn_fence(__ATOMIC_ACQUIRE, "agent");
            asm volatile("s_waitcnt vmcnt(0)" ::: "memory");
        }
    }
    __syncthreads();
}

enum { K_X = 0, K_C, K_CTX, K_CCTX, K_ADAW, K_ADAB, K_NORMW, K_FNORMW, K_FFNG, K_FFNU, K_FFND, K_GQAIN, K_GQAOUT, K_GQASINK, K_DIFFIN, K_DIFFOUT, K_DIFFLAM, K_DIFFSUB,
       K_HGRNIN, K_HGRNOUT, K_HGRNNORM, K_HGRNLB, K_MLADOWN, K_MLAQN, K_MLAKVN, K_MLAUQ, K_MLAUKV, K_MLAOUT, K_OUT, K_WS };
__device__ __forceinline__ const float* karg_ptr(int idx) {
    const __attribute__((address_space(4))) unsigned long long* ka = (const __attribute__((address_space(4))) unsigned long long*)__builtin_amdgcn_kernarg_segment_ptr();
    int i = idx; asm volatile("" : "+s"(i));
    return (const float*)ka[i];
}
__device__ __forceinline__ Params load_params() {
    Params q;
    const float** qq = (const float**)&q;
#pragma unroll
    for (int i = 0; i < 30; ++i) qq[i] = karg_ptr(i);
    q.ph_lo = 0; q.ph_hi = 0;
    return q;
}
__global__ void __launch_bounds__(NTHR, 2) fwd_megakernel(Params p) {
    extern __shared__ __attribute__((aligned(16))) unsigned char lds_raw[];
    LAS unsigned char* lds = (LAS unsigned char*)lds_raw;
    cg::grid_group grid = cg::this_grid();
    const int ph_lo = p.ph_lo, ph_hi = p.ph_hi;
    volatile LAS unsigned* bst = (volatile LAS unsigned*)(lds + LDS_BYTES - 64);
    if (threadIdx.x < 2) bst[threadIdx.x] = 0u;
    __syncthreads();
    XcdBarrier bar = xcd_barrier_post((unsigned*)((unsigned char*)karg_ptr(K_WS) + WS_BAR), bst);
    int nsync = 0;
#define GRID_SYNC() do { xcd_barrier(bar); ++nsync; } while (0)
    if (ph_lo < 0) grid.sync();
    int ph = 0;
#ifndef PH_MASK
#define PH_MASK 0xffffffffu
#endif
#define COMP(k) (((PH_MASK) >> (k)) & 1u)
#ifndef DUP_MASK
#define DUP_MASK 0u
#endif
#define NREP(k) (1 + (int)(((DUP_MASK) >> (k)) & 1u))
#define PHASE_BEGIN(k) if (ph >= ph_lo && ph < ph_hi) { unsigned char* dout = (unsigned char*)karg_ptr(K_OUT); unsigned char* ws = (unsigned char*)karg_ptr(K_WS); \
        unsigned char* big = ws + WS_BIG; float* HX = (float*)(ws + WS_HX); const float* mod = (const float*)(ws + WS_MOD); bf16_t* Abuf = (bf16_t*)(dout + DO_A); \
        const float* modl = mod + (size_t)layer * 17 * NMODV; (void)big; (void)HX; (void)modl; (void)Abuf; \
        for (int rep_ = 0; rep_ < NREP(k); ++rep_) { if (rep_) GRID_SYNC();
#define PHASE_END   } if (ph + 1 < ph_hi) GRID_SYNC(); } ++ph;
    int layer = 0;
    PHASE_BEGIN(0) if (COMP(0)) { const Params q = load_params(); prologue(q, lds); } PHASE_END
#pragma unroll 1
    for (layer = 0; layer < 4; ++layer) {
        const bool with_ctx = layer < 3;
        PHASE_BEGIN(1) if (COMP(1)) { { const Params q = load_params(); convert_weights(q, layer, lds, dout); } __syncthreads(); norm_phase(HX, karg_ptr(K_NORMW) + (size_t)layer * 3 * DM, modl, 0, 1, Abuf, (layer > 0 && rep_ == 0) ? (const float*)(big + 200 * MiB) : nullptr, false, layer == 0 ? karg_ptr(K_X) : nullptr, layer == 0 ? karg_ptr(K_CTX) : nullptr); } PHASE_END
        PHASE_BEGIN(2) if (COMP(2)) { EpiSwiglu E{(bf16_t*)big}; run_gemm(lds, Abuf, (const bf16_t*)(dout + W_F1GU), 2 * FF, DM, E); } PHASE_END
        PHASE_BEGIN(3) if (COMP(3)) { EpiResid E{HX, modl, 2, rep_ + 1 < NREP(3) ? 0.f : 0.5f, (float*)(big + 200 * MiB)}; run_gemm(lds, (const bf16_t*)big, (const bf16_t*)(dout + W_F1D), DM, FF, E, true, false); } PHASE_END
        PHASE_BEGIN(1) if (COMP(1)) norm_phase(HX, karg_ptr(K_NORMW) + (size_t)layer * 3 * DM + DM, modl, 3, 4, Abuf, rep_ == 0 ? (const float*)(big + 200 * MiB) : nullptr); PHASE_END
        if (layer == 0) {
            PHASE_BEGIN(4) if (COMP(4)) { EpiGqaIn E{(bf16_t*)big, (bf16_t*)(big + U72), (bf16_t*)(big + U72 + 18 * MiB), (const float*)(ws + WS_ROPEH)}; run_gemm(lds, Abuf, (const bf16_t*)(dout + W_MIN), 1536, DM, E); } PHASE_END
            PHASE_BEGIN(5) if (COMP(5)) attn_phase<0>(big, Abuf, karg_ptr(K_GQASINK), nullptr, lds, true); PHASE_END
        } else if (layer == 1) {
            PHASE_BEGIN(6) if (COMP(6)) { EpiDiffIn E{(bf16_t*)big, (bf16_t*)(big + U72), (bf16_t*)(big + 2 * U72), (const float*)(ws + WS_ROPEH)}; run_gemm(lds, Abuf, (const bf16_t*)(dout + W_MIN), 3072, DM, E); } PHASE_END
            PHASE_BEGIN(7) if (COMP(7)) attn_phase<1>(big, Abuf, karg_ptr(K_DIFFSUB), (const float*)(ws + WS_LAM), lds, true); PHASE_END
        } else if (layer == 2) {
            PHASE_BEGIN(9) if (COMP(9)) { EpiHgrnIn E{(bf16_t*)big, (unsigned short*)(big + U72), (unsigned short*)(big + 2 * U72), (bf16_t*)(big + 3 * U72), (bf16_t*)(big + 4 * U72), (const float*)(ws + WS_LB)};
                          run_gemm(lds, Abuf, (const bf16_t*)(dout + W_MIN), 5120, DM, E); } PHASE_END
            PHASE_BEGIN(10) if (COMP(10)) hgrn_scan(big, (bf16_t*)(ws + WS_END), Abuf, lds); PHASE_END
            PHASE_BEGIN(11) if (COMP(11)) hgrn_combine((const bf16_t*)(ws + WS_END), Abuf, (const bf16_t*)(big + 4 * U72), karg_ptr(K_HGRNNORM), Abuf); PHASE_END
        } else {
            PHASE_BEGIN(12) if (COMP(12)) { EpiF32 E{(float*)big, 768}; run_gemm(lds, Abuf, (const bf16_t*)(dout + W_MIN), 768, DM, E); } PHASE_END
            PHASE_BEGIN(13) if (COMP(13)) mla_rows((const float*)big, karg_ptr(K_MLAQN), karg_ptr(K_MLAKVN), (const float*)(ws + WS_ROPEM), (bf16_t*)(big + 108 * MiB), (bf16_t*)(big + 126 * MiB), (bf16_t*)(big + 2 * U72 + 108 * MiB)); PHASE_END
            PHASE_BEGIN(14) if (COMP(14)) { EpiMlaUq E1{(bf16_t*)(big + 2 * U72), (const float*)(ws + WS_ROPEM)}; run_gemm(lds, (const bf16_t*)(big + 108 * MiB), (const bf16_t*)(dout + W_UQ), 1536, 256, E1);
                          EpiMlaUkv E2{(bf16_t*)(big + 2 * U72 + 108 * MiB), (bf16_t*)big}; run_gemm(lds, (const bf16_t*)(big + 126 * MiB), (const bf16_t*)(dout + W_UKV), 2048, 256, E2); } PHASE_END
            PHASE_BEGIN(15) if (COMP(15)) attn_phase<3>(big, Abuf, karg_ptr(K_GQASINK), nullptr, lds, false); PHASE_END
        }
        PHASE_BEGIN(3) if (COMP(3)) { EpiResid E{HX, modl, 5, rep_ + 1 < NREP(3) ? 0.f : 1.0f, (float*)(big + 200 * MiB)}; run_gemm(lds, Abuf, (const bf16_t*)(dout + W_MOUT), DM, DM, E, true, layer == 3); } PHASE_END
        PHASE_BEGIN(1) if (COMP(1)) norm_phase(HX, karg_ptr(K_NORMW) + (size_t)layer * 3 * DM + 2 * DM, modl, 6, 7, Abuf, (layer < 3 && rep_ == 0) ? (const float*)(big + 200 * MiB) : nullptr, layer == 3); PHASE_END
        PHASE_BEGIN(2) if (COMP(2)) { EpiSwiglu E{(bf16_t*)big}; run_gemm(lds, Abuf, (const bf16_t*)(dout + W_F2GU), 2 * FF, DM, E, false, layer == 3); } PHASE_END
        PHASE_BEGIN(3) if (COMP(3)) { EpiResid E{HX, modl, 8, rep_ + 1 < NREP(3) ? 0.f : 0.5f, (float*)(big + 200 * MiB)}; run_gemm(lds, (const bf16_t*)big, (const bf16_t*)(dout + W_F2D), DM, FF, E, true, layer == 3); } PHASE_END
    }
    layer = 0;
    if (NREP(17) > 1) { for (int i = 0; i < 20; ++i) GRID_SYNC(); }
    PHASE_BEGIN(16) if (COMP(16)) final_phase(HX, karg_ptr(K_FNORMW), (float*)dout); PHASE_END
#undef PHASE_BEGIN
#undef PHASE_END
}

#ifndef MK_MULTI
#define MK_MULTI 0
#endif
constexpr int N_PHASES = 1 + (10 + 10 + 11 + 12) + 1;

extern "C" void kernel_launch(void* const* d_in, const int* in_sizes, int n_in, void* d_out, int out_size, void* d_ws, size_t ws_size, hipStream_t stream) {
    static int grid = 0;
    if (grid == 0) {
        if (n_in != 28 || ws_size < WS_END + U72 || out_size != NB * SQ * DM) { fprintf(stderr, "kernel_launch: unexpected sizes n_in %d out %d ws %zu\n", n_in, out_size, ws_size); grid = -1; return; }
        int dev = 0, cus = 0, per_cu = 0;
        hipGetDevice(&dev); hipDeviceGetAttribute(&cus, hipDeviceAttributeMultiprocessorCount, dev);
        if (hipFuncSetAttribute((const void*)fwd_megakernel, hipFuncAttributeMaxDynamicSharedMemorySize, LDS_BYTES) != hipSuccess) { fprintf(stderr, "kernel_launch: hipFuncSetAttribute failed\n"); grid = -1; return; }
        if (hipOccupancyMaxActiveBlocksPerMultiprocessor(&per_cu, (const void*)fwd_megakernel, NTHR, LDS_BYTES) != hipSuccess || per_cu < 1) { fprintf(stderr, "kernel_launch: occupancy query says %d\n", per_cu); per_cu = 1; }
        (void)hipGetLastError();
        grid = cus * (per_cu > 1 ? 1 : per_cu);
        if (grid != GRID) { fprintf(stderr, "kernel_launch: this kernel is built for a %d-workgroup cooperative grid (one per CU), device offers %d\n", GRID, grid); grid = -1; return; }
    }
    if (grid < 0) return;
    if (hipMemsetAsync((char*)d_ws + WS_BAR, 0, XCD_BAR_WORDS * 4, stream) != hipSuccess) { fprintf(stderr, "kernel_launch: memset failed\n"); return; }
    Params p{};
    const float** pp = (const float**)&p;
    for (int i = 0; i < 28; ++i) pp[i] = (const float*)d_in[i];
    p.out = (float*)d_out; p.ws = (unsigned char*)d_ws;
#if MK_MULTI
    for (int ph = 0; ph < N_PHASES; ++ph) { p.ph_lo = ph; p.ph_hi = ph + 1; hipLaunchKernelGGL(fwd_megakernel, dim3(grid), dim3(NTHR), LDS_BYTES, stream, p); }
#else
    p.ph_lo = 0; p.ph_hi = N_PHASES;
    void* args[] = {&p};
    hipError_t e = hipLaunchCooperativeKernel((const void*)fwd_megakernel, dim3(grid), dim3(NTHR), args, LDS_BYTES, stream);
    if (e != hipSuccess) fprintf(stderr, "cooperative launch failed: %s (grid %d)\n", hipGetErrorString(e), grid);
#endif
}
```

```cpp
#include <hip/hip_runtime.h>
#include <hip/hip_cooperative_groups.h>
#include <cstdio>
#include <cstdint>
namespace cg = cooperative_groups;
namespace pg8 {
#define PG8_LAS __attribute__((address_space(3)))
typedef unsigned short bf16_t;
typedef short bf16x8 __attribute__((ext_vector_type(8)));
typedef float f32x4 __attribute__((ext_vector_type(4)));
typedef unsigned u32x4 __attribute__((ext_vector_type(4)));
constexpr int BM = 256, BK = 64, HALF = 128, HTB = HALF * BK * 2  , STAGE_BYTES = 8 * HTB, NXCD = 8, WGM = 8;

__host__ __device__ __forceinline__ int lds_byte(int r, int c) { const int st = (r >> 4) * 2 + (c >> 5), rr = r & 15, cc = c & 31, ob = rr * 64 + cc * 2; return st * 1024 + (ob ^ (((ob >> 9) & 1) << 5)); }
__host__ __device__ __forceinline__ void stage_rc(int b, int& R, int& C) { const int st = b / 1024, sb = b % 1024, swz = sb ^ (((sb >> 9) & 1) << 5); R = (st >> 1) * 16 + swz / 64; C = (st & 1) * 32 + (swz % 64) / 2; }
__host__ __device__ __forceinline__ int perm32(int rho) { const int n = rho >> 4, i = rho & 15; return 8 * (i >> 2) + 4 * n + (i & 3); }

struct Unit { int pm, pn, k0, nk, part; };
struct Gemm { const bf16_t* A; const bf16_t* Bt; int M, N, K; };

struct StaticOrder {
    int nN, nwg, G, c, nt, nfull, S, nMf; bool lat;
    __host__ __device__ void init(int M, int N, int G_, int c_, int nt_, bool split, bool lat_) {
        const int nM = M / BM; nN = N / BM; nwg = nM * nN; G = G_; c = c_; nt = nt_; lat = lat_; nfull = nwg; S = 1;
        if (split) { const int rem = nwg % G; if (rem > 0 && rem * 2 <= G && ((nwg - rem) % nN) == 0) { S = G / rem; if (S > 4) S = 4; if (S > nt / 2) S = nt / 2; nfull = nwg - rem; } }
        nMf = nfull / nN;
    }
    __host__ __device__ bool next(int i, Unit& u) const {
        const long L = (long)i * G + c;
        int pm, pn, k0 = 0, nk = nt, part = -1; bool ok = true;
        if (L < nfull) {
            int wgid = (int)L;
            { const int q = nfull / NXCD, r = nfull % NXCD, xcd = wgid % NXCD, off = wgid / NXCD; wgid = (xcd < r ? xcd * (q + 1) : r * (q + 1) + (xcd - r) * q) + off; }
            const int nig = WGM * nN, gid = wgid / nig, fm = gid * WGM, gsz = (nMf - fm) < WGM ? (nMf - fm) : WGM;
            pm = fm + ((wgid % nig) % gsz); pn = (wgid % nig) / gsz;
        } else {
            const long q = L - nfull; const int t = (int)(q / S); part = (int)(q % S); ok = (nfull + t < nwg);
            pm = nMf + t / nN; pn = t % nN;
            const int pairs = nt / 2, base = pairs / S, extra = pairs % S; const int p0 = part * base + (part < extra ? part : extra), np = base + (part < extra ? 1 : 0); k0 = 2 * p0; nk = 2 * np;
        }
        if (lat) pm = (pm >> 3) * 9 + 1 + (pm & 7);
        u.pm = pm; u.pn = pn; u.k0 = k0; u.nk = nk; u.part = part;
        return ok;
    }
    __device__ __forceinline__ void a_ready(const Unit&) const {}
    __device__ __forceinline__ void done(const Unit&) const {}
};
template <class Epi, class Sched, bool ALIGN_EPI = false, bool SP2 = false>
__device__ __forceinline__ void gemm_phase(PG8_LAS unsigned char* lds, const Gemm g, const Sched& S, const Epi& E) {
    int tid_ = threadIdx.x; asm volatile("" : "+v"(tid_));
    const int tid = tid_, wid = __builtin_amdgcn_readfirstlane(tid >> 6), lane = tid & 63, wr = wid >> 2, wc = wid & 3, fr = lane & 15, fq = lane >> 4;
    const int K = g.K;
    unsigned voffA[2], voffB[2];
#pragma unroll
    for (int i = 0; i < 2; ++i) { int R, C; stage_rc(tid * 16 + i * 8192, R, C); const int Rb = Epi::PERM ? ((R & ~31) + perm32(R & 31)) : R;
        voffA[i] = (unsigned)(R * K + C) * 2u; voffB[i] = (unsigned)(Rb * K + C) * 2u; }
    const size_t kstep = (size_t)(BK * 2);
    const size_t hstep = (size_t)HALF * K * 2;
    const size_t tstep = 2 * hstep;
    const unsigned ldsw = (unsigned)wid * 1024u;
    const int aoff = lds_byte(wr * 64 + fr, fq * 8), boff = lds_byte(wc * 32 + fr, fq * 8);
#define PG8_SA(b, h) (((b) * 2 + (h)) * HTB)
#define PG8_SB(b, h) ((4 + (b) * 2 + (h)) * HTB)
#define PG8_STAGE(bufoff, gbase, voff) do { _Pragma("unroll") for (int _i = 0; _i < 2; ++_i) \
        __builtin_amdgcn_global_load_lds((const unsigned*)((const char*)(gbase) + (voff)[_i]), (PG8_LAS unsigned*)(lds + (bufoff) + ldsw + _i * 8192), 16, 0, 0); } while (0)
#define PG8_LDA(dst, b, h) do { _Pragma("unroll") for (int m = 0; m < 4; ++m) _Pragma("unroll") for (int k = 0; k < 2; ++k) dst[m][k] = *(const PG8_LAS bf16x8*)(lds + PG8_SA(b, h) + aoff + m * 2048 + k * 1024); } while (0)
#define PG8_LDB(dst, b, h) do { _Pragma("unroll") for (int n = 0; n < 2; ++n) _Pragma("unroll") for (int k = 0; k < 2; ++k) dst[n][k] = *(const PG8_LAS bf16x8*)(lds + PG8_SB(b, h) + boff + n * 2048 + k * 1024); } while (0)
#define PG8_MMA(ai, bj, At, Bt) do { __builtin_amdgcn_s_setprio(1); _Pragma("unroll") for (int m = 0; m < 4; ++m) _Pragma("unroll") for (int n = 0; n < 2; ++n) _Pragma("unroll") for (int k = 0; k < 2; ++k) \
        acc[ai][bj][m][n] = __builtin_amdgcn_mfma_f32_16x16x32_bf16(Bt[n][k], At[m][k], acc[ai][bj][m][n], 0, 0, 0); __builtin_amdgcn_s_setprio(0); } while (0)
#define PG8_WAIT_V(n) asm volatile("s_waitcnt vmcnt(" #n ")" ::: "memory")
#define PG8_WAIT_L(n) asm volatile("s_waitcnt lgkmcnt(" #n ")" ::: "memory")
#define PG8_BAR __builtin_amdgcn_s_barrier()
#define PG8_SCHED __builtin_amdgcn_sched_barrier(0)
    Unit cur, nxt; int ui = 0;
    if (!S.next(0, cur)) return;
    f32x4 acc[2][2][4][2];
#pragma unroll
    for (int a = 0; a < 2; ++a)
#pragma unroll
        for (int b = 0; b < 2; ++b)
#pragma unroll
            for (int m = 0; m < 4; ++m)
#pragma unroll
                for (int n = 0; n < 2; ++n) acc[a][b][m][n] = (f32x4){0.f, 0.f, 0.f, 0.f};
    bf16x8 At[4][2], B0[2][2], B1[2][2];
    const char* cA = (const char*)g.A + (size_t)cur.pm * tstep + (size_t)cur.k0 * kstep; const char* cB = (const char*)g.Bt + (size_t)cur.pn * tstep + (size_t)cur.k0 * kstep;
    S.a_ready(cur);
    if constexpr (SP2) {
        PG8_STAGE(PG8_SB(0, 0), cB, voffB); PG8_STAGE(PG8_SB(0, 1), cB + hstep, voffB); PG8_STAGE(PG8_SA(0, 0), cA, voffA); PG8_STAGE(PG8_SA(0, 1), cA + hstep, voffA);
        if (wr == 1) PG8_BAR;
        PG8_WAIT_V(2); PG8_BAR;
        PG8_STAGE(PG8_SB(1, 0), cB + kstep, voffB); PG8_STAGE(PG8_SA(1, 0), cA + kstep, voffA); PG8_STAGE(PG8_SB(1, 1), cB + hstep + kstep, voffB);
        PG8_WAIT_V(6); PG8_BAR;
    } else {
        PG8_STAGE(PG8_SB(0, 0), cB, voffB); PG8_STAGE(PG8_SA(0, 0), cA, voffA); PG8_STAGE(PG8_SB(0, 1), cB + hstep, voffB); PG8_STAGE(PG8_SA(0, 1), cA + hstep, voffA);
        if (wr == 1) PG8_BAR;
        PG8_WAIT_V(4); PG8_BAR;
        PG8_STAGE(PG8_SB(1, 0), cB + kstep, voffB); PG8_STAGE(PG8_SA(1, 0), cA + kstep, voffA); PG8_STAGE(PG8_SB(1, 1), cB + hstep + kstep, voffB);
        PG8_WAIT_V(6); PG8_BAR;
    }
    for (;;) {
        const bool has_next = S.next(ui + 1, nxt);
        const char* nA = has_next ? (const char*)g.A + (size_t)nxt.pm * tstep + (size_t)nxt.k0 * kstep : cA; const char* nB = has_next ? (const char*)g.Bt + (size_t)nxt.pn * tstep + (size_t)nxt.k0 * kstep : cB;
        const int nt = cur.nk;
#pragma unroll 1
        for (int t = 0; t < nt; t += 2) {
            const bool last = (t == nt - 2);
            const char* a1 = cA + (size_t)(t + 1) * kstep;
            const char* a2 = last ? nA : cA + (size_t)(t + 2) * kstep; const char* b2 = last ? nB : cB + (size_t)(t + 2) * kstep;
            const char* a3 = a2 + kstep; const char* b3 = b2 + kstep;
            if (last && has_next) S.a_ready(nxt);
            if constexpr (SP2) {
            PG8_LDB(B0, 0, 0); PG8_LDB(B1, 0, 1); PG8_SCHED; PG8_LDA(At, 0, 0); PG8_STAGE(PG8_SA(1, 1), a1 + hstep, voffA);
            PG8_WAIT_V(8); PG8_WAIT_L(0); PG8_BAR; PG8_MMA(0, 0, At, B0); PG8_MMA(0, 1, At, B1); PG8_BAR; PG8_SCHED;
            PG8_LDA(At, 0, 1); PG8_STAGE(PG8_SB(0, 0), b2, voffB); PG8_STAGE(PG8_SB(0, 1), b2 + hstep, voffB); PG8_STAGE(PG8_SA(0, 0), a2, voffA);
            PG8_WAIT_V(8); PG8_WAIT_L(0); PG8_BAR; PG8_MMA(1, 0, At, B0); PG8_MMA(1, 1, At, B1); PG8_BAR; PG8_SCHED;
            PG8_LDB(B0, 1, 0); PG8_LDB(B1, 1, 1); PG8_SCHED; PG8_LDA(At, 1, 0); PG8_STAGE(PG8_SA(0, 1), a2 + hstep, voffA);
            PG8_WAIT_V(8); PG8_WAIT_L(0); PG8_BAR; PG8_MMA(0, 0, At, B0); PG8_MMA(0, 1, At, B1); PG8_BAR; PG8_SCHED;
            PG8_LDA(At, 1, 1); PG8_STAGE(PG8_SB(1, 0), b3, voffB); PG8_STAGE(PG8_SB(1, 1), b3 + hstep, voffB); PG8_STAGE(PG8_SA(1, 0), a3, voffA);
            PG8_WAIT_V(8); PG8_WAIT_L(0); PG8_BAR; PG8_MMA(1, 0, At, B0); PG8_MMA(1, 1, At, B1); PG8_BAR; PG8_SCHED;
            } else {
            PG8_LDB(B0, 0, 0); PG8_SCHED; PG8_LDA(At, 0, 0); PG8_STAGE(PG8_SA(1, 1), a1 + hstep, voffA);
            PG8_WAIT_L(8); PG8_BAR; PG8_WAIT_L(0); PG8_MMA(0, 0, At, B0); PG8_BAR; PG8_SCHED;
            PG8_LDB(B1, 0, 1); PG8_STAGE(PG8_SB(0, 0), b2, voffB);
            PG8_BAR; PG8_WAIT_L(0); PG8_MMA(0, 1, At, B1); PG8_BAR;
            PG8_LDA(At, 0, 1); PG8_STAGE(PG8_SA(0, 0), a2, voffA);
            PG8_BAR; PG8_WAIT_L(0); PG8_MMA(1, 0, At, B0); PG8_BAR; PG8_SCHED;
            PG8_STAGE(PG8_SB(0, 1), b2 + hstep, voffB);
            PG8_WAIT_V(6); PG8_BAR; PG8_MMA(1, 1, At, B1); PG8_BAR;
            PG8_LDB(B0, 1, 0); PG8_SCHED; PG8_LDA(At, 1, 0); PG8_STAGE(PG8_SA(0, 1), a2 + hstep, voffA);
            PG8_WAIT_L(8); PG8_BAR; PG8_WAIT_L(0); PG8_MMA(0, 0, At, B0); PG8_BAR; PG8_SCHED;
            PG8_LDB(B1, 1, 1); PG8_STAGE(PG8_SB(1, 0), b3, voffB);
            PG8_BAR; PG8_WAIT_L(0); PG8_MMA(0, 1, At, B1); PG8_BAR;
            PG8_LDA(At, 1, 1); PG8_STAGE(PG8_SA(1, 0), a3, voffA);
            PG8_BAR; PG8_WAIT_L(0); PG8_MMA(1, 0, At, B0); PG8_BAR; PG8_SCHED;
            PG8_STAGE(PG8_SB(1, 1), b3 + hstep, voffB);
            PG8_WAIT_V(6); PG8_BAR; PG8_MMA(1, 1, At, B1); PG8_BAR;
            }
        }
        if constexpr (ALIGN_EPI) { if (wr == 0) PG8_BAR; }
        if constexpr (!Epi::AFTER_DRAIN) { E(acc, cur, wr, wc, fr, fq); S.done(cur); }
        if (!has_next) break;
#pragma unroll
        for (int a = 0; a < 2; ++a)
#pragma unroll
            for (int b = 0; b < 2; ++b)
#pragma unroll
                for (int m = 0; m < 4; ++m)
#pragma unroll
                    for (int n = 0; n < 2; ++n) acc[a][b][m][n] = (f32x4){0.f, 0.f, 0.f, 0.f};
        cur = nxt; cA = nA; cB = nB; ++ui;
        if constexpr (ALIGN_EPI) { if (wr == 1) PG8_BAR; }
    }
    PG8_WAIT_V(0);
    if constexpr (!ALIGN_EPI) { if (wr == 0) PG8_BAR; }
    PG8_BAR;
    if constexpr (Epi::AFTER_DRAIN) { E.fused(acc, cur, wr, wc, fr, fq, lds, wid, lane); S.done(cur); }
#undef PG8_SA
#undef PG8_SB
#undef PG8_STAGE
#undef PG8_LDA
#undef PG8_LDB
#undef PG8_MMA
#undef PG8_WAIT_V
#undef PG8_WAIT_L
#undef PG8_BAR
#undef PG8_SCHED
}
}

#define LAS __attribute__((address_space(3)))
#define GAS __attribute__((address_space(1)))
using pg8::bf16_t; using pg8::bf16x8; using pg8::f32x4; using pg8::u32x4;
typedef float f32x16 __attribute__((ext_vector_type(16)));
typedef unsigned u32x2 __attribute__((ext_vector_type(2)));
typedef float f32x2v __attribute__((ext_vector_type(2)));
typedef __bf16 bf16x2v __attribute__((ext_vector_type(2)));

constexpr int NB = 16, SQ = 2048, CL = 256, TB = SQ + CL, TT = NB * TB, DM = 1024, FF = 2816, NMODV = 9216;
constexpr int NTHR = 512, GRID = 256;
constexpr size_t MiB = (size_t)1 << 20;
constexpr size_t U72 = 72 * MiB;
constexpr size_t WS_MOD = 0;
constexpr size_t WS_ROPEH = 3 * MiB;
constexpr size_t WS_ROPEM = 3 * MiB + 512 * 1024;
constexpr size_t WS_LB = 3 * MiB + 768 * 1024;
constexpr size_t WS_LAM = WS_LB + 4096;
constexpr size_t WS_BAR = 4 * MiB - 64 * 1024;
constexpr size_t WS_HX = 4 * MiB;
constexpr size_t WS_BIG = 148 * MiB;
constexpr size_t WS_END = 508 * MiB;
constexpr size_t DO_A = 0;
constexpr size_t DO_W = 72 * MiB;
constexpr size_t W_F1GU = DO_W, W_F1D = DO_W + 11 * MiB, W_F2GU = DO_W + 33 * MiB / 2, W_F2D = DO_W + 55 * MiB / 2;
constexpr size_t W_MIN = DO_W + 33 * MiB, W_MOUT = DO_W + 43 * MiB, W_UQ = DO_W + 45 * MiB, W_UKV = DO_W + 46 * MiB;
constexpr int LDS_BYTES = 147456;
constexpr float LOG2E = 1.4426950408889634f;

struct Params {
    const float *x, *c, *ctx, *c_ctx, *ada_w, *ada_b, *norm_w, *final_norm_w, *ffn_g, *ffn_u, *ffn_d,
        *gqa_in, *gqa_out, *gqa_sinks, *diff_in, *diff_out, *diff_lambda, *diff_subln,
        *hgrn_in, *hgrn_out, *hgrn_norm, *hgrn_lb, *mla_down, *mla_qn, *mla_kvn, *mla_uq, *mla_ukv, *mla_out;
    float* out; unsigned char* ws; int ph_lo, ph_hi;
};

__device__ __forceinline__ int fresh_bid() { int t = blockIdx.x; asm volatile("" : "+s"(t)); return t; }
__device__ __forceinline__ int fresh_gdim() { int t = gridDim.x; asm volatile("" : "+s"(t)); return t; }
__device__ __forceinline__ int fresh_tid() { int t = threadIdx.x; asm volatile("" : "+v"(t)); return t; }
__device__ __forceinline__ unsigned pk2(float lo, float hi) { f32x2v v = {lo, hi}; bf16x2v b = __builtin_convertvector(v, bf16x2v); return __builtin_bit_cast(unsigned, b); }
__device__ __forceinline__ unsigned short f2bf(float f) { return (unsigned short)(pk2(f, 0.f) & 0xffffu); }
__device__ __forceinline__ float bf2f(unsigned short u) { return __uint_as_float((unsigned)u << 16); }
__device__ __forceinline__ float bflo(unsigned w) { return __uint_as_float(w << 16); }
__device__ __forceinline__ float bfhi(unsigned w) { return __uint_as_float(w & 0xffff0000u); }
__device__ __forceinline__ unsigned short f2h(float f) { _Float16 h = (_Float16)f; return __builtin_bit_cast(unsigned short, h); }
__device__ __forceinline__ float h2f(unsigned short u) { return (float)__builtin_bit_cast(_Float16, u); }
__device__ __forceinline__ float silu_f(float v) { return v * __builtin_amdgcn_rcpf(1.f + __expf(-v)); }
__device__ __forceinline__ float wave_sum(float v) {
#pragma unroll
    for (int o = 1; o < 64; o <<= 1) v += __shfl_xor(v, o);
    return v;
}
__device__ __forceinline__ int crow(int r, int hi) { return (r & 3) + 8 * (r >> 2) + 4 * hi; }
__device__ __forceinline__ void store4bf(bf16_t* p, f32x4 v) { u32x2 w; w.x = pk2(v[0], v[1]); w.y = pk2(v[2], v[3]); *(GAS u32x2*)p = w; }
__device__ __forceinline__ f32x4 ldg4(const float* p) { return *(const GAS f32x4*)p; }
__device__ __forceinline__ void stg4(float* p, f32x4 v) { *(GAS f32x4*)p = v; }

template <class F> __device__ __forceinline__ void epi_loop(const f32x4 (&acc)[2][2][4][2], const pg8::Unit& u, int wr, int wc, int fr, int fq, const F& f) {
#pragma unroll
    for (int ai = 0; ai < 2; ++ai)
#pragma unroll
        for (int m = 0; m < 4; ++m) {
            const int row = u.pm * 256 + ai * 128 + wr * 64 + m * 16 + fr;
#pragma unroll
            for (int bj = 0; bj < 2; ++bj) f.item(row, u.pn * 256 + bj * 128 + wc * 32 + 4 * fq, acc[ai][bj][m][0], acc[ai][bj][m][1]);
        }
}
struct EpiSwiglu {
    static constexpr bool PERM = true, AFTER_DRAIN = false;
    bf16_t* H;
    __device__ __forceinline__ void operator()(const f32x4 (&acc)[2][2][4][2], const pg8::Unit& u, int wr, int wc, int fr, int fq) const {
        const int row0 = u.pm * 256 + wr * 64 + fr, col0 = u.pn * 128 + wc * 32 + 8 * fq;
#pragma unroll
        for (int ai = 0; ai < 2; ++ai)
#pragma unroll
            for (int m = 0; m < 4; ++m) {
                bf16_t* rp = H + (size_t)(row0 + ai * 128 + m * 16) * FF + col0;
                const f32x4 g0 = acc[ai][0][m][0], g1 = acc[ai][0][m][1], u0 = acc[ai][1][m][0], u1 = acc[ai][1][m][1];
                u32x4 w;
                w.x = pk2(silu_f(g0[0]) * u0[0], silu_f(g0[1]) * u0[1]); w.y = pk2(silu_f(g0[2]) * u0[2], silu_f(g0[3]) * u0[3]);
                w.z = pk2(silu_f(g1[0]) * u1[0], silu_f(g1[1]) * u1[1]); w.w = pk2(silu_f(g1[2]) * u1[2], silu_f(g1[3]) * u1[3]);
                *(GAS u32x4*)rp = w;
                asm volatile("" ::: "memory");
            }
    }
};
constexpr int SPLIT_PM0 = 128, SPLIT_ROWS = 4096;
struct EpiResid {
    static constexpr bool PERM = false, AFTER_DRAIN = false;
    float* HX; const float* modl; int midx; float coef; float* P;
    __device__ __forceinline__ void operator()(const f32x4 (&acc)[2][2][4][2], const pg8::Unit& u, int wr, int wc, int fr, int fq) const {
        const int bi = u.pm / 9, mr = (u.pm - bi * 9) == 0 ? 16 : bi;
        const int col0 = u.pn * 256 + wc * 32 + 4 * fq;
        const float* g = modl + (size_t)mr * NMODV + midx * 1024 + col0;
        f32x4 gv[2][2];
#pragma unroll
        for (int bj = 0; bj < 2; ++bj)
#pragma unroll
            for (int n = 0; n < 2; ++n) gv[bj][n] = coef * ldg4(g + bj * 128 + n * 16);
        if (u.part < 0) {
#pragma unroll
            for (int ai = 0; ai < 2; ++ai)
#pragma unroll
                for (int m = 0; m < 4; ++m) {
                    float* hp = HX + (size_t)(u.pm * 256 + ai * 128 + wr * 64 + m * 16 + fr) * DM + col0;
#pragma unroll
                    for (int bj = 0; bj < 2; ++bj)
#pragma unroll
                        for (int n = 0; n < 2; ++n) { float* h = hp + bj * 128 + n * 16; stg4(h, ldg4(h) + gv[bj][n] * acc[ai][bj][m][n]); }
                }
        } else {
#pragma unroll
            for (int ai = 0; ai < 2; ++ai)
#pragma unroll
                for (int m = 0; m < 4; ++m) {
                    bf16_t* hp = (bf16_t*)P + ((size_t)u.part * SPLIT_ROWS + (size_t)((u.pm - SPLIT_PM0) * 256 + ai * 128 + wr * 64 + m * 16 + fr)) * DM + col0;
#pragma unroll
                    for (int bj = 0; bj < 2; ++bj)
#pragma unroll
                        for (int n = 0; n < 2; ++n) store4bf(hp + bj * 128 + n * 16, gv[bj][n] * acc[ai][bj][m][n]);
                    if (m & 1) asm volatile("" ::: "memory");
                }
        }
    }
};
__device__ __forceinline__ void rope64(f32x4& a, f32x4& b, const float* tab, int s, int col) {
    const int half = (col >> 5) & 1, i0 = col & 31;
    const GAS f32x4* tp = (const GAS f32x4*)(tab + ((size_t)s * 32 + half * 16 + i0) * 2);
    const f32x4 t0 = tp[0], t1 = tp[1];
    f32x4 na, nb;
    na[0] = a[0] * t0[0] - b[0] * t0[1]; nb[0] = b[0] * t0[0] + a[0] * t0[1];
    na[1] = a[1] * t0[2] - b[1] * t0[3]; nb[1] = b[1] * t0[2] + a[1] * t0[3];
    na[2] = a[2] * t1[0] - b[2] * t1[1]; nb[2] = b[2] * t1[0] + a[2] * t1[1];
    na[3] = a[3] * t1[2] - b[3] * t1[3]; nb[3] = b[3] * t1[2] + a[3] * t1[3];
    a = na; b = nb;
}
__device__ __forceinline__ void store_vt(bf16_t* vt, const f32x4& a, const f32x4& b) {
#pragma unroll
    for (int j = 0; j < 4; ++j) ((GAS bf16_t*)vt)[(size_t)j * TB] = f2bf(a[j]);
    asm volatile("" ::: "memory");
    GAS bf16_t* v2 = (GAS bf16_t*)vt + (size_t)16 * TB;
#pragma unroll
    for (int j = 0; j < 4; ++j) v2[(size_t)j * TB] = f2bf(b[j]);
    asm volatile("" ::: "memory");
}
struct EpiGqaIn {
    static constexpr bool PERM = false, AFTER_DRAIN = false;
    bf16_t *Q, *K, *Vt; const float* ropeH;
    __device__ __forceinline__ void item(int row, int col, const f32x4& a_, const f32x4& b_) const {
        f32x4 a = a_, b = b_; const int bi = row / TB, t = row - bi * TB;
        if (col < 1280) {
            if (t >= CL) rope64(a, b, ropeH, t - CL, col);
            if (col < 1024) { const float c2 = 0.125f * LOG2E; a = a * c2; b = b * c2; bf16_t* q = Q + (size_t)row * 1024 + col; store4bf(q, a); store4bf(q + 16, b); }
            else { bf16_t* k = K + (size_t)row * 256 + (col - 1024); store4bf(k, a); store4bf(k + 16, b); }
        } else { const int cv = col - 1280, head = cv >> 6, dv = cv & 63; store_vt(Vt + ((size_t)(bi * 4 + head) * 64 + dv) * TB + t, a, b); }
    }
    __device__ __forceinline__ void operator()(const f32x4 (&acc)[2][2][4][2], const pg8::Unit& u, int wr, int wc, int fr, int fq) const { epi_loop(acc, u, wr, wc, fr, fq, *this); }
};
struct EpiDiffIn {
    static constexpr bool PERM = false, AFTER_DRAIN = false;
    bf16_t *Q, *K, *Vt; const float* ropeH;
    __device__ __forceinline__ void item(int row, int col, const f32x4& a_, const f32x4& b_) const {
        f32x4 a = a_, b = b_; const int bi = row / TB, t = row - bi * TB;
        if (col < 2048) {
            if (t >= CL) rope64(a, b, ropeH, t - CL, col);
            if (col < 1024) { const float c2 = 0.125f * LOG2E; a = a * c2; b = b * c2; bf16_t* q = Q + (size_t)row * 1024 + col; store4bf(q, a); store4bf(q + 16, b); }
            else { bf16_t* k = K + (size_t)row * 1024 + (col - 1024); store4bf(k, a); store4bf(k + 16, b); }
        } else { const int cv = col - 2048, head = cv >> 7, dv = cv & 127; store_vt(Vt + ((size_t)(bi * 8 + head) * 128 + dv) * TB + t, a, b); }
    }
    __device__ __forceinline__ void operator()(const f32x4 (&acc)[2][2][4][2], const pg8::Unit& u, int wr, int wc, int fr, int fq) const { epi_loop(acc, u, wr, wc, fr, fq, *this); }
};
struct EpiHgrnIn {
    static constexpr bool PERM = false, AFTER_DRAIN = false;
    bf16_t* Qh; unsigned short *LF, *LB; bf16_t *V, *Gt; const float* lb;
    __device__ __forceinline__ void item(int row, int col, const f32x4& a, const f32x4& b) const {
        const int sec = col >> 10, cc = col & 1023; const size_t o = (size_t)row * 1024 + cc;
        if (sec == 0 || sec == 4) { f32x4 x, y;
#pragma unroll
            for (int j = 0; j < 4; ++j) { x[j] = silu_f(a[j]); y[j] = silu_f(b[j]); }
            bf16_t* d = (sec == 0 ? Qh : Gt) + o; store4bf(d, x); store4bf(d + 16, y);
        } else if (sec == 3) { store4bf(V + o, a); store4bf(V + o + 16, b); }
        else { unsigned short* d = (sec == 1 ? LF : LB) + o; const f32x4 la = ldg4(lb + cc), lbb = ldg4(lb + cc + 16);
            unsigned short ha[4], hb[4];
#pragma unroll
            for (int j = 0; j < 4; ++j) { const float fa = la[j] + (1.f - la[j]) * __builtin_amdgcn_rcpf(1.f + __expf(-a[j])), fb = lbb[j] + (1.f - lbb[j]) * __builtin_amdgcn_rcpf(1.f + __expf(-b[j]));
                ha[j] = f2h(__builtin_amdgcn_logf(fa) * 0.6931471805599453f); hb[j] = f2h(__builtin_amdgcn_logf(fb) * 0.6931471805599453f); }
            u32x2 w; w.x = ha[0] | ((unsigned)ha[1] << 16); w.y = ha[2] | ((unsigned)ha[3] << 16); *(GAS u32x2*)d = w;
            w.x = hb[0] | ((unsigned)hb[1] << 16); w.y = hb[2] | ((unsigned)hb[3] << 16); *(GAS u32x2*)(d + 16) = w; }
    }
    __device__ __forceinline__ void operator()(const f32x4 (&acc)[2][2][4][2], const pg8::Unit& u, int wr, int wc, int fr, int fq) const { epi_loop(acc, u, wr, wc, fr, fq, *this); }
};
struct EpiF32 {
    static constexpr bool PERM = false, AFTER_DRAIN = false;
    float* O; int ld;
    __device__ __forceinline__ void item(int row, int col, const f32x4& a, const f32x4& b) const { float* d = O + (size_t)row * ld + col; stg4(d, a); stg4(d + 16, b); }
    __device__ __forceinline__ void operator()(const f32x4 (&acc)[2][2][4][2], const pg8::Unit& u, int wr, int wc, int fr, int fq) const { epi_loop(acc, u, wr, wc, fr, fq, *this); }
};
struct EpiMlaUq {
    static constexpr bool PERM = false, AFTER_DRAIN = false;
    bf16_t* Q; const float* ropeM;
    __device__ __forceinline__ void half(f32x4& a, const float* tp, bool first) const {
        const f32x4 t0 = ldg4(tp), t1 = ldg4(tp + 4);
        f32x4 pa;
#pragma unroll
        for (int j = 0; j < 4; ++j) { pa[j] = __shfl_xor(a[j], 32); if (first) pa[j] = -pa[j]; }
        a[0] = a[0] * t0[0] + pa[0] * t0[1]; a[1] = a[1] * t0[2] + pa[1] * t0[3]; a[2] = a[2] * t1[0] + pa[2] * t1[1]; a[3] = a[3] * t1[2] + pa[3] * t1[3];
    }
    __device__ __forceinline__ void item(int row, int col, const f32x4& a_, const f32x4& b_) const {
        f32x4 a = a_, b = b_; const int bi = row / TB, t = row - bi * TB; const int g32 = col >> 5;
        const float c2 = 0.10206207261596577f * LOG2E;
        bf16_t* q = Q + (size_t)row * 1536 + col;
        const bool rot = (g32 % 3) == 2 && t >= CL;
        const int fq = (col & 15) >> 2; const bool first = fq < 2; const int i0 = 4 * (fq & 1);
        const float* tp = ropeM + ((size_t)(rot ? t - CL : 0) * 16 + i0) * 2;
        if (rot) half(a, tp, first);
        a = a * c2; store4bf(q, a);
        asm volatile("" ::: "memory");
        if (rot) half(b, tp + 16, first);
        b = b * c2; store4bf(q + 16, b);
        asm volatile("" ::: "memory");
    }
    __device__ __forceinline__ void operator()(const f32x4 (&acc)[2][2][4][2], const pg8::Unit& u, int wr, int wc, int fr, int fq) const { epi_loop(acc, u, wr, wc, fr, fq, *this); }
};
struct EpiMlaUkv {
    static constexpr bool PERM = false, AFTER_DRAIN = false;
    bf16_t *K, *Vt;
    __device__ __forceinline__ void item(int row, int col, const f32x4& a, const f32x4& b) const {
        const int bi = row / TB, t = row - bi * TB; const int head = col >> 7, x = col & 127;
        if (x < 64) { bf16_t* k = K + (size_t)row * 1536 + head * 96 + x; store4bf(k, a); store4bf(k + 16, b); }
        else store_vt(Vt + ((size_t)(bi * 16 + head) * 64 + (x - 64)) * TB + t, a, b);
    }
    __device__ __forceinline__ void operator()(const f32x4 (&acc)[2][2][4][2], const pg8::Unit& u, int wr, int wc, int fr, int fq) const { epi_loop(acc, u, wr, wc, fr, fq, *this); }
};

template <class Epi> __device__ __forceinline__ void run_gemm(LAS unsigned char* lds, const bf16_t* A, const bf16_t* Bt, int N, int K, const Epi& E, bool split = false, bool lat = false) {
    pg8::Gemm g{A, Bt, lat ? NB * SQ : TT, N, K}; pg8::StaticOrder S; S.init(lat ? NB * SQ : TT, N, GRID, fresh_bid(), K / 64, split, lat);
    pg8::gemm_phase<Epi, pg8::StaticOrder, true, true>(lds, g, S, E);
}

__device__ __forceinline__ void transpose_item(const float* W, int K, int N, bf16_t* WT, int mode, LAS float* scr, int item, int lane) {
    const int nblk = N / 32, kb = item / nblk, nb = item - kb * nblk, k0 = 64 * kb, n0 = 32 * nb;
#pragma unroll 8
    for (int i = 0; i < 32; ++i) { const int kk = 2 * i + (lane >> 5); scr[kk * 33 + (lane & 31)] = W[(size_t)(k0 + kk) * N + n0 + (lane & 31)]; }
    asm volatile("s_waitcnt lgkmcnt(0)" ::: "memory");
    const int drow0 = mode == 0 ? n0 : (n0 >> 7) * 256 + (n0 & 127) + (mode == 2 ? 128 : 0);
    const int c = lane & 7;
#pragma unroll
    for (int j = 0; j < 4; ++j) { const int n = (lane >> 3) + 8 * j; const LAS float* s = scr + (8 * c) * 33 + n;
        u32x4 o; o.x = pk2(s[0 * 33], s[1 * 33]); o.y = pk2(s[2 * 33], s[3 * 33]); o.z = pk2(s[4 * 33], s[5 * 33]); o.w = pk2(s[6 * 33], s[7 * 33]);
        *(u32x4*)(WT + (size_t)(drow0 + n) * K + k0 + 8 * c) = o; }
    asm volatile("s_waitcnt lgkmcnt(0)" ::: "memory");
}
__device__ __forceinline__ void conv_job(const float* W, int K, int N, bf16_t* WT, int mode, LAS float* scr, int gw, int NGW, int lane, int& base) {
    const int n = (K / 64) * (N / 32);
    int it = gw - (base % NGW); if (it < 0) it += NGW;
    for (; it < n; it += NGW) transpose_item(W, K, N, WT, mode, scr, it, lane);
    base += n;
}
__device__ __forceinline__ void convert_weights(const Params& p, int layer, LAS unsigned char* lds, unsigned char* dout) {
    const int tid = fresh_tid(), lane = tid & 63, wave = tid >> 6;
    const int gw = fresh_bid() * 8 + wave, NGW = fresh_gdim() * 8;
    LAS float* scr = (LAS float*)(lds + wave * 16384);
    int base = 0;
    const size_t fgu = (size_t)DM * FF;
    for (int f = 0; f < 2; ++f) {
        const size_t off = ((size_t)layer * 2 + f) * fgu;
        bf16_t* gu = (bf16_t*)(dout + (f == 0 ? W_F1GU : W_F2GU)); bf16_t* dn = (bf16_t*)(dout + (f == 0 ? W_F1D : W_F2D));
        conv_job(p.ffn_g + off, DM, FF, gu, 1, scr, gw, NGW, lane, base);
        conv_job(p.ffn_u + off, DM, FF, gu, 2, scr, gw, NGW, lane, base);
        conv_job(p.ffn_d + off, FF, DM, dn, 0, scr, gw, NGW, lane, base);
    }
    bf16_t* win = (bf16_t*)(dout + W_MIN); bf16_t* wout = (bf16_t*)(dout + W_MOUT);
    if (layer == 0) { conv_job(p.gqa_in, DM, 1536, win, 0, scr, gw, NGW, lane, base); conv_job(p.gqa_out, DM, DM, wout, 0, scr, gw, NGW, lane, base); }
    else if (layer == 1) { conv_job(p.diff_in, DM, 3072, win, 0, scr, gw, NGW, lane, base); conv_job(p.diff_out, DM, DM, wout, 0, scr, gw, NGW, lane, base); }
    else if (layer == 2) { conv_job(p.hgrn_in, DM, 5120, win, 0, scr, gw, NGW, lane, base); conv_job(p.hgrn_out, DM, DM, wout, 0, scr, gw, NGW, lane, base); }
    else {
        conv_job(p.mla_down, DM, 544, win, 0, scr, gw, NGW, lane, base);
        conv_job(p.mla_uq, 256, 1536, (bf16_t*)(dout + W_UQ), 0, scr, gw, NGW, lane, base);
        conv_job(p.mla_ukv, 256, 2048, (bf16_t*)(dout + W_UKV), 0, scr, gw, NGW, lane, base);
        conv_job(p.mla_out, DM, DM, wout, 0, scr, gw, NGW, lane, base);
    }
}

__device__ __forceinline__ void prologue(const Params& p, LAS unsigned char* lds) {
    const int tid = fresh_tid(), G = fresh_gdim(), bid = fresh_bid();
    float* HX = (float*)(p.ws + WS_HX);
    for (size_t i = (size_t)bid * NTHR + tid; i < (size_t)TT * 256; i += (size_t)G * NTHR) {
        const int row = (int)(i >> 8), c4 = (int)(i & 255); const int b = row / TB, t = row - b * TB;
        const float* src = t < CL ? p.ctx + ((size_t)(b * CL + t)) * DM : p.x + ((size_t)(b * SQ + t - CL)) * DM;
        ((f32x4*)HX)[i] = ((const f32x4*)src)[c4];
    }
    float* ropeH = (float*)(p.ws + WS_ROPEH); float* ropeM = (float*)(p.ws + WS_ROPEM);
    for (int i = bid * NTHR + tid; i < 2048 * 32; i += G * NTHR) { const int s = i >> 5, e = i & 31; const float pos = (e < 16) ? (float)(s >> 6) : (float)(s & 63);
        const float inv = powf(10000.f, -(float)(2 * (e & 15)) / 32.f); const float ang = pos * inv; ropeH[2 * i] = cosf(ang); ropeH[2 * i + 1] = sinf(ang); }
    for (int i = bid * NTHR + tid; i < 2048 * 16; i += G * NTHR) { const int s = i >> 4, e = i & 15; const float pos = (e < 8) ? (float)(s >> 6) : (float)(s & 63);
        const float inv = powf(10000.f, -(float)(2 * (e & 7)) / 16.f); const float ang = pos * inv; ropeM[2 * i] = cosf(ang); ropeM[2 * i + 1] = sinf(ang); }
    if (bid == 0) {
        float* lbv = (float*)(p.ws + WS_LB);
        for (int d = tid; d < 1024; d += NTHR) { const float a0 = p.hgrn_lb[d], a1 = p.hgrn_lb[1024 + d], a2 = p.hgrn_lb[2048 + d], a3 = p.hgrn_lb[3072 + d];
            const float mx = fmaxf(fmaxf(a0, a1), fmaxf(a2, a3)); const float e0 = expf(a0 - mx), e1 = expf(a1 - mx), e2 = expf(a2 - mx), e3 = expf(a3 - mx);
            lbv[d] = (e1 + e2) / (e0 + e1 + e2 + e3); }
        if (tid == 0) { float s1 = 0.f, s2 = 0.f; for (int d = 0; d < 64; ++d) { s1 += p.diff_lambda[d] * p.diff_lambda[64 + d]; s2 += p.diff_lambda[128 + d] * p.diff_lambda[192 + d]; }
            const float lambda_init = 0.8f - 0.6f * expf(-0.3f);
            ((float*)(p.ws + WS_LAM))[0] = expf(s1) - expf(s2) + lambda_init; ((float*)(p.ws + WS_LAM))[1] = lambda_init; }
    }
    LAS float* sS = (LAS float*)lds; LAS float* red = (LAS float*)(lds + 17 * 1024 * 4);
    for (int i = tid; i < 17 * 1024; i += NTHR) { const int r = i >> 10, k = i & 1023; const float v = r < 16 ? p.c[r * 1024 + k] : p.c_ctx[k]; sS[i] = v / (1.f + expf(-v)); }
    __syncthreads();
    float* mod = (float*)(p.ws + WS_MOD);
    for (int item = bid; item < 4 * 144; item += G) {
        const int l = item / 144, n0 = (item - l * 144) * 64, col = tid & 63, kq = tid >> 6;
        const float* W = p.ada_w + (size_t)l * 1024 * NMODV + n0 + col;
        float acc[17];
#pragma unroll
        for (int r = 0; r < 17; ++r) acc[r] = 0.f;
        for (int k = kq * 128; k < kq * 128 + 128; k += 8) {
            float w[8];
#pragma unroll
            for (int i = 0; i < 8; ++i) w[i] = *(const GAS float*)(W + (size_t)(k + i) * NMODV);
#pragma unroll
            for (int i = 0; i < 8; i += 4)
#pragma unroll
                for (int r = 0; r < 17; ++r) { const f32x4 s4 = *(const LAS f32x4*)(sS + r * 1024 + k + i); acc[r] += (s4[0] * w[i] + s4[1] * w[i + 1]) + (s4[2] * w[i + 2] + s4[3] * w[i + 3]); }
        }
#pragma unroll
        for (int r = 0; r < 17; ++r) red[(kq * 17 + r) * 64 + col] = acc[r];
        __syncthreads();
        for (int o = tid; o < 17 * 64; o += NTHR) { const int r = o >> 6, cc = o & 63;
            float s = 0.f;
#pragma unroll
            for (int q = 0; q < 8; ++q) s += red[(q * 17 + r) * 64 + cc];
            mod[((size_t)l * 17 + r) * NMODV + n0 + cc] = s + p.ada_b[(size_t)l * NMODV + n0 + cc]; }
        __syncthreads();
    }
}

__device__ __forceinline__ void norm_phase(float* HX, const float* nw, const float* modl, int shift_idx, int scale_idx, bf16_t* A, const float* P, bool skip_ctx = false) {
    const int tid = fresh_tid(), lane = tid & 63, gw = fresh_bid() * 8 + (tid >> 6), NGW = fresh_gdim() * 8;
    f32x4 w4[4];
#pragma unroll
    for (int j = 0; j < 4; ++j) w4[j] = *(const f32x4*)(nw + lane * 4 + 256 * j);
    for (int row = gw; row < TT; row += NGW) {
        const int b = row / TB, t = row - b * TB, mr = t < CL ? 16 : b;
        if (skip_ctx && t < CL) continue;
        f32x4* xr = (f32x4*)(HX + (size_t)row * DM) + lane;
        f32x4 v[4]; float ss = 0.f;
#pragma unroll
        for (int j = 0; j < 4; ++j) v[j] = xr[64 * j];
        if (P != nullptr && row >= SPLIT_PM0 * 256) {
            const u32x2* pr = (const u32x2*)((const bf16_t*)P + (size_t)(row - SPLIT_PM0 * 256) * DM) + lane;
#pragma unroll
            for (int j = 0; j < 4; ++j) {
                f32x4 a = {0.f, 0.f, 0.f, 0.f};
#pragma unroll
                for (int q = 0; q < 4; ++q) { const u32x2 w = pr[(size_t)q * SPLIT_ROWS * 256 + 64 * j]; a[0] += bflo(w.x); a[1] += bfhi(w.x); a[2] += bflo(w.y); a[3] += bfhi(w.y); }
                v[j] = v[j] + a; xr[64 * j] = v[j]; }
        }
#pragma unroll
        for (int j = 0; j < 4; ++j) ss += (v[j][0] * v[j][0] + v[j][1] * v[j][1]) + (v[j][2] * v[j][2] + v[j][3] * v[j][3]);
        const float rstd = rsqrtf(wave_sum(ss) * (1.f / 1024.f) + 1e-6f);
        const float* sh = modl + (size_t)mr * NMODV + shift_idx * 1024 + lane * 4; const float* sc = modl + (size_t)mr * NMODV + scale_idx * 1024 + lane * 4;
        bf16_t* ar = A + (size_t)row * DM + lane * 4;
#pragma unroll
        for (int j = 0; j < 4; ++j) { const f32x4 s4 = *(const f32x4*)(sc + 256 * j), h4 = *(const f32x4*)(sh + 256 * j);
            const f32x4 y = v[j] * rstd * w4[j] * (1.f + s4) + h4; store4bf(ar + 256 * j, y); }
    }
}
__device__ __forceinline__ void final_phase(const float* HX, const float* nw, float* out) {
    const int tid = fresh_tid(), lane = tid & 63, gw = fresh_bid() * 8 + (tid >> 6), NGW = fresh_gdim() * 8;
    f32x4 w4[4];
#pragma unroll
    for (int j = 0; j < 4; ++j) w4[j] = *(const f32x4*)(nw + lane * 4 + 256 * j);
    for (int r = gw; r < NB * SQ; r += NGW) {
        const int b = r >> 11, s = r & 2047; const int row = b * TB + CL + s;
        const f32x4* xr = (const f32x4*)(HX + (size_t)row * DM) + lane;
        f32x4 v[4]; float ss = 0.f;
#pragma unroll
        for (int j = 0; j < 4; ++j) { v[j] = xr[64 * j]; ss += (v[j][0] * v[j][0] + v[j][1] * v[j][1]) + (v[j][2] * v[j][2] + v[j][3] * v[j][3]); }
        const float rstd = rsqrtf(wave_sum(ss) * (1.f / 1024.f) + 1e-6f);
        f32x4* o = (f32x4*)(out + (size_t)r * DM) + lane;
#pragma unroll
        for (int j = 0; j < 4; ++j) o[64 * j] = v[j] * rstd * w4[j];
    }
}
__device__ __forceinline__ void diff_combine(const bf16_t* O16, const float* subln, const float* lamp, bf16_t* A) {
    const int tid = fresh_tid(), lane = tid & 63, gw = fresh_bid() * 8 + (tid >> 6), NGW = fresh_gdim() * 8;
    const float lam = lamp[0], om = 1.f - lamp[1];
    const int h = lane >> 3, e0 = (lane & 7) * 16;
    float sw[16];
#pragma unroll
    for (int j = 0; j < 16; ++j) sw[j] = subln[e0 + j] * om;
    for (int row = gw; row < TT; row += NGW) {
        const u32x4* o1 = (const u32x4*)(O16 + (size_t)row * 2048 + (2 * h) * 128 + e0); const u32x4* o2 = (const u32x4*)(O16 + (size_t)row * 2048 + (2 * h + 1) * 128 + e0);
        float v[16]; float ss = 0.f;
#pragma unroll
        for (int q = 0; q < 2; ++q) { const u32x4 a = o1[q], b = o2[q];
#pragma unroll
            for (int k = 0; k < 4; ++k) { v[q * 8 + 2 * k] = bflo(a[k]) - lam * bflo(b[k]); v[q * 8 + 2 * k + 1] = bfhi(a[k]) - lam * bfhi(b[k]); } }
#pragma unroll
        for (int j = 0; j < 16; ++j) ss += v[j] * v[j];
        ss += __shfl_xor(ss, 1); ss += __shfl_xor(ss, 2); ss += __shfl_xor(ss, 4);
        const float rstd = rsqrtf(ss * (1.f / 128.f) + 1e-6f);
        u32x4 w0, w1;
        w0.x = pk2(v[0] * rstd * sw[0], v[1] * rstd * sw[1]); w0.y = pk2(v[2] * rstd * sw[2], v[3] * rstd * sw[3]); w0.z = pk2(v[4] * rstd * sw[4], v[5] * rstd * sw[5]); w0.w = pk2(v[6] * rstd * sw[6], v[7] * rstd * sw[7]);
        w1.x = pk2(v[8] * rstd * sw[8], v[9] * rstd * sw[9]); w1.y = pk2(v[10] * rstd * sw[10], v[11] * rstd * sw[11]); w1.z = pk2(v[12] * rstd * sw[12], v[13] * rstd * sw[13]); w1.w = pk2(v[14] * rstd * sw[14], v[15] * rstd * sw[15]);
        u32x4* d = (u32x4*)(A + (size_t)row * 1024 + h * 128 + e0); d[0] = w0; d[1] = w1;
    }
}
__device__ __forceinline__ void hgrn_combine(const bf16_t* OF, const bf16_t* OB, const bf16_t* Gt, const float* nw, bf16_t* A) {
    const int tid = fresh_tid(), lane = tid & 63, gw = fresh_bid() * 8 + (tid >> 6), NGW = fresh_gdim() * 8;
    const int e0 = (lane & 7) * 16;
    float sw[16];
#pragma unroll
    for (int j = 0; j < 16; ++j) sw[j] = nw[e0 + j];
    for (int row = gw; row < TT; row += NGW) {
        const size_t off = (size_t)row * 1024 + lane * 16;
        const u32x4* pf = (const u32x4*)(OF + off); const u32x4* pb = (const u32x4*)(OB + off); const u32x4* pg = (const u32x4*)(Gt + off);
        float v[16], g[16]; float ss = 0.f;
#pragma unroll
        for (int q = 0; q < 2; ++q) { const u32x4 a = pf[q], b = pb[q], c = pg[q];
#pragma unroll
            for (int k = 0; k < 4; ++k) { v[q * 8 + 2 * k] = bflo(a[k]) + bflo(b[k]); v[q * 8 + 2 * k + 1] = bfhi(a[k]) + bfhi(b[k]); g[q * 8 + 2 * k] = bflo(c[k]); g[q * 8 + 2 * k + 1] = bfhi(c[k]); } }
#pragma unroll
        for (int j = 0; j < 16; ++j) ss += v[j] * v[j];
        ss += __shfl_xor(ss, 1); ss += __shfl_xor(ss, 2); ss += __shfl_xor(ss, 4);
        const float rstd = rsqrtf(ss * (1.f / 128.f) + 1e-6f);
        u32x4 w0, w1;
#define HC(j) (v[j] * rstd * sw[j] * g[j])
        w0.x = pk2(HC(0), HC(1)); w0.y = pk2(HC(2), HC(3)); w0.z = pk2(HC(4), HC(5)); w0.w = pk2(HC(6), HC(7));
        w1.x = pk2(HC(8), HC(9)); w1.y = pk2(HC(10), HC(11)); w1.z = pk2(HC(12), HC(13)); w1.w = pk2(HC(14), HC(15));
#undef HC
        u32x4* d = (u32x4*)(A + off); d[0] = w0; d[1] = w1;
    }
}
__device__ __forceinline__ void mla_rows(const float* DN, const float* qn, const float* kvn, const float* ropeM, bf16_t* CQ, bf16_t* CKV, bf16_t* K) {
    const int tid = fresh_tid(), lane = tid & 63, gw = fresh_bid() * 8 + (tid >> 6), NGW = fresh_gdim() * 8;
    const f32x4 wq = *(const f32x4*)(qn + lane * 4), wk = *(const f32x4*)(kvn + lane * 4);
    for (int row = gw; row < TT; row += NGW) {
        const int b = row / TB, t = row - b * TB;
        const float* dr = DN + (size_t)row * 768;
        const f32x4 a = *(const f32x4*)(dr + lane * 4), c = *(const f32x4*)(dr + 256 + lane * 4);
        const float kr = dr[512 + (lane & 31)];
        float sa = (a[0] * a[0] + a[1] * a[1]) + (a[2] * a[2] + a[3] * a[3]), sc = (c[0] * c[0] + c[1] * c[1]) + (c[2] * c[2] + c[3] * c[3]);
        sa = wave_sum(sa); sc = wave_sum(sc);
        const float ra = rsqrtf(sa * (1.f / 256.f) + 1e-6f), rc = rsqrtf(sc * (1.f / 256.f) + 1e-6f);
        store4bf(CQ + (size_t)row * 256 + lane * 4, a * ra * wq); store4bf(CKV + (size_t)row * 256 + lane * 4, c * rc * wk);
        const int d = lane & 31; float kv = kr;
        const float part = __shfl_xor(kr, 8);
        if (t >= CL) { const int e = (d >> 4) * 8 + (d & 7); const float cs = ropeM[((size_t)(t - CL) * 16 + e) * 2], sn = ropeM[((size_t)(t - CL) * 16 + e) * 2 + 1];
            kv = kr * cs + ((d & 8) ? part : -part) * sn; }
        float o8[8];
#pragma unroll
        for (int j = 0; j < 8; ++j) o8[j] = __shfl(kv, (lane & 3) * 8 + j);
        u32x4 w; w.x = pk2(o8[0], o8[1]); w.y = pk2(o8[2], o8[3]); w.z = pk2(o8[4], o8[5]); w.w = pk2(o8[6], o8[7]);
        *(u32x4*)(K + (size_t)row * 1536 + (lane >> 2) * 96 + 64 + (lane & 3) * 8) = w;
    }
}

template <int DQK, int DV>
__device__ __forceinline__ void attn_unit(LAS unsigned char* lds, const bf16_t* Qr, int qs, const bf16_t* Kb, int ks, const bf16_t* Vtb, bf16_t* Or, int os,
                                          int lt0, int lt1, bool windowed, int qpos0, float m_init, float l_init,
                                          const bf16_t* Oprev = nullptr, float lam = 0.f, float om = 0.f, const float* subw = nullptr) {
    constexpr int KST = DQK * 2 + 16, VST = 144, KBUF = 64 * KST, VBUF = DV * VST, KCH = DQK / 8, NKC = 64 * KCH, KPT = (NKC + NTHR - 1) / NTHR, VPT = DV / 64, ND = DQK / 16, NO = DV / 32;
    const int tid = fresh_tid(), lane = tid & 63, r32 = lane & 31, hi = lane >> 5, wid = tid >> 6;
    LAS unsigned char* Kl = lds; LAS unsigned char* Vl = lds + 2 * KBUF;
    const int ntiles = 4 + (lt1 - lt0);
    const GAS bf16_t* Qg = (const GAS bf16_t*)Qr; const GAS bf16_t* Kg = (const GAS bf16_t*)Kb; const GAS bf16_t* Vg = (const GAS bf16_t*)Vtb; GAS bf16_t* Og = (GAS bf16_t*)Or;
    bf16x8 qf[ND];
#pragma unroll
    for (int d0 = 0; d0 < ND; ++d0) qf[d0] = *(const GAS bf16x8*)(Qg + (size_t)(wid * 32 + r32) * qs + d0 * 16 + hi * 8);
    f32x16 o[NO];
#pragma unroll
    for (int nb = 0; nb < NO; ++nb)
#pragma unroll
        for (int r = 0; r < 16; ++r) o[nb][r] = 0.f;
    const bool have_ref = l_init > 0.f;
    float m = have_ref ? m_init : 0.f, l = (hi == 0) ? l_init : 0.f;
    u32x4 kreg[KPT], vreg[VPT];
#define ATT_KT(tt_) ((tt_) < 4 ? (tt_) : lt0 + (tt_) - 4)
#define ATT_LOADK(tt_) do { const int kt_ = ATT_KT(tt_); \
        _Pragma("unroll") for (int i_ = 0; i_ < KPT; ++i_) { const int c_ = tid + NTHR * i_; if (c_ < NKC) { const int key_ = c_ / KCH, part_ = c_ - key_ * KCH; kreg[i_] = *(const GAS u32x4*)(Kg + (size_t)(kt_ * 64 + key_) * ks + part_ * 8); } } } while (0)
#define ATT_LOADV(tt_) do { const int kt_ = ATT_KT(tt_); \
        _Pragma("unroll") for (int i_ = 0; i_ < VPT; ++i_) { const int c_ = tid + NTHR * i_; const int dv_ = c_ >> 3, part_ = c_ & 7; vreg[i_] = *(const GAS u32x4*)(Vg + (size_t)dv_ * TB + kt_ * 64 + part_ * 8); } } while (0)
#define ATT_STOREK(buf_) do { \
        _Pragma("unroll") for (int i_ = 0; i_ < KPT; ++i_) { const int c_ = tid + NTHR * i_; if (c_ < NKC) { const int key_ = c_ / KCH, part_ = c_ - key_ * KCH; *(LAS u32x4*)(Kl + (buf_) * KBUF + key_ * KST + part_ * 16) = kreg[i_]; } } } while (0)
#define ATT_STOREV(buf_) do { \
        _Pragma("unroll") for (int i_ = 0; i_ < VPT; ++i_) { const int c_ = tid + NTHR * i_; const int dv_ = c_ >> 3, part_ = c_ & 7; LAS unsigned char* d_ = Vl + (buf_) * VBUF + dv_ * VST + (part_ >> 1) * 32 + (part_ & 1) * 8;     \
            *(LAS u32x2*)d_ = (u32x2){vreg[i_].x, vreg[i_].y}; *(LAS u32x2*)(d_ + 16) = (u32x2){vreg[i_].z, vreg[i_].w}; } } while (0)
#define SCHED_FENCE() __builtin_amdgcn_sched_barrier(0)
#define ATT_KFRAG(buf_) do { const LAS unsigned char* kb_ = Kl + (buf_) * KBUF + r32 * KST + hi * 16; \
        _Pragma("unroll") for (int d0 = 0; d0 < ND; ++d0) { kf[2 * d0] = *(const LAS bf16x8*)(kb_ + d0 * 32); kf[2 * d0 + 1] = *(const LAS bf16x8*)(kb_ + 32 * KST + d0 * 32); } } while (0)
#define ATT_QKM(P0_, P1_) do { \
        _Pragma("unroll") for (int d0 = 0; d0 < ND; ++d0) { \
            if (d0 == 0) { const f32x16 z_ = {0.f, 0.f, 0.f, 0.f, 0.f, 0.f, 0.f, 0.f, 0.f, 0.f, 0.f, 0.f, 0.f, 0.f, 0.f, 0.f}; P0_ = __builtin_amdgcn_mfma_f32_32x32x16_bf16(kf[0], qf[0], z_, 0, 0, 0); P1_ = __builtin_amdgcn_mfma_f32_32x32x16_bf16(kf[1], qf[0], z_, 0, 0, 0); } \
            else { P0_ = __builtin_amdgcn_mfma_f32_32x32x16_bf16(kf[2 * d0], qf[d0], P0_, 0, 0, 0); P1_ = __builtin_amdgcn_mfma_f32_32x32x16_bf16(kf[2 * d0 + 1], qf[d0], P1_, 0, 0, 0); } } } while (0)
#define ATT_VFRAG(dst_, nb_) do { _Pragma("unroll") for (int j_ = 0; j_ < 4; ++j_) dst_[j_] = *(const LAS u32x4*)(vb + (nb_) * 32 * VST + j_ * 32); } while (0)
    bf16x8 kf[2 * ND];
    f32x16 n0, n1;
    ATT_LOADK(0); ATT_LOADV(0); ATT_STOREK(0); ATT_STOREV(0);
    __syncthreads();
    ATT_LOADK(1); ATT_KFRAG(0); ATT_QKM(n0, n1); ATT_STOREK(1);
    __syncthreads();
    for (int tt = 0; tt < ntiles; ++tt) {
        const int cur = tt & 1;
        f32x16 p0 = n0, p1 = n1;
        if (tt + 2 < ntiles) ATT_LOADK(tt + 2);
        if (tt + 1 < ntiles) ATT_LOADV(tt + 1);
#define ATT_OUTSIDE(t_) (windowed && (t_) >= 4 && (((lt0 + (t_) - 4) * 64 - CL) > qhi_w + 128 || ((lt0 + (t_) - 4) * 64 - CL + 63) < qlo_w - 128))
        const int qlo_w = qpos0 + __builtin_amdgcn_readfirstlane(wid) * 32, qhi_w = qlo_w + 31;
        const bool skip_cur = ATT_OUTSIDE(tt), skip_next = ATT_OUTSIDE(tt + 1);
        u32x4 pw[4];
        if (!skip_cur) {
        if (windowed && tt >= 4) {
            const int kt = lt0 + tt - 4; const int kbase = kt * 64 - CL, qp = qpos0 + wid * 32 + r32;
#pragma unroll
            for (int r = 0; r < 16; ++r) { const int d0 = qp - (kbase + crow(r, hi)); if (d0 > 128 || d0 < -128) p0[r] = -1e30f; const int d1 = d0 - 32; if (d1 > 128 || d1 < -128) p1[r] = -1e30f; }
        }
        float mx = __builtin_fmaxf(__builtin_fmaxf(p0[0], p1[0]), p0[1]);
#pragma unroll
        for (int r = 1; r < 16; ++r) { if (r > 1) mx = __builtin_fmaxf(__builtin_fmaxf(mx, p0[r]), p1[r]); else mx = __builtin_fmaxf(mx, p1[1]); }
        mx = __builtin_fmaxf(mx, __shfl_xor(mx, 32)) - m;
        const bool force = (tt == 0) && !have_ref;
        if (force || __any(mx > 8.f)) {
            const float delta = force ? mx : __builtin_fmaxf(mx, 0.f);
            m += delta;
            if (!force) { const float alpha = __builtin_amdgcn_exp2f(-delta); l *= alpha;
#pragma unroll
                for (int nb = 0; nb < NO; ++nb)
#pragma unroll
                    for (int r = 0; r < 16; ++r) o[nb][r] *= alpha; }
        }
        float ls = 0.f;
#pragma unroll
        for (int r = 0; r < 16; ++r) { p0[r] = __builtin_amdgcn_exp2f(p0[r] - m); p1[r] = __builtin_amdgcn_exp2f(p1[r] - m); ls += p0[r] + p1[r]; }
        l += ls;
        pw[0] = (u32x4){pk2(p0[0], p0[1]), pk2(p0[2], p0[3]), pk2(p0[4], p0[5]), pk2(p0[6], p0[7])};
        pw[1] = (u32x4){pk2(p0[8], p0[9]), pk2(p0[10], p0[11]), pk2(p0[12], p0[13]), pk2(p0[14], p0[15])};
        pw[2] = (u32x4){pk2(p1[0], p1[1]), pk2(p1[2], p1[3]), pk2(p1[4], p1[5]), pk2(p1[6], p1[7])};
        pw[3] = (u32x4){pk2(p1[8], p1[9]), pk2(p1[10], p1[11]), pk2(p1[12], p1[13]), pk2(p1[14], p1[15])};
        SCHED_FENCE();
        }
        const LAS unsigned char* vb = Vl + cur * VBUF + r32 * VST + hi * 16;
        u32x4 vf[2][4];
        if (!skip_next) ATT_KFRAG(cur ^ 1);
        if (!skip_cur) ATT_VFRAG(vf[0], 0);
        SCHED_FENCE();
        if (!skip_next) ATT_QKM(n0, n1);
        if (!skip_cur) {
#pragma unroll
        for (int nb = 0; nb < NO; ++nb) {
            if (nb + 1 < NO) ATT_VFRAG(vf[(nb + 1) & 1], nb + 1);
            SCHED_FENCE();
#pragma unroll
            for (int j = 0; j < 4; ++j) o[nb] = __builtin_amdgcn_mfma_f32_32x32x16_bf16(__builtin_bit_cast(bf16x8, vf[nb & 1][j]), __builtin_bit_cast(bf16x8, pw[j]), o[nb], 0, 0, 0);
            SCHED_FENCE();
        }
        }
#undef ATT_OUTSIDE
        if (tt + 2 < ntiles) ATT_STOREK(cur);
        if (tt + 1 < ntiles) ATT_STOREV(cur ^ 1);
        __syncthreads();
    }
#undef SCHED_FENCE
#undef ATT_KFRAG
#undef ATT_QKM
#undef ATT_VFRAG
#undef ATT_KT
#undef ATT_LOADK
#undef ATT_LOADV
#undef ATT_STOREK
#undef ATT_STOREV
    l += __shfl_xor(l, 32);
    const float inv = 1.f / l;
    GAS bf16_t* orow = Og + (size_t)(wid * 32 + r32) * os + 4 * hi;
    if (DV == 128 && Oprev != nullptr) {
        const GAS bf16_t* prow = (const GAS bf16_t*)Oprev + (size_t)(wid * 32 + r32) * os + 4 * hi;
        const float li = lam * inv; float ss = 0.f;
#pragma unroll
        for (int nb = 0; nb < NO; ++nb)
#pragma unroll
            for (int g = 0; g < 4; ++g) { const u32x2 a = *(const GAS u32x2*)(prow + nb * 32 + 8 * g);
                const float x0 = bflo(a.x) - li * o[nb][4 * g], x1 = bfhi(a.x) - li * o[nb][4 * g + 1], x2 = bflo(a.y) - li * o[nb][4 * g + 2], x3 = bfhi(a.y) - li * o[nb][4 * g + 3];
                o[nb][4 * g] = x0; o[nb][4 * g + 1] = x1; o[nb][4 * g + 2] = x2; o[nb][4 * g + 3] = x3; ss += (x0 * x0 + x1 * x1) + (x2 * x2 + x3 * x3); }
        ss += __shfl_xor(ss, 32);
        const float rs = rsqrtf(ss * (1.f / 128.f) + 1e-6f) * om;
#pragma unroll
        for (int nb = 0; nb < NO; ++nb)
#pragma unroll
            for (int g = 0; g < 4; ++g) { const f32x4 w4 = ldg4(subw + nb * 32 + 8 * g + 4 * hi); u32x2 w;
                w.x = pk2(o[nb][4 * g] * rs * w4[0], o[nb][4 * g + 1] * rs * w4[1]); w.y = pk2(o[nb][4 * g + 2] * rs * w4[2], o[nb][4 * g + 3] * rs * w4[3]); *(GAS u32x2*)(orow + nb * 32 + 8 * g) = w; }
    } else {
#pragma unroll
    for (int nb = 0; nb < NO; ++nb)
#pragma unroll
        for (int g = 0; g < 4; ++g) { u32x2 w; w.x = pk2(o[nb][4 * g] * inv, o[nb][4 * g + 1] * inv); w.y = pk2(o[nb][4 * g + 2] * inv, o[nb][4 * g + 3] * inv); *(GAS u32x2*)(orow + nb * 32 + 8 * g) = w; }
    }
}

template <int KIND>
__device__ __forceinline__ void attn_phase(unsigned char* big, bf16_t* Abuf, const float* sinks  , const float* lamp, LAS unsigned char* lds, bool with_ctx) {
    constexpr int NHU = (KIND == 1) ? 8 : 16;
    const int NLAT = NB * NHU * 8, NU = NLAT + (with_ctx ? NB * NHU : 0);
    const int bid_ = fresh_bid(), vb_ = (bid_ & 7) * (GRID / 8) + (bid_ >> 3);
    for (int u = vb_; u < NU; u += GRID) {
        int b, head, j;
        if (u < NLAT) { j = 1 + (u & 7); head = (u >> 3) % NHU; b = (u >> 3) / NHU; } else { const int v = u - NLAT; j = 0; head = v % NHU; b = v / NHU; }
        const size_t row0 = (size_t)b * TB + j * 256;
        int lt0 = 4, lt1 = 4; const int qpos0 = (j - 1) * 256;
        if (j > 0) { if (KIND == 0) { int lo = qpos0 - 128; if (lo < 0) lo = 0; int hi = qpos0 + 255 + 128; if (hi > SQ - 1) hi = SQ - 1; lt0 = 4 + lo / 64; lt1 = 4 + hi / 64 + 1; } else { lt0 = 4; lt1 = 36; } }
        if (KIND == 0) {
            const bf16_t* Q = (const bf16_t*)big; const bf16_t* K = (const bf16_t*)(big + U72); const bf16_t* Vt = (const bf16_t*)(big + U72 + 18 * MiB);
            const float sink = sinks[head] * LOG2E;
            attn_unit<64, 64>(lds, Q + row0 * 1024 + head * 64, 1024, K + (size_t)b * TB * 256 + (head >> 2) * 64, 256, Vt + (size_t)(b * 4 + (head >> 2)) * 64 * TB,
                              Abuf + row0 * 1024 + head * 64, 1024, lt0, lt1, true, qpos0, sink, 1.f);
        } else if (KIND == 1) {
            const bf16_t* Q = (const bf16_t*)big; const bf16_t* K = (const bf16_t*)(big + U72); const bf16_t* Vt = (const bf16_t*)(big + 2 * U72); bf16_t* Otmp = (bf16_t*)(big + 3 * U72);
            const float lam = lamp[0], om = 1.f - lamp[1];
            attn_unit<64, 128>(lds, Q + row0 * 1024 + (2 * head) * 64, 1024, K + (size_t)b * TB * 1024 + (2 * head) * 64, 1024, Vt + (size_t)(b * 8 + head) * 128 * TB,
                               Otmp + row0 * 1024 + head * 128, 1024, lt0, lt1, false, qpos0, -1e30f, 0.f);
            attn_unit<64, 128>(lds, Q + row0 * 1024 + (2 * head + 1) * 64, 1024, K + (size_t)b * TB * 1024 + (2 * head + 1) * 64, 1024, Vt + (size_t)(b * 8 + head) * 128 * TB,
                               Abuf + row0 * 1024 + head * 128, 1024, lt0, lt1, false, qpos0, -1e30f, 0.f, Otmp + row0 * 1024 + head * 128, lam, om, sinks);
        } else {
            const bf16_t* Vt = (const bf16_t*)big; const bf16_t* Q = (const bf16_t*)(big + 2 * U72); const bf16_t* K = (const bf16_t*)(big + 2 * U72 + 108 * MiB);
            attn_unit<96, 64>(lds, Q + row0 * 1536 + head * 96, 1536, K + (size_t)b * TB * 1536 + head * 96, 1536, Vt + (size_t)(b * 16 + head) * 64 * TB,
                              Abuf + row0 * 1024 + head * 64, 1024, lt0, lt1, false, qpos0, -1e30f, 0.f);
        }
    }
}

__device__ __forceinline__ void hgrn_scan(unsigned char* big, bf16_t* OF, bf16_t* OB, LAS unsigned char* lds) {
    constexpr int GST = 132;
    constexpr int O_G = 0, O_QT = 34816, O_KT = O_QT + 17408, O_KTT = O_KT + 17408, O_VT = O_KTT + 18432, O_AB = O_VT + 18432, O_SEG = O_AB + 9216, O_GM = O_SEG + 2048, O_GL = O_GM + 512;
    const bf16_t* Qh = (const bf16_t*)big; const bf16_t* Vv = (const bf16_t*)(big + 3 * U72);
    const int tid = fresh_tid(), lane = tid & 63, r32 = lane & 31, hi = lane >> 5, wid = tid >> 6;
    LAS float* Gs = (LAS float*)(lds + O_G); LAS unsigned char* STb = lds + O_G;
    LAS unsigned char* QTb = lds + O_QT; LAS unsigned char* KTb = lds + O_KT; LAS unsigned short* KTT = (LAS unsigned short*)(lds + O_KTT); LAS unsigned short* VT = (LAS unsigned short*)(lds + O_VT);
    LAS unsigned short* AB = (LAS unsigned short*)(lds + O_AB); LAS float* SEG = (LAS float*)(lds + O_SEG); LAS float* GM = (LAS float*)(lds + O_GM); LAS float* GL = (LAS float*)(lds + O_GL);
    for (int u = fresh_bid(); u < 256; u += fresh_gdim()) {
        const int dir = u & 1, h = (u >> 1) & 7, b = u >> 4;
        const unsigned short* LFd = (const unsigned short*)(big + (dir == 0 ? U72 : 2 * U72));
        bf16_t* Od = dir == 0 ? OF : OB;
        f32x16 S[2];
#pragma unroll
        for (int nb = 0; nb < 2; ++nb)
#pragma unroll
            for (int r = 0; r < 16; ++r) S[nb][r] = 0.f;
        const int db = wid >> 1, eh = wid & 1, ti = wid >> 2, ei = wid & 3;
        u32x4 q8[2], lf8[2], v8[2];
#define HG_TOK(ci_, tp_) ((size_t)b * TB + (size_t)((dir == 0) ? (ci_) : ((ci_) < 4 ? 3 - (ci_) : 39 - (ci_))) * 64 + ((dir == 0) ? (tp_) : 63 - (tp_)))
#define HG_LOAD(ci_) do { _Pragma("unroll") for (int i_ = 0; i_ < 2; ++i_) { const int ch_ = tid + NTHR * i_; const int tp_ = ch_ & 63, dc_ = ch_ >> 6; const size_t o_ = HG_TOK(ci_, tp_) * 1024 + h * 128 + dc_ * 8; \
            q8[i_] = *(const GAS u32x4*)((const GAS bf16_t*)Qh + o_); lf8[i_] = *(const GAS u32x4*)((const GAS unsigned short*)LFd + o_); v8[i_] = *(const GAS u32x4*)((const GAS bf16_t*)Vv + o_); } } while (0)
        HG_LOAD(0);
        for (int ci = 0; ci < 36; ++ci) {
#pragma unroll
            for (int i = 0; i < 2; ++i) { const int ch = tid + NTHR * i, tp = ch & 63, dc = ch >> 6; LAS float* g = Gs + tp * GST + dc * 8;
#pragma unroll
                for (int k = 0; k < 4; ++k) { g[2 * k] = h2f((unsigned short)(lf8[i][k] & 0xffffu)); g[2 * k + 1] = h2f((unsigned short)(lf8[i][k] >> 16)); } }
            __syncthreads();
            { const int d = tid & 127, seg = tid >> 7; float run = 0.f;
#pragma unroll
              for (int t = 0; t < 16; ++t) { LAS float* g = Gs + (seg * 16 + t) * GST + d; run += *g; *g = run; }
              SEG[seg * 128 + d] = run; }
            __syncthreads();
#pragma unroll
            for (int i = 0; i < 2; ++i) { const int ch = tid + NTHR * i, tp = ch & 63, dc = ch >> 6, seg = tp >> 4;
                float qt[8], kt[8];
#pragma unroll
                for (int k = 0; k < 8; ++k) { const int d = dc * 8 + k; const float s0 = SEG[d], s1 = SEG[128 + d], s2 = SEG[256 + d];
                    const float off = (seg > 0 ? s0 : 0.f) + (seg > 1 ? s1 : 0.f) + (seg > 2 ? s2 : 0.f);
                    const float g = Gs[tp * GST + d] + off, gm = s0 + s1 + Gs[32 * GST + d];
                    const unsigned lw = lf8[i][k >> 1], qw = q8[i][k >> 1], vw = v8[i][k >> 1];
                    const float lf = h2f((unsigned short)((k & 1) ? (lw >> 16) : (lw & 0xffffu)));
                    const float qv = (k & 1) ? bfhi(qw) : bflo(qw);
                    const float kk = 1.f - __expf(lf);
                    qt[k] = qv * __expf(g - gm); kt[k] = kk * __expf(gm - g);
                    KTT[d * 72 + tp] = f2bf(kt[k]); VT[d * 72 + tp] = (unsigned short)((k & 1) ? (vw >> 16) : (vw & 0xffffu)); }
                *(LAS u32x4*)(QTb + tp * 272 + dc * 16) = (u32x4){pk2(qt[0], qt[1]), pk2(qt[2], qt[3]), pk2(qt[4], qt[5]), pk2(qt[6], qt[7])};
                *(LAS u32x4*)(KTb + tp * 272 + dc * 16) = (u32x4){pk2(kt[0], kt[1]), pk2(kt[2], kt[3]), pk2(kt[4], kt[5]), pk2(kt[6], kt[7])}; }
            if (tid < 128) { const float s0 = SEG[tid], s1 = SEG[128 + tid], s2 = SEG[256 + tid], s3 = SEG[384 + tid]; GM[tid] = s0 + s1 + Gs[32 * GST + tid]; GL[tid] = (s0 + s1) + (s2 + s3); }
            if (ci + 1 < 36) HG_LOAD(ci + 1);
            __syncthreads();
#pragma unroll
            for (int nb = 0; nb < 2; ++nb)
#pragma unroll
                for (int g4 = 0; g4 < 4; ++g4) { const int d0 = 32 * db + 8 * g4 + 4 * hi; const f32x4 gm4 = *(const LAS f32x4*)(GM + d0);
#pragma unroll
                    for (int k = 0; k < 4; ++k) S[nb][4 * g4 + k] *= __expf(gm4[k]);
                    *(LAS u32x2*)(STb + (64 * eh + 32 * nb + r32) * 272 + d0 * 2) = (u32x2){pk2(S[nb][4 * g4], S[nb][4 * g4 + 1]), pk2(S[nb][4 * g4 + 2], S[nb][4 * g4 + 3])}; }
            __syncthreads();
            f32x16 o;
#pragma unroll
            for (int r = 0; r < 16; ++r) o[r] = 0.f;
#pragma unroll
            for (int kk = 0; kk < 8; ++kk) { const bf16x8 a = *(const LAS bf16x8*)(QTb + (32 * ti + r32) * 272 + kk * 32 + hi * 16), bb = *(const LAS bf16x8*)(STb + (32 * ei + r32) * 272 + kk * 32 + hi * 16);
                o = __builtin_amdgcn_mfma_f32_32x32x16_bf16(a, bb, o, 0, 0, 0); }
            if (wid < 4) { const int ti2 = wid >> 1, si = wid & 1; f32x16 a2;
#pragma unroll
                for (int r = 0; r < 16; ++r) a2[r] = 0.f;
#pragma unroll
                for (int kk = 0; kk < 8; ++kk) { const bf16x8 a = *(const LAS bf16x8*)(QTb + (32 * ti2 + r32) * 272 + kk * 32 + hi * 16), bb = *(const LAS bf16x8*)(KTb + (32 * si + r32) * 272 + kk * 32 + hi * 16);
                    a2 = __builtin_amdgcn_mfma_f32_32x32x16_bf16(a, bb, a2, 0, 0, 0); }
#pragma unroll
                for (int r = 0; r < 16; ++r) { const int t = 32 * ti2 + crow(r, hi), s = 32 * si + r32; AB[t * 72 + s] = (t >= s) ? f2bf(a2[r]) : (unsigned short)0; } }
            __syncthreads();
#pragma unroll
            for (int kk = 0; kk < 4; ++kk) { const bf16x8 a = *(const LAS bf16x8*)((LAS unsigned char*)AB + (32 * ti + r32) * 144 + kk * 32 + hi * 16), bb = *(const LAS bf16x8*)((LAS unsigned char*)VT + (32 * ei + r32) * 144 + kk * 32 + hi * 16);
                o = __builtin_amdgcn_mfma_f32_32x32x16_bf16(a, bb, o, 0, 0, 0); }
#pragma unroll
            for (int r = 0; r < 16; ++r) { const int t = 32 * ti + crow(r, hi); ((GAS bf16_t*)Od)[HG_TOK(ci, t) * 1024 + h * 128 + 32 * ei + r32] = f2bf(o[r]); }
#pragma unroll
            for (int nb = 0; nb < 2; ++nb)
#pragma unroll
                for (int kk = 0; kk < 4; ++kk) { const bf16x8 a = *(const LAS bf16x8*)((LAS unsigned char*)KTT + (32 * db + r32) * 144 + kk * 32 + hi * 16), bb = *(const LAS bf16x8*)((LAS unsigned char*)VT + (64 * eh + 32 * nb + r32) * 144 + kk * 32 + hi * 16);
                    S[nb] = __builtin_amdgcn_mfma_f32_32x32x16_bf16(a, bb, S[nb], 0, 0, 0); }
#pragma unroll
            for (int g4 = 0; g4 < 4; ++g4) { const int d0 = 32 * db + 8 * g4 + 4 * hi; const f32x4 gm4 = *(const LAS f32x4*)(GM + d0), gl4 = *(const LAS f32x4*)(GL + d0);
#pragma unroll
                for (int k = 0; k < 4; ++k) { const float sc = __expf(gl4[k] - gm4[k]); S[0][4 * g4 + k] *= sc; S[1][4 * g4 + k] *= sc; } }
            __syncthreads();
        }
#undef HG_LOAD
#undef HG_TOK
    }
}


#define XB_TMO      128
#define XB_XCNT(j)  (256  + 64 * (j))
#define XB_XSUB(j)  (1280 + 64 * (j))
#define XB_XGEN(j)  (2304 + 64 * (j))
#define XB_TOP      3328
#define XB_TOPGEN   3392
#define XCD_BAR_WORDS 3456
#define XB_SPIN_CAP (1u << 18)

__device__ __forceinline__ unsigned xb_ld(unsigned* p)              { return __hip_atomic_load(p, __ATOMIC_RELAXED, __HIP_MEMORY_SCOPE_AGENT); }
__device__ __forceinline__ unsigned xb_add(unsigned* p, unsigned v) { return __hip_atomic_fetch_add(p, v, __ATOMIC_RELAXED, __HIP_MEMORY_SCOPE_AGENT); }
__device__ __forceinline__ unsigned xb_xcc_id() { return (unsigned)__builtin_amdgcn_s_getreg((3 << 11) | 20) & 0xFu; }
#define XB_SPIN(cond, bar) do { unsigned _sp = 0; while (cond) { __builtin_amdgcn_s_sleep(1); \
    if ((++_sp & 255u) == 0u) { if (xb_ld(&(bar)[XB_TMO])) break; if (_sp > XB_SPIN_CAP) { atomicAdd(&(bar)[XB_TMO], 1u); break; } } } } while (0)

struct XcdBarrier {
    unsigned* bar; unsigned x;
    volatile LAS unsigned* st;
};

__device__ __forceinline__ XcdBarrier xcd_barrier_post(unsigned* bar, volatile LAS unsigned* st) {
    XcdBarrier b; b.bar = bar; b.x = xb_xcc_id(); b.st = st;
    if (threadIdx.x == 0) (void)xb_add(&bar[XB_XCNT(b.x)], 1u);
    return b;
}
__device__ __forceinline__ void xcd_barrier_complete(unsigned* bar, unsigned x, unsigned& nloc, unsigned& nx) {
    const unsigned G = gridDim.x * gridDim.y * gridDim.z;
    unsigned sum, cnt, mine, sp = 0u;
    for (;;) {
        sum = 0u; cnt = 0u; mine = 0u;
#pragma unroll
        for (unsigned j = 0; j < 16; ++j) { const unsigned c = xb_ld(&bar[XB_XCNT(j)]); sum += c; cnt += (c > 0u) ? 1u : 0u; mine = (j == x) ? c : mine; }
        if (sum == G) break;
        __builtin_amdgcn_s_sleep(1);
        if ((++sp & 255u) == 0u) { if (xb_ld(&bar[XB_TMO])) break; if (sp > XB_SPIN_CAP) { atomicAdd(&bar[XB_TMO], 1u); break; } }
    }
    nloc = mine > 0u ? mine : 1u; nx = cnt > 0u ? cnt : 1u;
}

__device__ __forceinline__ void xcd_barrier(const XcdBarrier& b) {
    asm volatile("s_waitcnt vmcnt(0)" ::: "memory");
    __syncthreads();
    if (threadIdx.x == 0) {
        unsigned* bar = b.bar;
        __builtin_amdgcn_s_waitcnt(0);
        unsigned nloc = b.st[0], nx = b.st[1];
        if (nloc == 0u) { xcd_barrier_complete(bar, b.x, nloc, nx); b.st[0] = nloc; b.st[1] = nx; }
        const unsigned old = xb_add(&bar[XB_XSUB(b.x)], 1u);
        const unsigned gen = old / nloc;
        if (old + 1u == (gen + 1u) * nloc) {
            __builtin_amdgcn_fence(__ATOMIC_RELEASE, "agent");
            asm volatile("s_waitcnt vmcnt(0)" ::: "memory");
            const unsigned og = xb_add(&bar[XB_TOP], 1u);
            const unsigned tg = og / nx;
            if (og + 1u == (tg + 1u) * nx) xb_add(&bar[XB_TOPGEN], 1u);
            else XB_SPIN(xb_ld(&bar[XB_TOPGEN]) == tg, bar);
            __builtin_amdgcn_fence(__ATOMIC_ACQUIRE, "agent");
            xb_add(&bar[XB_XGEN(b.x)], 1u);
            asm volatile("s_waitcnt vmcnt(0)" ::: "memory");
        } else {
            XB_SPIN(xb_ld(&bar[XB_XGEN(b.x)]) == gen, bar);
            __builtin_amdgcn_fence(__ATOMIC_ACQUIRE, "agent");
            asm volatile("s_waitcnt vmcnt(0)" ::: "memory");
        }
    }
    __syncthreads();
}

enum { K_X = 0, K_C, K_CTX, K_CCTX, K_ADAW, K_ADAB, K_NORMW, K_FNORMW, K_FFNG, K_FFNU, K_FFND, K_GQAIN, K_GQAOUT, K_GQASINK, K_DIFFIN, K_DIFFOUT, K_DIFFLAM, K_DIFFSUB,
       K_HGRNIN, K_HGRNOUT, K_HGRNNORM, K_HGRNLB, K_MLADOWN, K_MLAQN, K_MLAKVN, K_MLAUQ, K_MLAUKV, K_MLAOUT, K_OUT, K_WS };
__device__ __forceinline__ const float* karg_ptr(int idx) {
    const __attribute__((address_space(4))) unsigned long long* ka = (const __attribute__((address_space(4))) unsigned long long*)__builtin_amdgcn_kernarg_segment_ptr();
    int i = idx; asm volatile("" : "+s"(i));
    return (const float*)ka[i];
}
__device__ __forceinline__ Params load_params() {
    Params q;
    const float** qq = (const float**)&q;
#pragma unroll
    for (int i = 0; i < 30; ++i) qq[i] = karg_ptr(i);
    q.ph_lo = 0; q.ph_hi = 0;
    return q;
}
__global__ void __launch_bounds__(NTHR, 2) fwd_megakernel(Params p) {
    extern __shared__ __attribute__((aligned(16))) unsigned char lds_raw[];
    LAS unsigned char* lds = (LAS unsigned char*)lds_raw;
    cg::grid_group grid = cg::this_grid();
    const int ph_lo = p.ph_lo, ph_hi = p.ph_hi;
    volatile LAS unsigned* bst = (volatile LAS unsigned*)(lds + LDS_BYTES - 64);
    if (threadIdx.x < 2) bst[threadIdx.x] = 0u;
    __syncthreads();
    XcdBarrier bar = xcd_barrier_post((unsigned*)((unsigned char*)karg_ptr(K_WS) + WS_BAR), bst);
    int nsync = 0;
#define GRID_SYNC() do { xcd_barrier(bar); ++nsync; } while (0)
    if (ph_lo < 0) grid.sync();
    int ph = 0;
#ifndef PH_MASK
#define PH_MASK 0xffffffffu
#endif
#define COMP(k) (((PH_MASK) >> (k)) & 1u)
#ifndef DUP_MASK
#define DUP_MASK 0u
#endif
#define NREP(k) (1 + (int)(((DUP_MASK) >> (k)) & 1u))
#define PHASE_BEGIN(k) if (ph >= ph_lo && ph < ph_hi) { unsigned char* dout = (unsigned char*)karg_ptr(K_OUT); unsigned char* ws = (unsigned char*)karg_ptr(K_WS); \
        unsigned char* big = ws + WS_BIG; float* HX = (float*)(ws + WS_HX); const float* mod = (const float*)(ws + WS_MOD); bf16_t* Abuf = (bf16_t*)(dout + DO_A); \
        const float* modl = mod + (size_t)layer * 17 * NMODV; (void)big; (void)HX; (void)modl; (void)Abuf; \
        for (int rep_ = 0; rep_ < NREP(k); ++rep_) { if (rep_) GRID_SYNC();
#define PHASE_END   } if (ph + 1 < ph_hi) GRID_SYNC(); } ++ph;
    int layer = 0;
    PHASE_BEGIN(0) if (COMP(0)) { const Params q = load_params(); prologue(q, lds); } PHASE_END
#pragma unroll 1
    for (layer = 0; layer < 4; ++layer) {
        const bool with_ctx = layer < 3;
        PHASE_BEGIN(1) if (COMP(1)) { { const Params q = load_params(); convert_weights(q, layer, lds, dout); } __syncthreads(); norm_phase(HX, karg_ptr(K_NORMW) + (size_t)layer * 3 * DM, modl, 0, 1, Abuf, (layer > 0 && rep_ == 0) ? (const float*)(big + 200 * MiB) : nullptr); } PHASE_END
        PHASE_BEGIN(2) if (COMP(2)) { EpiSwiglu E{(bf16_t*)big}; run_gemm(lds, Abuf, (const bf16_t*)(dout + W_F1GU), 2 * FF, DM, E); } PHASE_END
        PHASE_BEGIN(3) if (COMP(3)) { EpiResid E{HX, modl, 2, rep_ + 1 < NREP(3) ? 0.f : 0.5f, (float*)(big + 200 * MiB)}; run_gemm(lds, (const bf16_t*)big, (const bf16_t*)(dout + W_F1D), DM, FF, E, true, false); } PHASE_END
        PHASE_BEGIN(1) if (COMP(1)) norm_phase(HX, karg_ptr(K_NORMW) + (size_t)layer * 3 * DM + DM, modl, 3, 4, Abuf, rep_ == 0 ? (const float*)(big + 200 * MiB) : nullptr); PHASE_END
        if (layer == 0) {
            PHASE_BEGIN(4) if (COMP(4)) { EpiGqaIn E{(bf16_t*)big, (bf16_t*)(big + U72), (bf16_t*)(big + U72 + 18 * MiB), (const float*)(ws + WS_ROPEH)}; run_gemm(lds, Abuf, (const bf16_t*)(dout + W_MIN), 1536, DM, E); } PHASE_END
            PHASE_BEGIN(5) if (COMP(5)) attn_phase<0>(big, Abuf, karg_ptr(K_GQASINK), nullptr, lds, true); PHASE_END
        } else if (layer == 1) {
            PHASE_BEGIN(6) if (COMP(6)) { EpiDiffIn E{(bf16_t*)big, (bf16_t*)(big + U72), (bf16_t*)(big + 2 * U72), (const float*)(ws + WS_ROPEH)}; run_gemm(lds, Abuf, (const bf16_t*)(dout + W_MIN), 3072, DM, E); } PHASE_END
            PHASE_BEGIN(7) if (COMP(7)) attn_phase<1>(big, Abuf, karg_ptr(K_DIFFSUB), (const float*)(ws + WS_LAM), lds, true); PHASE_END
        } else if (layer == 2) {
            PHASE_BEGIN(9) if (COMP(9)) { EpiHgrnIn E{(bf16_t*)big, (unsigned short*)(big + U72), (unsigned short*)(big + 2 * U72), (bf16_t*)(big + 3 * U72), (bf16_t*)(big + 4 * U72), (const float*)(ws + WS_LB)};
                          run_gemm(lds, Abuf, (const bf16_t*)(dout + W_MIN), 5120, DM, E); } PHASE_END
            PHASE_BEGIN(10) if (COMP(10)) hgrn_scan(big, (bf16_t*)(ws + WS_END), Abuf, lds); PHASE_END
            PHASE_BEGIN(11) if (COMP(11)) hgrn_combine((const bf16_t*)(ws + WS_END), Abuf, (const bf16_t*)(big + 4 * U72), karg_ptr(K_HGRNNORM), Abuf); PHASE_END
        } else {
            PHASE_BEGIN(12) if (COMP(12)) { EpiF32 E{(float*)big, 768}; run_gemm(lds, Abuf, (const bf16_t*)(dout + W_MIN), 768, DM, E); } PHASE_END
            PHASE_BEGIN(13) if (COMP(13)) mla_rows((const float*)big, karg_ptr(K_MLAQN), karg_ptr(K_MLAKVN), (const float*)(ws + WS_ROPEM), (bf16_t*)(big + 108 * MiB), (bf16_t*)(big + 126 * MiB), (bf16_t*)(big + 2 * U72 + 108 * MiB)); PHASE_END
            PHASE_BEGIN(14) if (COMP(14)) { EpiMlaUq E1{(bf16_t*)(big + 2 * U72), (const float*)(ws + WS_ROPEM)}; run_gemm(lds, (const bf16_t*)(big + 108 * MiB), (const bf16_t*)(dout + W_UQ), 1536, 256, E1);
                          EpiMlaUkv E2{(bf16_t*)(big + 2 * U72 + 108 * MiB), (bf16_t*)big}; run_gemm(lds, (const bf16_t*)(big + 126 * MiB), (const bf16_t*)(dout + W_UKV), 2048, 256, E2); } PHASE_END
            PHASE_BEGIN(15) if (COMP(15)) attn_phase<3>(big, Abuf, karg_ptr(K_GQASINK), nullptr, lds, false); PHASE_END
        }
        PHASE_BEGIN(3) if (COMP(3)) { EpiResid E{HX, modl, 5, rep_ + 1 < NREP(3) ? 0.f : 1.0f, (float*)(big + 200 * MiB)}; run_gemm(lds, Abuf, (const bf16_t*)(dout + W_MOUT), DM, DM, E, true, layer == 3); } PHASE_END
        PHASE_BEGIN(1) if (COMP(1)) norm_phase(HX, karg_ptr(K_NORMW) + (size_t)layer * 3 * DM + 2 * DM, modl, 6, 7, Abuf, (layer < 3 && rep_ == 0) ? (const float*)(big + 200 * MiB) : nullptr, layer == 3); PHASE_END
        PHASE_BEGIN(2) if (COMP(2)) { EpiSwiglu E{(bf16_t*)big}; run_gemm(lds, Abuf, (const bf16_t*)(dout + W_F2GU), 2 * FF, DM, E, false, layer == 3); } PHASE_END
        PHASE_BEGIN(3) if (COMP(3)) { EpiResid E{HX, modl, 8, rep_ + 1 < NREP(3) ? 0.f : 0.5f, (float*)(big + 200 * MiB)}; run_gemm(lds, (const bf16_t*)big, (const bf16_t*)(dout + W_F2D), DM, FF, E, true, layer == 3); } PHASE_END
    }
    layer = 0;
    if (NREP(17) > 1) { for (int i = 0; i < 20; ++i) GRID_SYNC(); }
    PHASE_BEGIN(16) if (COMP(16)) final_phase(HX, karg_ptr(K_FNORMW), (float*)dout); PHASE_END
#undef PHASE_BEGIN
#undef PHASE_END
}

#ifndef MK_MULTI
#define MK_MULTI 0
#endif
constexpr int N_PHASES = 1 + (10 + 10 + 11 + 12) + 1;

extern "C" void kernel_launch(void* const* d_in, const int* in_sizes, int n_in, void* d_out, int out_size, void* d_ws, size_t ws_size, hipStream_t stream) {
    static int grid = 0;
    if (grid == 0) {
        if (n_in != 28 || ws_size < WS_END + U72 || out_size != NB * SQ * DM) { fprintf(stderr, "kernel_launch: unexpected sizes n_in %d out %d ws %zu\n", n_in, out_size, ws_size); grid = -1; return; }
        int dev = 0, cus = 0, per_cu = 0;
        hipGetDevice(&dev); hipDeviceGetAttribute(&cus, hipDeviceAttributeMultiprocessorCount, dev);
        if (hipFuncSetAttribute((const void*)fwd_megakernel, hipFuncAttributeMaxDynamicSharedMemorySize, LDS_BYTES) != hipSuccess) { fprintf(stderr, "kernel_launch: hipFuncSetAttribute failed\n"); grid = -1; return; }
        if (hipOccupancyMaxActiveBlocksPerMultiprocessor(&per_cu, (const void*)fwd_megakernel, NTHR, LDS_BYTES) != hipSuccess || per_cu < 1) { fprintf(stderr, "kernel_launch: occupancy query says %d\n", per_cu); per_cu = 1; }
        (void)hipGetLastError();
        grid = cus * (per_cu > 1 ? 1 : per_cu);
        if (grid != GRID) { fprintf(stderr, "kernel_launch: this kernel is built for a %d-workgroup cooperative grid (one per CU), device offers %d\n", GRID, grid); grid = -1; return; }
    }
    if (grid < 0) return;
    if (hipMemsetAsync((char*)d_ws + WS_BAR, 0, XCD_BAR_WORDS * 4, stream) != hipSuccess) { fprintf(stderr, "kernel_launch: memset failed\n"); return; }
    Params p{};
    const float** pp = (const float**)&p;
    for (int i = 0; i < 28; ++i) pp[i] = (const float*)d_in[i];
    p.out = (float*)d_out; p.ws = (unsigned char*)d_ws;
#if MK_MULTI
    for (int ph = 0; ph < N_PHASES; ++ph) { p.ph_lo = ph; p.ph_hi = ph + 1; hipLaunchKernelGGL(fwd_megakernel, dim3(grid), dim3(NTHR), LDS_BYTES, stream, p); }
#else
    p.ph_lo = 0; p.ph_hi = N_PHASES;
    void* args[] = {&p};
    hipError_t e = hipLaunchCooperativeKernel((const void*)fwd_megakernel, dim3(grid), dim3(NTHR), args, LDS_BYTES, stream);
    if (e != hipSuccess) fprintf(stderr, "cooperative launch failed: %s (grid %d)\n", hipGetErrorString(e), grid);
#endif
}
```

```cpp
#include <hip/hip_runtime.h>
#include <hip/hip_cooperative_groups.h>
#include <cstdio>
#include <cstdint>
namespace cg = cooperative_groups;
namespace pg8 {
#define PG8_LAS __attribute__((address_space(3)))
typedef unsigned short bf16_t;
typedef short bf16x8 __attribute__((ext_vector_type(8)));
typedef float f32x4 __attribute__((ext_vector_type(4)));
typedef unsigned u32x4 __attribute__((ext_vector_type(4)));
constexpr int BM = 256, BK = 64, HALF = 128, HTB = HALF * BK * 2  , STAGE_BYTES = 8 * HTB, NXCD = 8, WGM = 8;

__host__ __device__ __forceinline__ int lds_byte(int r, int c) { const int st = (r >> 4) * 2 + (c >> 5), rr = r & 15, cc = c & 31, ob = rr * 64 + cc * 2; return st * 1024 + (ob ^ (((ob >> 9) & 1) << 5)); }
__host__ __device__ __forceinline__ void stage_rc(int b, int& R, int& C) { const int st = b / 1024, sb = b % 1024, swz = sb ^ (((sb >> 9) & 1) << 5); R = (st >> 1) * 16 + swz / 64; C = (st & 1) * 32 + (swz % 64) / 2; }
__host__ __device__ __forceinline__ int perm32(int rho) { const int n = rho >> 4, i = rho & 15; return 8 * (i >> 2) + 4 * n + (i & 3); }

struct Unit { int pm, pn, k0, nk, part; };
struct Gemm { const bf16_t* A; const bf16_t* Bt; int M, N, K; };

struct StaticOrder {
    int nN, nwg, G, c, nt, nfull, S, nMf; bool lat;
    __host__ __device__ void init(int M, int N, int G_, int c_, int nt_, bool split, bool lat_) {
        const int nM = M / BM; nN = N / BM; nwg = nM * nN; G = G_; c = c_; nt = nt_; lat = lat_; nfull = nwg; S = 1;
        if (split) { const int rem = nwg % G; if (rem > 0 && rem * 2 <= G && ((nwg - rem) % nN) == 0) { S = G / rem; if (S > 4) S = 4; if (S > nt / 2) S = nt / 2; nfull = nwg - rem; } }
        nMf = nfull / nN;
    }
    __host__ __device__ bool next(int i, Unit& u) const {
        const long L = (long)i * G + c;
        int pm, pn, k0 = 0, nk = nt, part = -1; bool ok = true;
        if (L < nfull) {
            int wgid = (int)L;
            { const int q = nfull / NXCD, r = nfull % NXCD, xcd = wgid % NXCD, off = wgid / NXCD; wgid = (xcd < r ? xcd * (q + 1) : r * (q + 1) + (xcd - r) * q) + off; }
            const int nig = WGM * nN, gid = wgid / nig, fm = gid * WGM, gsz = (nMf - fm) < WGM ? (nMf - fm) : WGM;
            pm = fm + ((wgid % nig) % gsz); pn = (wgid % nig) / gsz;
        } else {
            const long q = L - nfull; const int t = (int)(q / S); part = (int)(q % S); ok = (nfull + t < nwg);
            pm = nMf + t / nN; pn = t % nN;
            const int pairs = nt / 2, base = pairs / S, extra = pairs % S; const int p0 = part * base + (part < extra ? part : extra), np = base + (part < extra ? 1 : 0); k0 = 2 * p0; nk = 2 * np;
        }
        if (lat) pm = (pm >> 3) * 9 + 1 + (pm & 7);
        u.pm = pm; u.pn = pn; u.k0 = k0; u.nk = nk; u.part = part;
        return ok;
    }
    __device__ __forceinline__ void a_ready(const Unit&) const {}
    __device__ __forceinline__ void done(const Unit&) const {}
};
template <class Epi, class Sched, bool ALIGN_EPI = false, bool SP2 = false>
__device__ __forceinline__ void gemm_phase(PG8_LAS unsigned char* lds, const Gemm g, const Sched& S, const Epi& E) {
    int tid_ = threadIdx.x; asm volatile("" : "+v"(tid_));
    const int tid = tid_, wid = __builtin_amdgcn_readfirstlane(tid >> 6), lane = tid & 63, wr = wid >> 2, wc = wid & 3, fr = lane & 15, fq = lane >> 4;
    const int K = g.K;
    unsigned voffA[2], voffB[2];
#pragma unroll
    for (int i = 0; i < 2; ++i) { int R, C; stage_rc(tid * 16 + i * 8192, R, C); const int Rb = Epi::PERM ? ((R & ~31) + perm32(R & 31)) : R;
        voffA[i] = (unsigned)(R * K + C) * 2u; voffB[i] = (unsigned)(Rb * K + C) * 2u; }
    const size_t kstep = (size_t)(BK * 2);
    const size_t hstep = (size_t)HALF * K * 2;
    const size_t tstep = 2 * hstep;
    const unsigned ldsw = (unsigned)wid * 1024u;
    const int aoff = lds_byte(wr * 64 + fr, fq * 8), boff = lds_byte(wc * 32 + fr, fq * 8);
#define PG8_SA(b, h) (((b) * 2 + (h)) * HTB)
#define PG8_SB(b, h) ((4 + (b) * 2 + (h)) * HTB)
#define PG8_STAGE(bufoff, gbase, voff) do { _Pragma("unroll") for (int _i = 0; _i < 2; ++_i) \
        __builtin_amdgcn_global_load_lds((const unsigned*)((const char*)(gbase) + (voff)[_i]), (PG8_LAS unsigned*)(lds + (bufoff) + ldsw + _i * 8192), 16, 0, 0); } while (0)
#define PG8_LDA(dst, b, h) do { _Pragma("unroll") for (int m = 0; m < 4; ++m) _Pragma("unroll") for (int k = 0; k < 2; ++k) dst[m][k] = *(const PG8_LAS bf16x8*)(lds + PG8_SA(b, h) + aoff + m * 2048 + k * 1024); } while (0)
#define PG8_LDB(dst, b, h) do { _Pragma("unroll") for (int n = 0; n < 2; ++n) _Pragma("unroll") for (int k = 0; k < 2; ++k) dst[n][k] = *(const PG8_LAS bf16x8*)(lds + PG8_SB(b, h) + boff + n * 2048 + k * 1024); } while (0)
#define PG8_MMA(ai, bj, At, Bt) do { __builtin_amdgcn_s_setprio(1); _Pragma("unroll") for (int m = 0; m < 4; ++m) _Pragma("unroll") for (int n = 0; n < 2; ++n) _Pragma("unroll") for (int k = 0; k < 2; ++k) \
        acc[ai][bj][m][n] = __builtin_amdgcn_mfma_f32_16x16x32_bf16(Bt[n][k], At[m][k], acc[ai][bj][m][n], 0, 0, 0); __builtin_amdgcn_s_setprio(0); } while (0)
#define PG8_WAIT_V(n) asm volatile("s_waitcnt vmcnt(" #n ")" ::: "memory")
#define PG8_WAIT_L(n) asm volatile("s_waitcnt lgkmcnt(" #n ")" ::: "memory")
#define PG8_BAR __builtin_amdgcn_s_barrier()
#define PG8_SCHED __builtin_amdgcn_sched_barrier(0)
    Unit cur, nxt; int ui = 0;
    if (!S.next(0, cur)) return;
    f32x4 acc[2][2][4][2];
#pragma unroll
    for (int a = 0; a < 2; ++a)
#pragma unroll
        for (int b = 0; b < 2; ++b)
#pragma unroll
            for (int m = 0; m < 4; ++m)
#pragma unroll
                for (int n = 0; n < 2; ++n) acc[a][b][m][n] = (f32x4){0.f, 0.f, 0.f, 0.f};
    bf16x8 At[4][2], B0[2][2], B1[2][2];
    const char* cA = (const char*)g.A + (size_t)cur.pm * tstep + (size_t)cur.k0 * kstep; const char* cB = (const char*)g.Bt + (size_t)cur.pn * tstep + (size_t)cur.k0 * kstep;
    S.a_ready(cur);
    if constexpr (SP2) {
        PG8_STAGE(PG8_SB(0, 0), cB, voffB); PG8_STAGE(PG8_SB(0, 1), cB + hstep, voffB); PG8_STAGE(PG8_SA(0, 0), cA, voffA); PG8_STAGE(PG8_SA(0, 1), cA + hstep, voffA);
        if (wr == 1) PG8_BAR;
        PG8_WAIT_V(2); PG8_BAR;
        PG8_STAGE(PG8_SB(1, 0), cB + kstep, voffB); PG8_STAGE(PG8_SA(1, 0), cA + kstep, voffA); PG8_STAGE(PG8_SB(1, 1), cB + hstep + kstep, voffB);
        PG8_WAIT_V(6); PG8_BAR;
    } else {
        PG8_STAGE(PG8_SB(0, 0), cB, voffB); PG8_STAGE(PG8_SA(0, 0), cA, voffA); PG8_STAGE(PG8_SB(0, 1), cB + hstep, voffB); PG8_STAGE(PG8_SA(0, 1), cA + hstep, voffA);
        if (wr == 1) PG8_BAR;
        PG8_WAIT_V(4); PG8_BAR;
        PG8_STAGE(PG8_SB(1, 0), cB + kstep, voffB); PG8_STAGE(PG8_SA(1, 0), cA + kstep, voffA); PG8_STAGE(PG8_SB(1, 1), cB + hstep + kstep, voffB);
        PG8_WAIT_V(6); PG8_BAR;
    }
    for (;;) {
        const bool has_next = S.next(ui + 1, nxt);
        const char* nA = has_next ? (const char*)g.A + (size_t)nxt.pm * tstep + (size_t)nxt.k0 * kstep : cA; const char* nB = has_next ? (const char*)g.Bt + (size_t)nxt.pn * tstep + (size_t)nxt.k0 * kstep : cB;
        const int nt = cur.nk;
#pragma unroll 1
        for (int t = 0; t < nt; t += 2) {
            const bool last = (t == nt - 2);
            const char* a1 = cA + (size_t)(t + 1) * kstep;
            const char* a2 = last ? nA : cA + (size_t)(t + 2) * kstep; const char* b2 = last ? nB : cB + (size_t)(t + 2) * kstep;
            const char* a3 = a2 + kstep; const char* b3 = b2 + kstep;
            if (last && has_next) S.a_ready(nxt);
            if constexpr (SP2) {
            PG8_LDB(B0, 0, 0); PG8_LDB(B1, 0, 1); PG8_SCHED; PG8_LDA(At, 0, 0); PG8_STAGE(PG8_SA(1, 1), a1 + hstep, voffA);
            PG8_WAIT_V(8); PG8_WAIT_L(0); PG8_BAR; PG8_MMA(0, 0, At, B0); PG8_MMA(0, 1, At, B1); PG8_BAR; PG8_SCHED;
            PG8_LDA(At, 0, 1); PG8_STAGE(PG8_SB(0, 0), b2, voffB); PG8_STAGE(PG8_SB(0, 1), b2 + hstep, voffB); PG8_STAGE(PG8_SA(0, 0), a2, voffA);
            PG8_WAIT_V(8); PG8_WAIT_L(0); PG8_BAR; PG8_MMA(1, 0, At, B0); PG8_MMA(1, 1, At, B1); PG8_BAR; PG8_SCHED;
            PG8_LDB(B0, 1, 0); PG8_LDB(B1, 1, 1); PG8_SCHED; PG8_LDA(At, 1, 0); PG8_STAGE(PG8_SA(0, 1), a2 + hstep, voffA);
            PG8_WAIT_V(8); PG8_WAIT_L(0); PG8_BAR; PG8_MMA(0, 0, At, B0); PG8_MMA(0, 1, At, B1); PG8_BAR; PG8_SCHED;
            PG8_LDA(At, 1, 1); PG8_STAGE(PG8_SB(1, 0), b3, voffB); PG8_STAGE(PG8_SB(1, 1), b3 + hstep, voffB); PG8_STAGE(PG8_SA(1, 0), a3, voffA);
            PG8_WAIT_V(8); PG8_WAIT_L(0); PG8_BAR; PG8_MMA(1, 0, At, B0); PG8_MMA(1, 1, At, B1); PG8_BAR; PG8_SCHED;
            } else {
            PG8_LDB(B0, 0, 0); PG8_SCHED; PG8_LDA(At, 0, 0); PG8_STAGE(PG8_SA(1, 1), a1 + hstep, voffA);
            PG8_WAIT_L(8); PG8_BAR; PG8_WAIT_L(0); PG8_MMA(0, 0, At, B0); PG8_BAR; PG8_SCHED;
            PG8_LDB(B1, 0, 1); PG8_STAGE(PG8_SB(0, 0), b2, voffB);
            PG8_BAR; PG8_WAIT_L(0); PG8_MMA(0, 1, At, B1); PG8_BAR;
            PG8_LDA(At, 0, 1); PG8_STAGE(PG8_SA(0, 0), a2, voffA);
            PG8_BAR; PG8_WAIT_L(0); PG8_MMA(1, 0, At, B0); PG8_BAR; PG8_SCHED;
            PG8_STAGE(PG8_SB(0, 1), b2 + hstep, voffB);
            PG8_WAIT_V(6); PG8_BAR; PG8_MMA(1, 1, At, B1); PG8_BAR;
            PG8_LDB(B0, 1, 0); PG8_SCHED; PG8_LDA(At, 1, 0); PG8_STAGE(PG8_SA(0, 1), a2 + hstep, voffA);
            PG8_WAIT_L(8); PG8_BAR; PG8_WAIT_L(0); PG8_MMA(0, 0, At, B0); PG8_BAR; PG8_SCHED;
            PG8_LDB(B1, 1, 1); PG8_STAGE(PG8_SB(1, 0), b3, voffB);
            PG8_BAR; PG8_WAIT_L(0); PG8_MMA(0, 1, At, B1); PG8_BAR;
            PG8_LDA(At, 1, 1); PG8_STAGE(PG8_SA(1, 0), a3, voffA);
            PG8_BAR; PG8_WAIT_L(0); PG8_MMA(1, 0, At, B0); PG8_BAR; PG8_SCHED;
            PG8_STAGE(PG8_SB(1, 1), b3 + hstep, voffB);
            PG8_WAIT_V(6); PG8_BAR; PG8_MMA(1, 1, At, B1); PG8_BAR;
            }
        }
        if constexpr (ALIGN_EPI) { if (wr == 0) PG8_BAR; }
        if constexpr (!Epi::AFTER_DRAIN) { E(acc, cur, wr, wc, fr, fq); S.done(cur); }
        if (!has_next) break;
#pragma unroll
        for (int a = 0; a < 2; ++a)
#pragma unroll
            for (int b = 0; b < 2; ++b)
#pragma unroll
                for (int m = 0; m < 4; ++m)
#pragma unroll
                    for (int n = 0; n < 2; ++n) acc[a][b][m][n] = (f32x4){0.f, 0.f, 0.f, 0.f};
        cur = nxt; cA = nA; cB = nB; ++ui;
        if constexpr (ALIGN_EPI) { if (wr == 1) PG8_BAR; }
    }
    PG8_WAIT_V(0);
    if constexpr (!ALIGN_EPI) { if (wr == 0) PG8_BAR; }
    PG8_BAR;
    if constexpr (Epi::AFTER_DRAIN) { E.fused(acc, cur, wr, wc, fr, fq, lds, wid, lane); S.done(cur); }
#undef PG8_SA
#undef PG8_SB
#undef PG8_STAGE
#undef PG8_LDA
#undef PG8_LDB
#undef PG8_MMA
#undef PG8_WAIT_V
#undef PG8_WAIT_L
#undef PG8_BAR
#undef PG8_SCHED
}
}

#define LAS __attribute__((address_space(3)))
#define GAS __attribute__((address_space(1)))
using pg8::bf16_t; using pg8::bf16x8; using pg8::f32x4; using pg8::u32x4;
typedef float f32x16 __attribute__((ext_vector_type(16)));
typedef unsigned u32x2 __attribute__((ext_vector_type(2)));
typedef float f32x2v __attribute__((ext_vector_type(2)));
typedef __bf16 bf16x2v __attribute__((ext_vector_type(2)));

constexpr int NB = 16, SQ = 2048, CL = 256, TB = SQ + CL, TT = NB * TB, DM = 1024, FF = 2816, NMODV = 9216;
constexpr int NTHR = 512, GRID = 256;
constexpr size_t MiB = (size_t)1 << 20;
constexpr size_t U72 = 72 * MiB;
constexpr size_t WS_MOD = 0;
constexpr size_t WS_ROPEH = 3 * MiB;
constexpr size_t WS_ROPEM = 3 * MiB + 512 * 1024;
constexpr size_t WS_LB = 3 * MiB + 768 * 1024;
constexpr size_t WS_LAM = WS_LB + 4096;
constexpr size_t WS_BAR = 4 * MiB - 64 * 1024;
constexpr size_t WS_HX = 4 * MiB;
constexpr size_t WS_BIG = 148 * MiB;
constexpr size_t WS_END = 508 * MiB;
constexpr size_t DO_A = 0;
constexpr size_t DO_W = 72 * MiB;
constexpr size_t W_F1GU = DO_W, W_F1D = DO_W + 11 * MiB, W_F2GU = DO_W + 33 * MiB / 2, W_F2D = DO_W + 55 * MiB / 2;
constexpr size_t W_MIN = DO_W + 33 * MiB, W_MOUT = DO_W + 43 * MiB, W_UQ = DO_W + 45 * MiB, W_UKV = DO_W + 46 * MiB;
constexpr int LDS_BYTES = 147456;
constexpr float LOG2E = 1.4426950408889634f;

struct Params {
    const float *x, *c, *ctx, *c_ctx, *ada_w, *ada_b, *norm_w, *final_norm_w, *ffn_g, *ffn_u, *ffn_d,
        *gqa_in, *gqa_out, *gqa_sinks, *diff_in, *diff_out, *diff_lambda, *diff_subln,
        *hgrn_in, *hgrn_out, *hgrn_norm, *hgrn_lb, *mla_down, *mla_qn, *mla_kvn, *mla_uq, *mla_ukv, *mla_out;
    float* out; unsigned char* ws; int ph_lo, ph_hi;
};

__device__ __forceinline__ int fresh_bid() { int t = blockIdx.x; asm volatile("" : "+s"(t)); return t; }
__device__ __forceinline__ int fresh_gdim() { int t = gridDim.x; asm volatile("" : "+s"(t)); return t; }
__device__ __forceinline__ int fresh_tid() { int t = threadIdx.x; asm volatile("" : "+v"(t)); return t; }
__device__ __forceinline__ unsigned pk2(float lo, float hi) { f32x2v v = {lo, hi}; bf16x2v b = __builtin_convertvector(v, bf16x2v); return __builtin_bit_cast(unsigned, b); }
__device__ __forceinline__ unsigned short f2bf(float f) { return (unsigned short)(pk2(f, 0.f) & 0xffffu); }
__device__ __forceinline__ float bf2f(unsigned short u) { return __uint_as_float((unsigned)u << 16); }
__device__ __forceinline__ float bflo(unsigned w) { return __uint_as_float(w << 16); }
__device__ __forceinline__ float bfhi(unsigned w) { return __uint_as_float(w & 0xffff0000u); }
__device__ __forceinline__ unsigned short f2h(float f) { _Float16 h = (_Float16)f; return __builtin_bit_cast(unsigned short, h); }
__device__ __forceinline__ float h2f(unsigned short u) { return (float)__builtin_bit_cast(_Float16, u); }
__device__ __forceinline__ float silu_f(float v) { return v * __builtin_amdgcn_rcpf(1.f + __expf(-v)); }
__device__ __forceinline__ float wave_sum(float v) {
#pragma unroll
    for (int o = 1; o < 64; o <<= 1) v += __shfl_xor(v, o);
    return v;
}
__device__ __forceinline__ int crow(int r, int hi) { return (r & 3) + 8 * (r >> 2) + 4 * hi; }
__device__ __forceinline__ void store4bf(bf16_t* p, f32x4 v) { u32x2 w; w.x = pk2(v[0], v[1]); w.y = pk2(v[2], v[3]); *(GAS u32x2*)p = w; }
__device__ __forceinline__ f32x4 ldg4(const float* p) { return *(const GAS f32x4*)p; }
__device__ __forceinline__ void stg4(float* p, f32x4 v) { *(GAS f32x4*)p = v; }

template <class F> __device__ __forceinline__ void epi_loop(const f32x4 (&acc)[2][2][4][2], const pg8::Unit& u, int wr, int wc, int fr, int fq, const F& f) {
#pragma unroll
    for (int ai = 0; ai < 2; ++ai)
#pragma unroll
        for (int m = 0; m < 4; ++m) {
            const int row = u.pm * 256 + ai * 128 + wr * 64 + m * 16 + fr;
#pragma unroll
            for (int bj = 0; bj < 2; ++bj) f.item(row, u.pn * 256 + bj * 128 + wc * 32 + 4 * fq, acc[ai][bj][m][0], acc[ai][bj][m][1]);
        }
}
struct EpiSwiglu {
    static constexpr bool PERM = true, AFTER_DRAIN = false;
    bf16_t* H;
    __device__ __forceinline__ void operator()(const f32x4 (&acc)[2][2][4][2], const pg8::Unit& u, int wr, int wc, int fr, int fq) const {
        const int row0 = u.pm * 256 + wr * 64 + fr, col0 = u.pn * 128 + wc * 32 + 8 * fq;
#pragma unroll
        for (int ai = 0; ai < 2; ++ai)
#pragma unroll
            for (int m = 0; m < 4; ++m) {
                bf16_t* rp = H + (size_t)(row0 + ai * 128 + m * 16) * FF + col0;
                const f32x4 g0 = acc[ai][0][m][0], g1 = acc[ai][0][m][1], u0 = acc[ai][1][m][0], u1 = acc[ai][1][m][1];
                u32x4 w;
                w.x = pk2(silu_f(g0[0]) * u0[0], silu_f(g0[1]) * u0[1]); w.y = pk2(silu_f(g0[2]) * u0[2], silu_f(g0[3]) * u0[3]);
                w.z = pk2(silu_f(g1[0]) * u1[0], silu_f(g1[1]) * u1[1]); w.w = pk2(silu_f(g1[2]) * u1[2], silu_f(g1[3]) * u1[3]);
                *(GAS u32x4*)rp = w;
                asm volatile("" ::: "memory");
            }
    }
};
constexpr int SPLIT_PM0 = 128, SPLIT_ROWS = 4096;
struct EpiResid {
    static constexpr bool PERM = false, AFTER_DRAIN = false;
    float* HX; const float* modl; int midx; float coef; float* P;
    __device__ __forceinline__ void operator()(const f32x4 (&acc)[2][2][4][2], const pg8::Unit& u, int wr, int wc, int fr, int fq) const {
        const int bi = u.pm / 9, mr = (u.pm - bi * 9) == 0 ? 16 : bi;
        const int col0 = u.pn * 256 + wc * 32 + 4 * fq;
        const float* g = modl + (size_t)mr * NMODV + midx * 1024 + col0;
        f32x4 gv[2][2];
#pragma unroll
        for (int bj = 0; bj < 2; ++bj)
#pragma unroll
            for (int n = 0; n < 2; ++n) gv[bj][n] = coef * ldg4(g + bj * 128 + n * 16);
        if (u.part < 0) {
#pragma unroll
            for (int ai = 0; ai < 2; ++ai)
#pragma unroll
                for (int m = 0; m < 4; ++m) {
                    float* hp = HX + (size_t)(u.pm * 256 + ai * 128 + wr * 64 + m * 16 + fr) * DM + col0;
#pragma unroll
                    for (int bj = 0; bj < 2; ++bj)
#pragma unroll
                        for (int n = 0; n < 2; ++n) { float* h = hp + bj * 128 + n * 16; stg4(h, ldg4(h) + gv[bj][n] * acc[ai][bj][m][n]); }
                }
        } else {
#pragma unroll
            for (int ai = 0; ai < 2; ++ai)
#pragma unroll
                for (int m = 0; m < 4; ++m) {
                    bf16_t* hp = (bf16_t*)P + ((size_t)u.part * SPLIT_ROWS + (size_t)((u.pm - SPLIT_PM0) * 256 + ai * 128 + wr * 64 + m * 16 + fr)) * DM + col0;
#pragma unroll
                    for (int bj = 0; bj < 2; ++bj)
#pragma unroll
                        for (int n = 0; n < 2; ++n) store4bf(hp + bj * 128 + n * 16, gv[bj][n] * acc[ai][bj][m][n]);
                    if (m & 1) asm volatile("" ::: "memory");
                }
        }
    }
};
__device__ __forceinline__ void rope64(f32x4& a, f32x4& b, const float* tab, int s, int col) {
    const int half = (col >> 5) & 1, i0 = col & 31;
    const GAS f32x4* tp = (const GAS f32x4*)(tab + ((size_t)s * 32 + half * 16 + i0) * 2);
    const f32x4 t0 = tp[0], t1 = tp[1];
    f32x4 na, nb;
    na[0] = a[0] * t0[0] - b[0] * t0[1]; nb[0] = b[0] * t0[0] + a[0] * t0[1];
    na[1] = a[1] * t0[2] - b[1] * t0[3]; nb[1] = b[1] * t0[2] + a[1] * t0[3];
    na[2] = a[2] * t1[0] - b[2] * t1[1]; nb[2] = b[2] * t1[0] + a[2] * t1[1];
    na[3] = a[3] * t1[2] - b[3] * t1[3]; nb[3] = b[3] * t1[2] + a[3] * t1[3];
    a = na; b = nb;
}
__device__ __forceinline__ void store_vt(bf16_t* vt, const f32x4& a, const f32x4& b) {
#pragma unroll
    for (int j = 0; j < 4; ++j) ((GAS bf16_t*)vt)[(size_t)j * TB] = f2bf(a[j]);
    asm volatile("" ::: "memory");
    GAS bf16_t* v2 = (GAS bf16_t*)vt + (size_t)16 * TB;
#pragma unroll
    for (int j = 0; j < 4; ++j) v2[(size_t)j * TB] = f2bf(b[j]);
    asm volatile("" ::: "memory");
}
struct EpiGqaIn {
    static constexpr bool PERM = false, AFTER_DRAIN = false;
    bf16_t *Q, *K, *Vt; const float* ropeH;
    __device__ __forceinline__ void item(int row, int col, const f32x4& a_, const f32x4& b_) const {
        f32x4 a = a_, b = b_; const int bi = row / TB, t = row - bi * TB;
        if (col < 1280) {
            if (t >= CL) rope64(a, b, ropeH, t - CL, col);
            if (col < 1024) { const float c2 = 0.125f * LOG2E; a = a * c2; b = b * c2; bf16_t* q = Q + (size_t)row * 1024 + col; store4bf(q, a); store4bf(q + 16, b); }
            else { bf16_t* k = K + (size_t)row * 256 + (col - 1024); store4bf(k, a); store4bf(k + 16, b); }
        } else { const int cv = col - 1280, head = cv >> 6, dv = cv & 63; store_vt(Vt + ((size_t)(bi * 4 + head) * 64 + dv) * TB + t, a, b); }
    }
    __device__ __forceinline__ void operator()(const f32x4 (&acc)[2][2][4][2], const pg8::Unit& u, int wr, int wc, int fr, int fq) const { epi_loop(acc, u, wr, wc, fr, fq, *this); }
};
struct EpiDiffIn {
    static constexpr bool PERM = false, AFTER_DRAIN = false;
    bf16_t *Q, *K, *Vt; const float* ropeH;
    __device__ __forceinline__ void item(int row, int col, const f32x4& a_, const f32x4& b_) const {
        f32x4 a = a_, b = b_; const int bi = row / TB, t = row - bi * TB;
        if (col < 2048) {
            if (t >= CL) rope64(a, b, ropeH, t - CL, col);
            if (col < 1024) { const float c2 = 0.125f * LOG2E; a = a * c2; b = b * c2; bf16_t* q = Q + (size_t)row * 1024 + col; store4bf(q, a); store4bf(q + 16, b); }
            else { bf16_t* k = K + (size_t)row * 1024 + (col - 1024); store4bf(k, a); store4bf(k + 16, b); }
        } else { const int cv = col - 2048, head = cv >> 7, dv = cv & 127; store_vt(Vt + ((size_t)(bi * 8 + head) * 128 + dv) * TB + t, a, b); }
    }
    __device__ __forceinline__ void operator()(const f32x4 (&acc)[2][2][4][2], const pg8::Unit& u, int wr, int wc, int fr, int fq) const { epi_loop(acc, u, wr, wc, fr, fq, *this); }
};
struct EpiHgrnIn {
    static constexpr bool PERM = false, AFTER_DRAIN = false;
    bf16_t* Qh; unsigned short *LF, *LB; bf16_t *V, *Gt; const float* lb;
    __device__ __forceinline__ void item(int row, int col, const f32x4& a, const f32x4& b) const {
        const int sec = col >> 10, cc = col & 1023; const size_t o = (size_t)row * 1024 + cc;
        if (sec == 0 || sec == 4) { f32x4 x, y;
#pragma unroll
            for (int j = 0; j < 4; ++j) { x[j] = silu_f(a[j]); y[j] = silu_f(b[j]); }
            bf16_t* d = (sec == 0 ? Qh : Gt) + o; store4bf(d, x); store4bf(d + 16, y);
        } else if (sec == 3) { store4bf(V + o, a); store4bf(V + o + 16, b); }
        else { unsigned short* d = (sec == 1 ? LF : LB) + o; const f32x4 la = ldg4(lb + cc), lbb = ldg4(lb + cc + 16);
            unsigned short ha[4], hb[4];
#pragma unroll
            for (int j = 0; j < 4; ++j) { const float fa = la[j] + (1.f - la[j]) * __builtin_amdgcn_rcpf(1.f + __expf(-a[j])), fb = lbb[j] + (1.f - lbb[j]) * __builtin_amdgcn_rcpf(1.f + __expf(-b[j]));
                ha[j] = f2h(__builtin_amdgcn_logf(fa) * 0.6931471805599453f); hb[j] = f2h(__builtin_amdgcn_logf(fb) * 0.6931471805599453f); }
            u32x2 w; w.x = ha[0] | ((unsigned)ha[1] << 16); w.y = ha[2] | ((unsigned)ha[3] << 16); *(GAS u32x2*)d = w;
            w.x = hb[0] | ((unsigned)hb[1] << 16); w.y = hb[2] | ((unsigned)hb[3] << 16); *(GAS u32x2*)(d + 16) = w; }
    }
    __device__ __forceinline__ void operator()(const f32x4 (&acc)[2][2][4][2], const pg8::Unit& u, int wr, int wc, int fr, int fq) const { epi_loop(acc, u, wr, wc, fr, fq, *this); }
};
struct EpiF32 {
    static constexpr bool PERM = false, AFTER_DRAIN = false;
    float* O; int ld;
    __device__ __forceinline__ void item(int row, int col, const f32x4& a, const f32x4& b) const { float* d = O + (size_t)row * ld + col; stg4(d, a); stg4(d + 16, b); }
    __device__ __forceinline__ void operator()(const f32x4 (&acc)[2][2][4][2], const pg8::Unit& u, int wr, int wc, int fr, int fq) const { epi_loop(acc, u, wr, wc, fr, fq, *this); }
};
struct EpiMlaUq {
    static constexpr bool PERM = false, AFTER_DRAIN = false;
    bf16_t* Q; const float* ropeM;
    __device__ __forceinline__ void half(f32x4& a, const float* tp, bool first) const {
        const f32x4 t0 = ldg4(tp), t1 = ldg4(tp + 4);
        f32x4 pa;
#pragma unroll
        for (int j = 0; j < 4; ++j) { pa[j] = __shfl_xor(a[j], 32); if (first) pa[j] = -pa[j]; }
        a[0] = a[0] * t0[0] + pa[0] * t0[1]; a[1] = a[1] * t0[2] + pa[1] * t0[3]; a[2] = a[2] * t1[0] + pa[2] * t1[1]; a[3] = a[3] * t1[2] + pa[3] * t1[3];
    }
    __device__ __forceinline__ void item(int row, int col, const f32x4& a_, const f32x4& b_) const {
        f32x4 a = a_, b = b_; const int bi = row / TB, t = row - bi * TB; const int g32 = col >> 5;
        const float c2 = 0.10206207261596577f * LOG2E;
        bf16_t* q = Q + (size_t)row * 1536 + col;
        const bool rot = (g32 % 3) == 2 && t >= CL;
        const int fq = (col & 15) >> 2; const bool first = fq < 2; const int i0 = 4 * (fq & 1);
        const float* tp = ropeM + ((size_t)(rot ? t - CL : 0) * 16 + i0) * 2;
        if (rot) half(a, tp, first);
        a = a * c2; store4bf(q, a);
        asm volatile("" ::: "memory");
        if (rot) half(b, tp + 16, first);
        b = b * c2; store4bf(q + 16, b);
        asm volatile("" ::: "memory");
    }
    __device__ __forceinline__ void operator()(const f32x4 (&acc)[2][2][4][2], const pg8::Unit& u, int wr, int wc, int fr, int fq) const { epi_loop(acc, u, wr, wc, fr, fq, *this); }
};
struct EpiMlaUkv {
    static constexpr bool PERM = false, AFTER_DRAIN = false;
    bf16_t *K, *Vt;
    __device__ __forceinline__ void item(int row, int col, const f32x4& a, const f32x4& b) const {
        const int bi = row / TB, t = row - bi * TB; const int head = col >> 7, x = col & 127;
        if (x < 64) { bf16_t* k = K + (size_t)row * 1536 + head * 96 + x; store4bf(k, a); store4bf(k + 16, b); }
        else store_vt(Vt + ((size_t)(bi * 16 + head) * 64 + (x - 64)) * TB + t, a, b);
    }
    __device__ __forceinline__ void operator()(const f32x4 (&acc)[2][2][4][2], const pg8::Unit& u, int wr, int wc, int fr, int fq) const { epi_loop(acc, u, wr, wc, fr, fq, *this); }
};

template <class Epi> __device__ __forceinline__ void run_gemm(LAS unsigned char* lds, const bf16_t* A, const bf16_t* Bt, int N, int K, const Epi& E, bool split = false, bool lat = false) {
    pg8::Gemm g{A, Bt, lat ? NB * SQ : TT, N, K}; pg8::StaticOrder S; S.init(lat ? NB * SQ : TT, N, GRID, fresh_bid(), K / 64, split, lat);
    pg8::gemm_phase<Epi, pg8::StaticOrder, true, true>(lds, g, S, E);
}

__device__ __forceinline__ void transpose_item(const float* W, int K, int N, bf16_t* WT, int mode, LAS float* scr, int item, int lane) {
    const int nblk = N / 32, kb = item / nblk, nb = item - kb * nblk, k0 = 64 * kb, n0 = 32 * nb;
#pragma unroll 8
    for (int i = 0; i < 32; ++i) { const int kk = 2 * i + (lane >> 5); scr[kk * 33 + (lane & 31)] = W[(size_t)(k0 + kk) * N + n0 + (lane & 31)]; }
    asm volatile("s_waitcnt lgkmcnt(0)" ::: "memory");
    const int drow0 = mode == 0 ? n0 : (n0 >> 7) * 256 + (n0 & 127) + (mode == 2 ? 128 : 0);
    const int c = lane & 7;
#pragma unroll
    for (int j = 0; j < 4; ++j) { const int n = (lane >> 3) + 8 * j; const LAS float* s = scr + (8 * c) * 33 + n;
        u32x4 o; o.x = pk2(s[0 * 33], s[1 * 33]); o.y = pk2(s[2 * 33], s[3 * 33]); o.z = pk2(s[4 * 33], s[5 * 33]); o.w = pk2(s[6 * 33], s[7 * 33]);
        *(u32x4*)(WT + (size_t)(drow0 + n) * K + k0 + 8 * c) = o; }
    asm volatile("s_waitcnt lgkmcnt(0)" ::: "memory");
}
__device__ __forceinline__ void conv_job(const float* W, int K, int N, bf16_t* WT, int mode, LAS float* scr, int gw, int NGW, int lane, int& base) {
    const int n = (K / 64) * (N / 32);
    int it = gw - (base % NGW); if (it < 0) it += NGW;
    for (; it < n; it += NGW) transpose_item(W, K, N, WT, mode, scr, it, lane);
    base += n;
}
__device__ __forceinline__ void convert_weights(const Params& p, int layer, LAS unsigned char* lds, unsigned char* dout) {
    const int tid = fresh_tid(), lane = tid & 63, wave = tid >> 6;
    const int gw = fresh_bid() * 8 + wave, NGW = fresh_gdim() * 8;
    LAS float* scr = (LAS float*)(lds + wave * 16384);
    int base = 0;
    const size_t fgu = (size_t)DM * FF;
    for (int f = 0; f < 2; ++f) {
        const size_t off = ((size_t)layer * 2 + f) * fgu;
        bf16_t* gu = (bf16_t*)(dout + (f == 0 ? W_F1GU : W_F2GU)); bf16_t* dn = (bf16_t*)(dout + (f == 0 ? W_F1D : W_F2D));
        conv_job(p.ffn_g + off, DM, FF, gu, 1, scr, gw, NGW, lane, base);
        conv_job(p.ffn_u + off, DM, FF, gu, 2, scr, gw, NGW, lane, base);
        conv_job(p.ffn_d + off, FF, DM, dn, 0, scr, gw, NGW, lane, base);
    }
    bf16_t* win = (bf16_t*)(dout + W_MIN); bf16_t* wout = (bf16_t*)(dout + W_MOUT);
    if (layer == 0) { conv_job(p.gqa_in, DM, 1536, win, 0, scr, gw, NGW, lane, base); conv_job(p.gqa_out, DM, DM, wout, 0, scr, gw, NGW, lane, base); }
    else if (layer == 1) { conv_job(p.diff_in, DM, 3072, win, 0, scr, gw, NGW, lane, base); conv_job(p.diff_out, DM, DM, wout, 0, scr, gw, NGW, lane, base); }
    else if (layer == 2) { conv_job(p.hgrn_in, DM, 5120, win, 0, scr, gw, NGW, lane, base); conv_job(p.hgrn_out, DM, DM, wout, 0, scr, gw, NGW, lane, base); }
    else {
        conv_job(p.mla_down, DM, 544, win, 0, scr, gw, NGW, lane, base);
        conv_job(p.mla_uq, 256, 1536, (bf16_t*)(dout + W_UQ), 0, scr, gw, NGW, lane, base);
        conv_job(p.mla_ukv, 256, 2048, (bf16_t*)(dout + W_UKV), 0, scr, gw, NGW, lane, base);
        conv_job(p.mla_out, DM, DM, wout, 0, scr, gw, NGW, lane, base);
    }
}

__device__ __forceinline__ void prologue(const Params& p, LAS unsigned char* lds) {
    const int tid = fresh_tid(), G = fresh_gdim(), bid = fresh_bid();
    float* HX = (float*)(p.ws + WS_HX);
    for (size_t i = (size_t)bid * NTHR + tid; i < (size_t)TT * 256; i += (size_t)G * NTHR) {
        const int row = (int)(i >> 8), c4 = (int)(i & 255); const int b = row / TB, t = row - b * TB;
        const float* src = t < CL ? p.ctx + ((size_t)(b * CL + t)) * DM : p.x + ((size_t)(b * SQ + t - CL)) * DM;
        ((f32x4*)HX)[i] = ((const f32x4*)src)[c4];
    }
    float* ropeH = (float*)(p.ws + WS_ROPEH); float* ropeM = (float*)(p.ws + WS_ROPEM);
    for (int i = bid * NTHR + tid; i < 2048 * 32; i += G * NTHR) { const int s = i >> 5, e = i & 31; const float pos = (e < 16) ? (float)(s >> 6) : (float)(s & 63);
        const float inv = powf(10000.f, -(float)(2 * (e & 15)) / 32.f); const float ang = pos * inv; ropeH[2 * i] = cosf(ang); ropeH[2 * i + 1] = sinf(ang); }
    for (int i = bid * NTHR + tid; i < 2048 * 16; i += G * NTHR) { const int s = i >> 4, e = i & 15; const float pos = (e < 8) ? (float)(s >> 6) : (float)(s & 63);
        const float inv = powf(10000.f, -(float)(2 * (e & 7)) / 16.f); const float ang = pos * inv; ropeM[2 * i] = cosf(ang); ropeM[2 * i + 1] = sinf(ang); }
    if (bid == 0) {
        float* lbv = (float*)(p.ws + WS_LB);
        for (int d = tid; d < 1024; d += NTHR) { const float a0 = p.hgrn_lb[d], a1 = p.hgrn_lb[1024 + d], a2 = p.hgrn_lb[2048 + d], a3 = p.hgrn_lb[3072 + d];
            const float mx = fmaxf(fmaxf(a0, a1), fmaxf(a2, a3)); const float e0 = expf(a0 - mx), e1 = expf(a1 - mx), e2 = expf(a2 - mx), e3 = expf(a3 - mx);
            lbv[d] = (e1 + e2) / (e0 + e1 + e2 + e3); }
        if (tid == 0) { float s1 = 0.f, s2 = 0.f; for (int d = 0; d < 64; ++d) { s1 += p.diff_lambda[d] * p.diff_lambda[64 + d]; s2 += p.diff_lambda[128 + d] * p.diff_lambda[192 + d]; }
            const float lambda_init = 0.8f - 0.6f * expf(-0.3f);
            ((float*)(p.ws + WS_LAM))[0] = expf(s1) - expf(s2) + lambda_init; ((float*)(p.ws + WS_LAM))[1] = lambda_init; }
    }
    LAS float* sS = (LAS float*)lds; LAS float* red = (LAS float*)(lds + 17 * 1024 * 4);
    for (int i = tid; i < 17 * 1024; i += NTHR) { const int r = i >> 10, k = i & 1023; const float v = r < 16 ? p.c[r * 1024 + k] : p.c_ctx[k]; sS[i] = v / (1.f + expf(-v)); }
    __syncthreads();
    float* mod = (float*)(p.ws + WS_MOD);
    for (int item = bid; item < 4 * 144; item += G) {
        const int l = item / 144, n0 = (item - l * 144) * 64, col = tid & 63, kq = tid >> 6;
        const float* W = p.ada_w + (size_t)l * 1024 * NMODV + n0 + col;
        float acc[17];
#pragma unroll
        for (int r = 0; r < 17; ++r) acc[r] = 0.f;
        for (int k = kq * 128; k < kq * 128 + 128; k += 8) {
            float w[8];
#pragma unroll
            for (int i = 0; i < 8; ++i) w[i] = *(const GAS float*)(W + (size_t)(k + i) * NMODV);
#pragma unroll
            for (int i = 0; i < 8; i += 4)
#pragma unroll
                for (int r = 0; r < 17; ++r) { const f32x4 s4 = *(const LAS f32x4*)(sS + r * 1024 + k + i); acc[r] += (s4[0] * w[i] + s4[1] * w[i + 1]) + (s4[2] * w[i + 2] + s4[3] * w[i + 3]); }
        }
#pragma unroll
        for (int r = 0; r < 17; ++r) red[(kq * 17 + r) * 64 + col] = acc[r];
        __syncthreads();
        for (int o = tid; o < 17 * 64; o += NTHR) { const int r = o >> 6, cc = o & 63;
            float s = 0.f;
#pragma unroll
            for (int q = 0; q < 8; ++q) s += red[(q * 17 + r) * 64 + cc];
            mod[((size_t)l * 17 + r) * NMODV + n0 + cc] = s + p.ada_b[(size_t)l * NMODV + n0 + cc]; }
        __syncthreads();
    }
}

__device__ __forceinline__ void norm_phase(float* HX, const float* nw, const float* modl, int shift_idx, int scale_idx, bf16_t* A, const float* P, bool skip_ctx = false) {
    const int tid = fresh_tid(), lane = tid & 63, gw = fresh_bid() * 8 + (tid >> 6), NGW = fresh_gdim() * 8;
    f32x4 w4[4];
#pragma unroll
    for (int j = 0; j < 4; ++j) w4[j] = *(const f32x4*)(nw + lane * 4 + 256 * j);
    for (int row = gw; row < TT; row += NGW) {
        const int b = row / TB, t = row - b * TB, mr = t < CL ? 16 : b;
        if (skip_ctx && t < CL) continue;
        f32x4* xr = (f32x4*)(HX + (size_t)row * DM) + lane;
        f32x4 v[4]; float ss = 0.f;
#pragma unroll
        for (int j = 0; j < 4; ++j) v[j] = xr[64 * j];
        if (P != nullptr && row >= SPLIT_PM0 * 256) {
            const u32x2* pr = (const u32x2*)((const bf16_t*)P + (size_t)(row - SPLIT_PM0 * 256) * DM) + lane;
#pragma unroll
            for (int j = 0; j < 4; ++j) {
                f32x4 a = {0.f, 0.f, 0.f, 0.f};
#pragma unroll
                for (int q = 0; q < 4; ++q) { const u32x2 w = pr[(size_t)q * SPLIT_ROWS * 256 + 64 * j]; a[0] += bflo(w.x); a[1] += bfhi(w.x); a[2] += bflo(w.y); a[3] += bfhi(w.y); }
                v[j] = v[j] + a; xr[64 * j] = v[j]; }
        }
#pragma unroll
        for (int j = 0; j < 4; ++j) ss += (v[j][0] * v[j][0] + v[j][1] * v[j][1]) + (v[j][2] * v[j][2] + v[j][3] * v[j][3]);
        const float rstd = rsqrtf(wave_sum(ss) * (1.f / 1024.f) + 1e-6f);
        const float* sh = modl + (size_t)mr * NMODV + shift_idx * 1024 + lane * 4; const float* sc = modl + (size_t)mr * NMODV + scale_idx * 1024 + lane * 4;
        bf16_t* ar = A + (size_t)row * DM + lane * 4;
#pragma unroll
        for (int j = 0; j < 4; ++j) { const f32x4 s4 = *(const f32x4*)(sc + 256 * j), h4 = *(const f32x4*)(sh + 256 * j);
            const f32x4 y = v[j] * rstd * w4[j] * (1.f + s4) + h4; store4bf(ar + 256 * j, y); }
    }
}
__device__ __forceinline__ void final_phase(const float* HX, const float* nw, float* out) {
    const int tid = fresh_tid(), lane = tid & 63, gw = fresh_bid() * 8 + (tid >> 6), NGW = fresh_gdim() * 8;
    f32x4 w4[4];
#pragma unroll
    for (int j = 0; j < 4; ++j) w4[j] = *(const f32x4*)(nw + lane * 4 + 256 * j);
    for (int r = gw; r < NB * SQ; r += NGW) {
        const int b = r >> 11, s = r & 2047; const int row = b * TB + CL + s;
        const f32x4* xr = (const f32x4*)(HX + (size_t)row * DM) + lane;
        f32x4 v[4]; float ss = 0.f;
#pragma unroll
        for (int j = 0; j < 4; ++j) { v[j] = xr[64 * j]; ss += (v[j][0] * v[j][0] + v[j][1] * v[j][1]) + (v[j][2] * v[j][2] + v[j][3] * v[j][3]); }
        const float rstd = rsqrtf(wave_sum(ss) * (1.f / 1024.f) + 1e-6f);
        f32x4* o = (f32x4*)(out + (size_t)r * DM) + lane;
#pragma unroll
        for (int j = 0; j < 4; ++j) o[64 * j] = v[j] * rstd * w4[j];
    }
}
__device__ __forceinline__ void diff_combine(const bf16_t* O16, const float* subln, const float* lamp, bf16_t* A) {
    const int tid = fresh_tid(), lane = tid & 63, gw = fresh_bid() * 8 + (tid >> 6), NGW = fresh_gdim() * 8;
    const float lam = lamp[0], om = 1.f - lamp[1];
    const int h = lane >> 3, e0 = (lane & 7) * 16;
    float sw[16];
#pragma unroll
    for (int j = 0; j < 16; ++j) sw[j] = subln[e0 + j] * om;
    for (int row = gw; row < TT; row += NGW) {
        const u32x4* o1 = (const u32x4*)(O16 + (size_t)row * 2048 + (2 * h) * 128 + e0); const u32x4* o2 = (const u32x4*)(O16 + (size_t)row * 2048 + (2 * h + 1) * 128 + e0);
        float v[16]; float ss = 0.f;
#pragma unroll
        for (int q = 0; q < 2; ++q) { const u32x4 a = o1[q], b = o2[q];
#pragma unroll
            for (int k = 0; k < 4; ++k) { v[q * 8 + 2 * k] = bflo(a[k]) - lam * bflo(b[k]); v[q * 8 + 2 * k + 1] = bfhi(a[k]) - lam * bfhi(b[k]); } }
#pragma unroll
        for (int j = 0; j < 16; ++j) ss += v[j] * v[j];
        ss += __shfl_xor(ss, 1); ss += __shfl_xor(ss, 2); ss += __shfl_xor(ss, 4);
        const float rstd = rsqrtf(ss * (1.f / 128.f) + 1e-6f);
        u32x4 w0, w1;
        w0.x = pk2(v[0] * rstd * sw[0], v[1] * rstd * sw[1]); w0.y = pk2(v[2] * rstd * sw[2], v[3] * rstd * sw[3]); w0.z = pk2(v[4] * rstd * sw[4], v[5] * rstd * sw[5]); w0.w = pk2(v[6] * rstd * sw[6], v[7] * rstd * sw[7]);
        w1.x = pk2(v[8] * rstd * sw[8], v[9] * rstd * sw[9]); w1.y = pk2(v[10] * rstd * sw[10], v[11] * rstd * sw[11]); w1.z = pk2(v[12] * rstd * sw[12], v[13] * rstd * sw[13]); w1.w = pk2(v[14] * rstd * sw[14], v[15] * rstd * sw[15]);
        u32x4* d = (u32x4*)(A + (size_t)row * 1024 + h * 128 + e0); d[0] = w0; d[1] = w1;
    }
}
__device__ __forceinline__ void hgrn_combine(const bf16_t* OF, const bf16_t* OB, const bf16_t* Gt, const float* nw, bf16_t* A) {
    const int tid = fresh_tid(), lane = tid & 63, gw = fresh_bid() * 8 + (tid >> 6), NGW = fresh_gdim() * 8;
    const int e0 = (lane & 7) * 16;
    float sw[16];
#pragma unroll
    for (int j = 0; j < 16; ++j) sw[j] = nw[e0 + j];
    for (int row = gw; row < TT; row += NGW) {
        const size_t off = (size_t)row * 1024 + lane * 16;
        const u32x4* pf = (const u32x4*)(OF + off); const u32x4* pb = (const u32x4*)(OB + off); const u32x4* pg = (const u32x4*)(Gt + off);
        float v[16], g[16]; float ss = 0.f;
#pragma unroll
        for (int q = 0; q < 2; ++q) { const u32x4 a = pf[q], b = pb[q], c = pg[q];
#pragma unroll
            for (int k = 0; k < 4; ++k) { v[q * 8 + 2 * k] = bflo(a[k]) + bflo(b[k]); v[q * 8 + 2 * k + 1] = bfhi(a[k]) + bfhi(b[k]); g[q * 8 + 2 * k] = bflo(c[k]); g[q * 8 + 2 * k + 1] = bfhi(c[k]); } }
#pragma unroll
        for (int j = 0; j < 16; ++j) ss += v[j] * v[j];
        ss += __shfl_xor(ss, 1); ss += __shfl_xor(ss, 2); ss += __shfl_xor(ss, 4);
        const float rstd = rsqrtf(ss * (1.f / 128.f) + 1e-6f);
        u32x4 w0, w1;
#define HC(j) (v[j] * rstd * sw[j] * g[j])
        w0.x = pk2(HC(0), HC(1)); w0.y = pk2(HC(2), HC(3)); w0.z = pk2(HC(4), HC(5)); w0.w = pk2(HC(6), HC(7));
        w1.x = pk2(HC(8), HC(9)); w1.y = pk2(HC(10), HC(11)); w1.z = pk2(HC(12), HC(13)); w1.w = pk2(HC(14), HC(15));
#undef HC
        u32x4* d = (u32x4*)(A + off); d[0] = w0; d[1] = w1;
    }
}
__device__ __forceinline__ void mla_rows(const float* DN, const float* qn, const float* kvn, const float* ropeM, bf16_t* CQ, bf16_t* CKV, bf16_t* K) {
    const int tid = fresh_tid(), lane = tid & 63, gw = fresh_bid() * 8 + (tid >> 6), NGW = fresh_gdim() * 8;
    const f32x4 wq = *(const f32x4*)(qn + lane * 4), wk = *(const f32x4*)(kvn + lane * 4);
    for (int row = gw; row < TT; row += NGW) {
        const int b = row / TB, t = row - b * TB;
        const float* dr = DN + (size_t)row * 768;
        const f32x4 a = *(const f32x4*)(dr + lane * 4), c = *(const f32x4*)(dr + 256 + lane * 4);
        const float kr = dr[512 + (lane & 31)];
        float sa = (a[0] * a[0] + a[1] * a[1]) + (a[2] * a[2] + a[3] * a[3]), sc = (c[0] * c[0] + c[1] * c[1]) + (c[2] * c[2] + c[3] * c[3]);
        sa = wave_sum(sa); sc = wave_sum(sc);
        const float ra = rsqrtf(sa * (1.f / 256.f) + 1e-6f), rc = rsqrtf(sc * (1.f / 256.f) + 1e-6f);
        store4bf(CQ + (size_t)row * 256 + lane * 4, a * ra * wq); store4bf(CKV + (size_t)row * 256 + lane * 4, c * rc * wk);
        const int d = lane & 31; float kv = kr;
        const float part = __shfl_xor(kr, 8);
        if (t >= CL) { const int e = (d >> 4) * 8 + (d & 7); const float cs = ropeM[((size_t)(t - CL) * 16 + e) * 2], sn = ropeM[((size_t)(t - CL) * 16 + e) * 2 + 1];
            kv = kr * cs + ((d & 8) ? part : -part) * sn; }
        float o8[8];
#pragma unroll
        for (int j = 0; j < 8; ++j) o8[j] = __shfl(kv, (lane & 3) * 8 + j);
        u32x4 w; w.x = pk2(o8[0], o8[1]); w.y = pk2(o8[2], o8[3]); w.z = pk2(o8[4], o8[5]); w.w = pk2(o8[6], o8[7]);
        *(u32x4*)(K + (size_t)row * 1536 + (lane >> 2) * 96 + 64 + (lane & 3) * 8) = w;
    }
}

template <int DQK, int DV>
__device__ __forceinline__ void attn_unit(LAS unsigned char* lds, const bf16_t* Qr, int qs, const bf16_t* Kb, int ks, const bf16_t* Vtb, bf16_t* Or, int os,
                                          int lt0, int lt1, bool windowed, int qpos0, float m_init, float l_init,
                                          int dmode = 0  , float lam = 0.f, float om = 0.f, const float* subw = nullptr) {
    constexpr int KST = DQK * 2 + 16, VST = 144, KBUF = 64 * KST, VBUF = DV * VST, KCH = DQK / 8, NKC = 64 * KCH, KPT = (NKC + NTHR - 1) / NTHR, VPT = DV / 64, ND = DQK / 16, NO = DV / 32;
    const int tid = fresh_tid(), lane = tid & 63, r32 = lane & 31, hi = lane >> 5, wid = tid >> 6;
    LAS unsigned char* Kl = lds; LAS unsigned char* Vl = lds + 2 * KBUF;
    const int ntiles = 4 + (lt1 - lt0);
    const GAS bf16_t* Qg = (const GAS bf16_t*)Qr; const GAS bf16_t* Kg = (const GAS bf16_t*)Kb; const GAS bf16_t* Vg = (const GAS bf16_t*)Vtb; GAS bf16_t* Og = (GAS bf16_t*)Or;
    bf16x8 qf[ND];
#pragma unroll
    for (int d0 = 0; d0 < ND; ++d0) qf[d0] = *(const GAS bf16x8*)(Qg + (size_t)(wid * 32 + r32) * qs + d0 * 16 + hi * 8);
    f32x16 o[NO];
#pragma unroll
    for (int nb = 0; nb < NO; ++nb)
#pragma unroll
        for (int r = 0; r < 16; ++r) o[nb][r] = 0.f;
    const bool have_ref = l_init > 0.f;
    float m = have_ref ? m_init : 0.f, l = (hi == 0) ? l_init : 0.f;
    u32x4 kreg[KPT], vreg[VPT];
#define ATT_KT(tt_) ((tt_) < 4 ? (tt_) : lt0 + (tt_) - 4)
#define ATT_LOADK(tt_) do { const int kt_ = ATT_KT(tt_); \
        _Pragma("unroll") for (int i_ = 0; i_ < KPT; ++i_) { const int c_ = tid + NTHR * i_; if (c_ < NKC) { const int key_ = c_ / KCH, part_ = c_ - key_ * KCH; kreg[i_] = *(const GAS u32x4*)(Kg + (size_t)(kt_ * 64 + key_) * ks + part_ * 8); } } } while (0)
#define ATT_LOADV(tt_) do { const int kt_ = ATT_KT(tt_); \
        _Pragma("unroll") for (int i_ = 0; i_ < VPT; ++i_) { const int c_ = tid + NTHR * i_; const int dv_ = c_ >> 3, part_ = c_ & 7; vreg[i_] = *(const GAS u32x4*)(Vg + (size_t)dv_ * TB + kt_ * 64 + part_ * 8); } } while (0)
#define ATT_STOREK(buf_) do { \
        _Pragma("unroll") for (int i_ = 0; i_ < KPT; ++i_) { const int c_ = tid + NTHR * i_; if (c_ < NKC) { const int key_ = c_ / KCH, part_ = c_ - key_ * KCH; *(LAS u32x4*)(Kl + (buf_) * KBUF + key_ * KST + part_ * 16) = kreg[i_]; } } } while (0)
#define ATT_STOREV(buf_) do { \
        _Pragma("unroll") for (int i_ = 0; i_ < VPT; ++i_) { const int c_ = tid + NTHR * i_; const int dv_ = c_ >> 3, part_ = c_ & 7; LAS unsigned char* d_ = Vl + (buf_) * VBUF + dv_ * VST + (part_ >> 1) * 32 + (part_ & 1) * 8;     \
            *(LAS u32x2*)d_ = (u32x2){vreg[i_].x, vreg[i_].y}; *(LAS u32x2*)(d_ + 16) = (u32x2){vreg[i_].z, vreg[i_].w}; } } while (0)
#define SCHED_FENCE() __builtin_amdgcn_sched_barrier(0)
#define ATT_KFRAG(buf_) do { const LAS unsigned char* kb_ = Kl + (buf_) * KBUF + r32 * KST + hi * 16; \
        _Pragma("unroll") for (int d0 = 0; d0 < ND; ++d0) { kf[2 * d0] = *(const LAS bf16x8*)(kb_ + d0 * 32); kf[2 * d0 + 1] = *(const LAS bf16x8*)(kb_ + 32 * KST + d0 * 32); } } while (0)
#define ATT_QKM(P0_, P1_) do { \
        _Pragma("unroll") for (int d0 = 0; d0 < ND; ++d0) { \
            if (d0 == 0) { const f32x16 z_ = {0.f, 0.f, 0.f, 0.f, 0.f, 0.f, 0.f, 0.f, 0.f, 0.f, 0.f, 0.f, 0.f, 0.f, 0.f, 0.f}; P0_ = __builtin_amdgcn_mfma_f32_32x32x16_bf16(kf[0], qf[0], z_, 0, 0, 0); P1_ = __builtin_amdgcn_mfma_f32_32x32x16_bf16(kf[1], qf[0], z_, 0, 0, 0); } \
            else { P0_ = __builtin_amdgcn_mfma_f32_32x32x16_bf16(kf[2 * d0], qf[d0], P0_, 0, 0, 0); P1_ = __builtin_amdgcn_mfma_f32_32x32x16_bf16(kf[2 * d0 + 1], qf[d0], P1_, 0, 0, 0); } } } while (0)
#define ATT_VFRAG(dst_, nb_) do { _Pragma("unroll") for (int j_ = 0; j_ < 4; ++j_) dst_[j_] = *(const LAS u32x4*)(vb + (nb_) * 32 * VST + j_ * 32); } while (0)
    bf16x8 kf[2 * ND];
    f32x16 n0, n1;
    ATT_LOADK(0); ATT_LOADV(0); ATT_STOREK(0); ATT_STOREV(0);
    __syncthreads();
    ATT_LOADK(1); ATT_KFRAG(0); ATT_QKM(n0, n1); ATT_STOREK(1);
    __syncthreads();
    for (int tt = 0; tt < ntiles; ++tt) {
        const int cur = tt & 1;
        f32x16 p0 = n0, p1 = n1;
        if (tt + 2 < ntiles) ATT_LOADK(tt + 2);
        if (tt + 1 < ntiles) ATT_LOADV(tt + 1);
#define ATT_OUTSIDE(t_) (windowed && (t_) >= 4 && (((lt0 + (t_) - 4) * 64 - CL) > qhi_w + 128 || ((lt0 + (t_) - 4) * 64 - CL + 63) < qlo_w - 128))
        const int qlo_w = qpos0 + __builtin_amdgcn_readfirstlane(wid) * 32, qhi_w = qlo_w + 31;
        const bool skip_cur = ATT_OUTSIDE(tt), skip_next = ATT_OUTSIDE(tt + 1);
        u32x4 pw[4];
        if (!skip_cur) {
        if (windowed && tt >= 4) {
            const int kt = lt0 + tt - 4; const int kbase = kt * 64 - CL, qp = qpos0 + wid * 32 + r32;
#pragma unroll
            for (int r = 0; r < 16; ++r) { const int d0 = qp - (kbase + crow(r, hi)); if (d0 > 128 || d0 < -128) p0[r] = -1e30f; const int d1 = d0 - 32; if (d1 > 128 || d1 < -128) p1[r] = -1e30f; }
        }
        float mx = __builtin_fmaxf(__builtin_fmaxf(p0[0], p1[0]), p0[1]);
#pragma unroll
        for (int r = 1; r < 16; ++r) { if (r > 1) mx = __builtin_fmaxf(__builtin_fmaxf(mx, p0[r]), p1[r]); else mx = __builtin_fmaxf(mx, p1[1]); }
        mx = __builtin_fmaxf(mx, __shfl_xor(mx, 32)) - m;
        const bool force = (tt == 0) && !have_ref;
        if (force || __any(mx > 8.f)) {
            const float delta = force ? mx : __builtin_fmaxf(mx, 0.f);
            m += delta;
            if (!force) { const float alpha = __builtin_amdgcn_exp2f(-delta); l *= alpha;
#pragma unroll
                for (int nb = 0; nb < NO; ++nb)
#pragma unroll
                    for (int r = 0; r < 16; ++r) o[nb][r] *= alpha; }
        }
        float ls = 0.f;
#pragma unroll
        for (int r = 0; r < 16; ++r) { p0[r] = __builtin_amdgcn_exp2f(p0[r] - m); p1[r] = __builtin_amdgcn_exp2f(p1[r] - m); ls += p0[r] + p1[r]; }
        l += ls;
        pw[0] = (u32x4){pk2(p0[0], p0[1]), pk2(p0[2], p0[3]), pk2(p0[4], p0[5]), pk2(p0[6], p0[7])};
        pw[1] = (u32x4){pk2(p0[8], p0[9]), pk2(p0[10], p0[11]), pk2(p0[12], p0[13]), pk2(p0[14], p0[15])};
        pw[2] = (u32x4){pk2(p1[0], p1[1]), pk2(p1[2], p1[3]), pk2(p1[4], p1[5]), pk2(p1[6], p1[7])};
        pw[3] = (u32x4){pk2(p1[8], p1[9]), pk2(p1[10], p1[11]), pk2(p1[12], p1[13]), pk2(p1[14], p1[15])};
        SCHED_FENCE();
        }
        const LAS unsigned char* vb = Vl + cur * VBUF + r32 * VST + hi * 16;
        u32x4 vf[2][4];
        if (!skip_next) ATT_KFRAG(cur ^ 1);
        if (!skip_cur) ATT_VFRAG(vf[0], 0);
        SCHED_FENCE();
        if (!skip_next) ATT_QKM(n0, n1);
        if (!skip_cur) {
#pragma unroll
        for (int nb = 0; nb < NO; ++nb) {
            if (nb + 1 < NO) ATT_VFRAG(vf[(nb + 1) & 1], nb + 1);
            SCHED_FENCE();
#pragma unroll
            for (int j = 0; j < 4; ++j) o[nb] = __builtin_amdgcn_mfma_f32_32x32x16_bf16(__builtin_bit_cast(bf16x8, vf[nb & 1][j]), __builtin_bit_cast(bf16x8, pw[j]), o[nb], 0, 0, 0);
            SCHED_FENCE();
        }
        }
#undef ATT_OUTSIDE
        if (tt + 2 < ntiles) ATT_STOREK(cur);
        if (tt + 1 < ntiles) ATT_STOREV(cur ^ 1);
        __syncthreads();
    }
#undef SCHED_FENCE
#undef ATT_KFRAG
#undef ATT_QKM
#undef ATT_VFRAG
#undef ATT_KT
#undef ATT_LOADK
#undef ATT_LOADV
#undef ATT_STOREK
#undef ATT_STOREV
    l += __shfl_xor(l, 32);
    const float inv = 1.f / l;
    GAS bf16_t* orow = Og + (size_t)(wid * 32 + r32) * os + 4 * hi;
    LAS unsigned char* stash = lds + 2 * KBUF + 2 * VBUF + (wid * 32 + r32) * 264 + 8 * hi;
    if (DV == 128 && dmode == 1) {
#pragma unroll
        for (int nb = 0; nb < NO; ++nb)
#pragma unroll
            for (int g = 0; g < 4; ++g) { u32x2 w; w.x = pk2(o[nb][4 * g] * inv, o[nb][4 * g + 1] * inv); w.y = pk2(o[nb][4 * g + 2] * inv, o[nb][4 * g + 3] * inv); *(LAS u32x2*)(stash + nb * 64 + 16 * g) = w; }
    } else if (DV == 128 && dmode == 2) {
        const float li = lam * inv; float ss = 0.f;
#pragma unroll
        for (int nb = 0; nb < NO; ++nb)
#pragma unroll
            for (int g = 0; g < 4; ++g) { const u32x2 a = *(const LAS u32x2*)(stash + nb * 64 + 16 * g);
                const float x0 = bflo(a.x) - li * o[nb][4 * g], x1 = bfhi(a.x) - li * o[nb][4 * g + 1], x2 = bflo(a.y) - li * o[nb][4 * g + 2], x3 = bfhi(a.y) - li * o[nb][4 * g + 3];
                o[nb][4 * g] = x0; o[nb][4 * g + 1] = x1; o[nb][4 * g + 2] = x2; o[nb][4 * g + 3] = x3; ss += (x0 * x0 + x1 * x1) + (x2 * x2 + x3 * x3); }
        ss += __shfl_xor(ss, 32);
        const float rs = rsqrtf(ss * (1.f / 128.f) + 1e-6f) * om;
#pragma unroll
        for (int nb = 0; nb < NO; ++nb)
#pragma unroll
            for (int g = 0; g < 4; ++g) { const f32x4 w4 = ldg4(subw + nb * 32 + 8 * g + 4 * hi); u32x2 w;
                w.x = pk2(o[nb][4 * g] * rs * w4[0], o[nb][4 * g + 1] * rs * w4[1]); w.y = pk2(o[nb][4 * g + 2] * rs * w4[2], o[nb][4 * g + 3] * rs * w4[3]); *(GAS u32x2*)(orow + nb * 32 + 8 * g) = w; }
    } else {
#pragma unroll
    for (int nb = 0; nb < NO; ++nb)
#pragma unroll
        for (int g = 0; g < 4; ++g) { u32x2 w; w.x = pk2(o[nb][4 * g] * inv, o[nb][4 * g + 1] * inv); w.y = pk2(o[nb][4 * g + 2] * inv, o[nb][4 * g + 3] * inv); *(GAS u32x2*)(orow + nb * 32 + 8 * g) = w; }
    }
}

template <int KIND>
__device__ __forceinline__ void attn_phase(unsigned char* big, bf16_t* Abuf, const float* sinks  , const float* lamp, LAS unsigned char* lds, bool with_ctx) {
    constexpr int NHU = (KIND == 1) ? 8 : 16;
    const int NLAT = NB * NHU * 8, NU = NLAT + (with_ctx ? NB * NHU : 0);
    const int bid_ = fresh_bid(), vb_ = (bid_ & 7) * (GRID / 8) + (bid_ >> 3);
    for (int u = vb_; u < NU; u += GRID) {
        int b, head, j;
        if (u < NLAT) { j = 1 + (u & 7); head = (u >> 3) % NHU; b = (u >> 3) / NHU; } else { const int v = u - NLAT; j = 0; head = v % NHU; b = v / NHU; }
        const size_t row0 = (size_t)b * TB + j * 256;
        int lt0 = 4, lt1 = 4; const int qpos0 = (j - 1) * 256;
        if (j > 0) { if (KIND == 0) { int lo = qpos0 - 128; if (lo < 0) lo = 0; int hi = qpos0 + 255 + 128; if (hi > SQ - 1) hi = SQ - 1; lt0 = 4 + lo / 64; lt1 = 4 + hi / 64 + 1; } else { lt0 = 4; lt1 = 36; } }
        if (KIND == 0) {
            const bf16_t* Q = (const bf16_t*)big; const bf16_t* K = (const bf16_t*)(big + U72); const bf16_t* Vt = (const bf16_t*)(big + U72 + 18 * MiB);
            const float sink = sinks[head] * LOG2E;
            attn_unit<64, 64>(lds, Q + row0 * 1024 + head * 64, 1024, K + (size_t)b * TB * 256 + (head >> 2) * 64, 256, Vt + (size_t)(b * 4 + (head >> 2)) * 64 * TB,
                              Abuf + row0 * 1024 + head * 64, 1024, lt0, lt1, true, qpos0, sink, 1.f);
        } else if (KIND == 1) {
            const bf16_t* Q = (const bf16_t*)big; const bf16_t* K = (const bf16_t*)(big + U72); const bf16_t* Vt = (const bf16_t*)(big + 2 * U72);
            const float lam = lamp[0], om = 1.f - lamp[1];
            attn_unit<64, 128>(lds, Q + row0 * 1024 + (2 * head) * 64, 1024, K + (size_t)b * TB * 1024 + (2 * head) * 64, 1024, Vt + (size_t)(b * 8 + head) * 128 * TB,
                               Abuf + row0 * 1024 + head * 128, 1024, lt0, lt1, false, qpos0, -1e30f, 0.f, 1);
            attn_unit<64, 128>(lds, Q + row0 * 1024 + (2 * head + 1) * 64, 1024, K + (size_t)b * TB * 1024 + (2 * head + 1) * 64, 1024, Vt + (size_t)(b * 8 + head) * 128 * TB,
                               Abuf + row0 * 1024 + head * 128, 1024, lt0, lt1, false, qpos0, -1e30f, 0.f, 2, lam, om, sinks);
        } else {
            const bf16_t* Vt = (const bf16_t*)big; const bf16_t* Q = (const bf16_t*)(big + 2 * U72); const bf16_t* K = (const bf16_t*)(big + 2 * U72 + 108 * MiB);
            attn_unit<96, 64>(lds, Q + row0 * 1536 + head * 96, 1536, K + (size_t)b * TB * 1536 + head * 96, 1536, Vt + (size_t)(b * 16 + head) * 64 * TB,
                              Abuf + row0 * 1024 + head * 64, 1024, lt0, lt1, false, qpos0, -1e30f, 0.f);
        }
    }
}

__device__ __forceinline__ void hgrn_scan(unsigned char* big, bf16_t* OF, bf16_t* OB, LAS unsigned char* lds) {
    constexpr int GST = 132;
    constexpr int O_G = 0, O_QT = 34816, O_KT = O_QT + 17408, O_KTT = O_KT + 17408, O_VT = O_KTT + 18432, O_AB = O_VT + 18432, O_SEG = O_AB + 9216, O_GM = O_SEG + 2048, O_GL = O_GM + 512;
    const bf16_t* Qh = (const bf16_t*)big; const bf16_t* Vv = (const bf16_t*)(big + 3 * U72);
    const int tid = fresh_tid(), lane = tid & 63, r32 = lane & 31, hi = lane >> 5, wid = tid >> 6;
    LAS float* Gs = (LAS float*)(lds + O_G); LAS unsigned char* STb = lds + O_G;
    LAS unsigned char* QTb = lds + O_QT; LAS unsigned char* KTb = lds + O_KT; LAS unsigned short* KTT = (LAS unsigned short*)(lds + O_KTT); LAS unsigned short* VT = (LAS unsigned short*)(lds + O_VT);
    LAS unsigned short* AB = (LAS unsigned short*)(lds + O_AB); LAS float* SEG = (LAS float*)(lds + O_SEG); LAS float* GM = (LAS float*)(lds + O_GM); LAS float* GL = (LAS float*)(lds + O_GL);
    for (int u = fresh_bid(); u < 256; u += fresh_gdim()) {
        const int dir = u & 1, h = (u >> 1) & 7, b = u >> 4;
        const unsigned short* LFd = (const unsigned short*)(big + (dir == 0 ? U72 : 2 * U72));
        bf16_t* Od = dir == 0 ? OF : OB;
        f32x16 S[2];
#pragma unroll
        for (int nb = 0; nb < 2; ++nb)
#pragma unroll
            for (int r = 0; r < 16; ++r) S[nb][r] = 0.f;
        const int db = wid >> 1, eh = wid & 1, ti = wid >> 2, ei = wid & 3;
        u32x4 q8[2], lf8[2], v8[2];
#define HG_TOK(ci_, tp_) ((size_t)b * TB + (size_t)((dir == 0) ? (ci_) : ((ci_) < 4 ? 3 - (ci_) : 39 - (ci_))) * 64 + ((dir == 0) ? (tp_) : 63 - (tp_)))
#define HG_LOAD(ci_) do { _Pragma("unroll") for (int i_ = 0; i_ < 2; ++i_) { const int ch_ = tid + NTHR * i_; const int tp_ = ch_ & 63, dc_ = ch_ >> 6; const size_t o_ = HG_TOK(ci_, tp_) * 1024 + h * 128 + dc_ * 8; \
            q8[i_] = *(const GAS u32x4*)((const GAS bf16_t*)Qh + o_); lf8[i_] = *(const GAS u32x4*)((const GAS unsigned short*)LFd + o_); v8[i_] = *(const GAS u32x4*)((const GAS bf16_t*)Vv + o_); } } while (0)
        HG_LOAD(0);
        for (int ci = 0; ci < 36; ++ci) {
#pragma unroll
            for (int i = 0; i < 2; ++i) { const int ch = tid + NTHR * i, tp = ch & 63, dc = ch >> 6; LAS float* g = Gs + tp * GST + dc * 8;
#pragma unroll
                for (int k = 0; k < 4; ++k) { g[2 * k] = h2f((unsigned short)(lf8[i][k] & 0xffffu)); g[2 * k + 1] = h2f((unsigned short)(lf8[i][k] >> 16)); } }
            __syncthreads();
            { const int d = tid & 127, seg = tid >> 7; float run = 0.f;
#pragma unroll
              for (int t = 0; t < 16; ++t) { LAS float* g = Gs + (seg * 16 + t) * GST + d; run += *g; *g = run; }
              SEG[seg * 128 + d] = run; }
            __syncthreads();
#pragma unroll
            for (int i = 0; i < 2; ++i) { const int ch = tid + NTHR * i, tp = ch & 63, dc = ch >> 6, seg = tp >> 4;
                float qt[8], kt[8];
#pragma unroll
                for (int k = 0; k < 8; ++k) { const int d = dc * 8 + k; const float s0 = SEG[d], s1 = SEG[128 + d], s2 = SEG[256 + d];
                    const float off = (seg > 0 ? s0 : 0.f) + (seg > 1 ? s1 : 0.f) + (seg > 2 ? s2 : 0.f);
                    const float g = Gs[tp * GST + d] + off, gm = s0 + s1 + Gs[32 * GST + d];
                    const unsigned lw = lf8[i][k >> 1], qw = q8[i][k >> 1], vw = v8[i][k >> 1];
                    const float lf = h2f((unsigned short)((k & 1) ? (lw >> 16) : (lw & 0xffffu)));
                    const float qv = (k & 1) ? bfhi(qw) : bflo(qw);
                    const float kk = 1.f - __expf(lf);
                    qt[k] = qv * __expf(g - gm); kt[k] = kk * __expf(gm - g);
                    KTT[d * 72 + tp] = f2bf(kt[k]); VT[d * 72 + tp] = (unsigned short)((k & 1) ? (vw >> 16) : (vw & 0xffffu)); }
                *(LAS u32x4*)(QTb + tp * 272 + dc * 16) = (u32x4){pk2(qt[0], qt[1]), pk2(qt[2], qt[3]), pk2(qt[4], qt[5]), pk2(qt[6], qt[7])};
                *(LAS u32x4*)(KTb + tp * 272 + dc * 16) = (u32x4){pk2(kt[0], kt[1]), pk2(kt[2], kt[3]), pk2(kt[4], kt[5]), pk2(kt[6], kt[7])}; }
            if (tid < 128) { const float s0 = SEG[tid], s1 = SEG[128 + tid], s2 = SEG[256 + tid], s3 = SEG[384 + tid]; GM[tid] = s0 + s1 + Gs[32 * GST + tid]; GL[tid] = (s0 + s1) + (s2 + s3); }
            if (ci + 1 < 36) HG_LOAD(ci + 1);
            __syncthreads();
#pragma unroll
            for (int nb = 0; nb < 2; ++nb)
#pragma unroll
                for (int g4 = 0; g4 < 4; ++g4) { const int d0 = 32 * db + 8 * g4 + 4 * hi; const f32x4 gm4 = *(const LAS f32x4*)(GM + d0);
#pragma unroll
                    for (int k = 0; k < 4; ++k) S[nb][4 * g4 + k] *= __expf(gm4[k]);
                    *(LAS u32x2*)(STb + (64 * eh + 32 * nb + r32) * 272 + d0 * 2) = (u32x2){pk2(S[nb][4 * g4], S[nb][4 * g4 + 1]), pk2(S[nb][4 * g4 + 2], S[nb][4 * g4 + 3])}; }
            __syncthreads();
            f32x16 o;
#pragma unroll
            for (int r = 0; r < 16; ++r) o[r] = 0.f;
#pragma unroll
            for (int kk = 0; kk < 8; ++kk) { const bf16x8 a = *(const LAS bf16x8*)(QTb + (32 * ti + r32) * 272 + kk * 32 + hi * 16), bb = *(const LAS bf16x8*)(STb + (32 * ei + r32) * 272 + kk * 32 + hi * 16);
                o = __builtin_amdgcn_mfma_f32_32x32x16_bf16(a, bb, o, 0, 0, 0); }
            if (wid < 4) { const int ti2 = wid >> 1, si = wid & 1; f32x16 a2;
#pragma unroll
                for (int r = 0; r < 16; ++r) a2[r] = 0.f;
#pragma unroll
                for (int kk = 0; kk < 8; ++kk) { const bf16x8 a = *(const LAS bf16x8*)(QTb + (32 * ti2 + r32) * 272 + kk * 32 + hi * 16), bb = *(const LAS bf16x8*)(KTb + (32 * si + r32) * 272 + kk * 32 + hi * 16);
                    a2 = __builtin_amdgcn_mfma_f32_32x32x16_bf16(a, bb, a2, 0, 0, 0); }
#pragma unroll
                for (int r = 0; r < 16; ++r) { const int t = 32 * ti2 + crow(r, hi), s = 32 * si + r32; AB[t * 72 + s] = (t >= s) ? f2bf(a2[r]) : (unsigned short)0; } }
            __syncthreads();
#pragma unroll
            for (int kk = 0; kk < 4; ++kk) { const bf16x8 a = *(const LAS bf16x8*)((LAS unsigned char*)AB + (32 * ti + r32) * 144 + kk * 32 + hi * 16), bb = *(const LAS bf16x8*)((LAS unsigned char*)VT + (32 * ei + r32) * 144 + kk * 32 + hi * 16);
                o = __builtin_amdgcn_mfma_f32_32x32x16_bf16(a, bb, o, 0, 0, 0); }
#pragma unroll
            for (int r = 0; r < 16; ++r) { const int t = 32 * ti + crow(r, hi); ((GAS bf16_t*)Od)[HG_TOK(ci, t) * 1024 + h * 128 + 32 * ei + r32] = f2bf(o[r]); }
#pragma unroll
            for (int nb = 0; nb < 2; ++nb)
#pragma unroll
                for (int kk = 0; kk < 4; ++kk) { const bf16x8 a = *(const LAS bf16x8*)((LAS unsigned char*)KTT + (32 * db + r32) * 144 + kk * 32 + hi * 16), bb = *(const LAS bf16x8*)((LAS unsigned char*)VT + (64 * eh + 32 * nb + r32) * 144 + kk * 32 + hi * 16);
                    S[nb] = __builtin_amdgcn_mfma_f32_32x32x16_bf16(a, bb, S[nb], 0, 0, 0); }
#pragma unroll
            for (int g4 = 0; g4 < 4; ++g4) { const int d0 = 32 * db + 8 * g4 + 4 * hi; const f32x4 gm4 = *(const LAS f32x4*)(GM + d0), gl4 = *(const LAS f32x4*)(GL + d0);
#pragma unroll
                for (int k = 0; k < 4; ++k) { const float sc = __expf(gl4[k] - gm4[k]); S[0][4 * g4 + k] *= sc; S[1][4 * g4 + k] *= sc; } }
            __syncthreads();
        }
#undef HG_LOAD
#undef HG_TOK
    }
}


#define XB_TMO      128
#define XB_XCNT(j)  (256  + 64 * (j))
#define XB_XSUB(j)  (1280 + 64 * (j))
#define XB_XGEN(j)  (2304 + 64 * (j))
#define XB_TOP      3328
#define XB_TOPGEN   3392
#define XCD_BAR_WORDS 3456
#define XB_SPIN_CAP (1u << 18)

__device__ __forceinline__ unsigned xb_ld(unsigned* p)              { return __hip_atomic_load(p, __ATOMIC_RELAXED, __HIP_MEMORY_SCOPE_AGENT); }
__device__ __forceinline__ unsigned xb_add(unsigned* p, unsigned v) { return __hip_atomic_fetch_add(p, v, __ATOMIC_RELAXED, __HIP_MEMORY_SCOPE_AGENT); }
__device__ __forceinline__ unsigned xb_xcc_id() { return (unsigned)__builtin_amdgcn_s_getreg((3 << 11) | 20) & 0xFu; }
#define XB_SPIN(cond, bar) do { unsigned _sp = 0; while (cond) { __builtin_amdgcn_s_sleep(1); \
    if ((++_sp & 255u) == 0u) { if (xb_ld(&(bar)[XB_TMO])) break; if (_sp > XB_SPIN_CAP) { atomicAdd(&(bar)[XB_TMO], 1u); break; } } } } while (0)

struct XcdBarrier {
    unsigned* bar; unsigned x;
    volatile LAS unsigned* st;
};

__device__ __forceinline__ XcdBarrier xcd_barrier_post(unsigned* bar, volatile LAS unsigned* st) {
    XcdBarrier b; b.bar = bar; b.x = xb_xcc_id(); b.st = st;
    if (threadIdx.x == 0) (void)xb_add(&bar[XB_XCNT(b.x)], 1u);
    return b;
}
__device__ __forceinline__ void xcd_barrier_complete(unsigned* bar, unsigned x, unsigned& nloc, unsigned& nx) {
    const unsigned G = gridDim.x * gridDim.y * gridDim.z;
    unsigned sum, cnt, mine, sp = 0u;
    for (;;) {
        sum = 0u; cnt = 0u; mine = 0u;
#pragma unroll
        for (unsigned j = 0; j < 16; ++j) { const unsigned c = xb_ld(&bar[XB_XCNT(j)]); sum += c; cnt += (c > 0u) ? 1u : 0u; mine = (j == x) ? c : mine; }
        if (sum == G) break;
        __builtin_amdgcn_s_sleep(1);
        if ((++sp & 255u) == 0u) { if (xb_ld(&bar[XB_TMO])) break; if (sp > XB_SPIN_CAP) { atomicAdd(&bar[XB_TMO], 1u); break; } }
    }
    nloc = mine > 0u ? mine : 1u; nx = cnt > 0u ? cnt : 1u;
}

__device__ __forceinline__ void xcd_barrier(const XcdBarrier& b) {
    asm volatile("s_waitcnt vmcnt(0)" ::: "memory");
    __syncthreads();
    if (threadIdx.x == 0) {
        unsigned* bar = b.bar;
        __builtin_amdgcn_s_waitcnt(0);
        unsigned nloc = b.st[0], nx = b.st[1];
        if (nloc == 0u) { xcd_barrier_complete(bar, b.x, nloc, nx); b.st[0] = nloc; b.st[1] = nx; }
        const unsigned old = xb_add(&bar[XB_XSUB(b.x)], 1u);
        const unsigned gen = old / nloc;
        if (old + 1u == (gen + 1u) * nloc) {
            __builtin_amdgcn_fence(__ATOMIC_RELEASE, "agent");
            asm volatile("s_waitcnt vmcnt(0)" ::: "memory");
            const unsigned og = xb_add(&bar[XB_TOP], 1u);
            const unsigned tg = og / nx;
            if (og + 1u == (tg + 1u) * nx) xb_add(&bar[XB_TOPGEN], 1u);
            else XB_SPIN(xb_ld(&bar[XB_TOPGEN]) == tg, bar);
            __builtin_amdgcn_fence(__ATOMIC_ACQUIRE, "agent");
            xb_add(&bar[XB_XGEN(b.x)], 1u);
            asm volatile("s_waitcnt vmcnt(0)" ::: "memory");
        } else {
            XB_SPIN(xb_ld(&bar[XB_XGEN(b.x)]) == gen, bar);
            __builtin_amdgcn_fence(__ATOMIC_ACQUIRE, "agent");
            asm volatile("s_waitcnt vmcnt(0)" ::: "memory");
        }
    }
    __syncthreads();
}

enum { K_X = 0, K_C, K_CTX, K_CCTX, K_ADAW, K_ADAB, K_NORMW, K_FNORMW, K_FFNG, K_FFNU, K_FFND, K_GQAIN, K_GQAOUT, K_GQASINK, K_DIFFIN, K_DIFFOUT, K_DIFFLAM, K_DIFFSUB,
       K_HGRNIN, K_HGRNOUT, K_HGRNNORM, K_HGRNLB, K_MLADOWN, K_MLAQN, K_MLAKVN, K_MLAUQ, K_MLAUKV, K_MLAOUT, K_OUT, K_WS };
__device__ __forceinline__ const float* karg_ptr(int idx) {
    const __attribute__((address_space(4))) unsigned long long* ka = (const __attribute__((address_space(4))) unsigned long long*)__builtin_amdgcn_kernarg_segment_ptr();
    int i = idx; asm volatile("" : "+s"(i));
    return (const float*)ka[i];
}
__device__ __forceinline__ Params load_params() {
    Params q;
    const float** qq = (const float**)&q;
#pragma unroll
    for (int i = 0; i < 30; ++i) qq[i] = karg_ptr(i);
    q.ph_lo = 0; q.ph_hi = 0;
    return q;
}
__global__ void __launch_bounds__(NTHR, 2) fwd_megakernel(Params p) {
    extern __shared__ __attribute__((aligned(16))) unsigned char lds_raw[];
    LAS unsigned char* lds = (LAS unsigned char*)lds_raw;
    cg::grid_group grid = cg::this_grid();
    const int ph_lo = p.ph_lo, ph_hi = p.ph_hi;
    volatile LAS unsigned* bst = (volatile LAS unsigned*)(lds + LDS_BYTES - 64);
    if (threadIdx.x < 2) bst[threadIdx.x] = 0u;
    __syncthreads();
    XcdBarrier bar = xcd_barrier_post((unsigned*)((unsigned char*)karg_ptr(K_WS) + WS_BAR), bst);
    int nsync = 0;
#define GRID_SYNC() do { xcd_barrier(bar); ++nsync; } while (0)
    if (ph_lo < 0) grid.sync();
    int ph = 0;
#ifndef PH_MASK
#define PH_MASK 0xffffffffu
#endif
#define COMP(k) (((PH_MASK) >> (k)) & 1u)
#ifndef DUP_MASK
#define DUP_MASK 0u
#endif
#define NREP(k) (1 + (int)(((DUP_MASK) >> (k)) & 1u))
#define PHASE_BEGIN(k) if (ph >= ph_lo && ph < ph_hi) { unsigned char* dout = (unsigned char*)karg_ptr(K_OUT); unsigned char* ws = (unsigned char*)karg_ptr(K_WS); \
        unsigned char* big = ws + WS_BIG; float* HX = (float*)(ws + WS_HX); const float* mod = (const float*)(ws + WS_MOD); bf16_t* Abuf = (bf16_t*)(dout + DO_A); \
        const float* modl = mod + (size_t)layer * 17 * NMODV; (void)big; (void)HX; (void)modl; (void)Abuf; \
        for (int rep_ = 0; rep_ < NREP(k); ++rep_) { if (rep_) GRID_SYNC();
#define PHASE_END   } if (ph + 1 < ph_hi) GRID_SYNC(); } ++ph;
    int layer = 0;
    PHASE_BEGIN(0) if (COMP(0)) { const Params q = load_params(); prologue(q, lds); } PHASE_END
#pragma unroll 1
    for (layer = 0; layer < 4; ++layer) {
        const bool with_ctx = layer < 3;
        PHASE_BEGIN(1) if (COMP(1)) { { const Params q = load_params(); convert_weights(q, layer, lds, dout); } __syncthreads(); norm_phase(HX, karg_ptr(K_NORMW) + (size_t)layer * 3 * DM, modl, 0, 1, Abuf, (layer > 0 && rep_ == 0) ? (const float*)(big + 200 * MiB) : nullptr); } PHASE_END
        PHASE_BEGIN(2) if (COMP(2)) { EpiSwiglu E{(bf16_t*)big}; run_gemm(lds, Abuf, (const bf16_t*)(dout + W_F1GU), 2 * FF, DM, E); } PHASE_END
        PHASE_BEGIN(3) if (COMP(3)) { EpiResid E{HX, modl, 2, rep_ + 1 < NREP(3) ? 0.f : 0.5f, (float*)(big + 200 * MiB)}; run_gemm(lds, (const bf16_t*)big, (const bf16_t*)(dout + W_F1D), DM, FF, E, true, false); } PHASE_END
        PHASE_BEGIN(1) if (COMP(1)) norm_phase(HX, karg_ptr(K_NORMW) + (size_t)layer * 3 * DM + DM, modl, 3, 4, Abuf, rep_ == 0 ? (const float*)(big + 200 * MiB) : nullptr); PHASE_END
        if (layer == 0) {
            PHASE_BEGIN(4) if (COMP(4)) { EpiGqaIn E{(bf16_t*)big, (bf16_t*)(big + U72), (bf16_t*)(big + U72 + 18 * MiB), (const float*)(ws + WS_ROPEH)}; run_gemm(lds, Abuf, (const bf16_t*)(dout + W_MIN), 1536, DM, E); } PHASE_END
            PHASE_BEGIN(5) if (COMP(5)) attn_phase<0>(big, Abuf, karg_ptr(K_GQASINK), nullptr, lds, true); PHASE_END
        } else if (layer == 1) {
            PHASE_BEGIN(6) if (COMP(6)) { EpiDiffIn E{(bf16_t*)big, (bf16_t*)(big + U72), (bf16_t*)(big + 2 * U72), (const float*)(ws + WS_ROPEH)}; run_gemm(lds, Abuf, (const bf16_t*)(dout + W_MIN), 3072, DM, E); } PHASE_END
            PHASE_BEGIN(7) if (COMP(7)) attn_phase<1>(big, Abuf, karg_ptr(K_DIFFSUB), (const float*)(ws + WS_LAM), lds, true); PHASE_END
        } else if (layer == 2) {
            PHASE_BEGIN(9) if (COMP(9)) { EpiHgrnIn E{(bf16_t*)big, (unsigned short*)(big + U72), (unsigned short*)(big + 2 * U72), (bf16_t*)(big + 3 * U72), (bf16_t*)(big + 4 * U72), (const float*)(ws + WS_LB)};
                          run_gemm(lds, Abuf, (const bf16_t*)(dout + W_MIN), 5120, DM, E); } PHASE_END
            PHASE_BEGIN(10) if (COMP(10)) hgrn_scan(big, (bf16_t*)(ws + WS_END), Abuf, lds); PHASE_END
            PHASE_BEGIN(11) if (COMP(11)) hgrn_combine((const bf16_t*)(ws + WS_END), Abuf, (const bf16_t*)(big + 4 * U72), karg_ptr(K_HGRNNORM), Abuf); PHASE_END
        } else {
            PHASE_BEGIN(12) if (COMP(12)) { EpiF32 E{(float*)big, 768}; run_gemm(lds, Abuf, (const bf16_t*)(dout + W_MIN), 768, DM, E); } PHASE_END
            PHASE_BEGIN(13) if (COMP(13)) mla_rows((const float*)big, karg_ptr(K_MLAQN), karg_ptr(K_MLAKVN), (const float*)(ws + WS_ROPEM), (bf16_t*)(big + 108 * MiB), (bf16_t*)(big + 126 * MiB), (bf16_t*)(big + 2 * U72 + 108 * MiB)); PHASE_END
            PHASE_BEGIN(14) if (COMP(14)) { EpiMlaUq E1{(bf16_t*)(big + 2 * U72), (const float*)(ws + WS_ROPEM)}; run_gemm(lds, (const bf16_t*)(big + 108 * MiB), (const bf16_t*)(dout + W_UQ), 1536, 256, E1);
                          EpiMlaUkv E2{(bf16_t*)(big + 2 * U72 + 108 * MiB), (bf16_t*)big}; run_gemm(lds, (const bf16_t*)(big + 126 * MiB), (const bf16_t*)(dout + W_UKV), 2048, 256, E2); } PHASE_END
            PHASE_BEGIN(15) if (COMP(15)) attn_phase<3>(big, Abuf, karg_ptr(K_GQASINK), nullptr, lds, false); PHASE_END
        }
        PHASE_BEGIN(3) if (COMP(3)) { EpiResid E{HX, modl, 5, rep_ + 1 < NREP(3) ? 0.f : 1.0f, (float*)(big + 200 * MiB)}; run_gemm(lds, Abuf, (const bf16_t*)(dout + W_MOUT), DM, DM, E, true, layer == 3); } PHASE_END
        PHASE_BEGIN(1) if (COMP(1)) norm_phase(HX, karg_ptr(K_NORMW) + (size_t)layer * 3 * DM + 2 * DM, modl, 6, 7, Abuf, (layer < 3 && rep_ == 0) ? (const float*)(big + 200 * MiB) : nullptr, layer == 3); PHASE_END
        PHASE_BEGIN(2) if (COMP(2)) { EpiSwiglu E{(bf16_t*)big}; run_gemm(lds, Abuf, (const bf16_t*)(dout + W_F2GU), 2 * FF, DM, E, false, layer == 3); } PHASE_END
        PHASE_BEGIN(3) if (COMP(3)) { EpiResid E{HX, modl, 8, rep_ + 1 < NREP(3) ? 0.f : 0.5f, (float*)(big + 200 * MiB)}; run_gemm(lds, (const bf16_t*)big, (const bf16_t*)(dout + W_F2D), DM, FF, E, true, layer == 3); } PHASE_END
    }
    layer = 0;
    if (NREP(17) > 1) { for (int i = 0; i < 20; ++i) GRID_SYNC(); }
    PHASE_BEGIN(16) if (COMP(16)) final_phase(HX, karg_ptr(K_FNORMW), (float*)dout); PHASE_END
#undef PHASE_BEGIN
#undef PHASE_END
}

#ifndef MK_MULTI
#define MK_MULTI 0
#endif
constexpr int N_PHASES = 1 + (10 + 10 + 11 + 12) + 1;

extern "C" void kernel_launch(void* const* d_in, const int* in_sizes, int n_in, void* d_out, int out_size, void* d_ws, size_t ws_size, hipStream_t stream) {
    static int grid = 0;
    if (grid == 0) {
        if (n_in != 28 || ws_size < WS_END + U72 || out_size != NB * SQ * DM) { fprintf(stderr, "kernel_launch: unexpected sizes n_in %d out %d ws %zu\n", n_in, out_size, ws_size); grid = -1; return; }
        int dev = 0, cus = 0, per_cu = 0;
        hipGetDevice(&dev); hipDeviceGetAttribute(&cus, hipDeviceAttributeMultiprocessorCount, dev);
        if (hipFuncSetAttribute((const void*)fwd_megakernel, hipFuncAttributeMaxDynamicSharedMemorySize, LDS_BYTES) != hipSuccess) { fprintf(stderr, "kernel_launch: hipFuncSetAttribute failed\n"); grid = -1; return; }
        if (hipOccupancyMaxActiveBlocksPerMultiprocessor(&per_cu, (const void*)fwd_megakernel, NTHR, LDS_BYTES) != hipSuccess || per_cu < 1) { fprintf(stderr, "kernel_launch: occupancy query says %d\n", per_cu); per_cu = 1; }
        (void)hipGetLastError();
        grid = cus * (per_cu > 1 ? 1 : per_cu);
        if (grid != GRID) { fprintf(stderr, "kernel_launch: this kernel is built for a %d-workgroup cooperative grid (one per CU), device offers %d\n", GRID, grid); grid = -1; return; }
    }
    if (grid < 0) return;
    if (hipMemsetAsync((char*)d_ws + WS_BAR, 0, XCD_BAR_WORDS * 4, stream) != hipSuccess) { fprintf(stderr, "kernel_launch: memset failed\n"); return; }
    Params p{};
    const float** pp = (const float**)&p;
    for (int i = 0; i < 28; ++i) pp[i] = (const float*)d_in[i];
    p.out = (float*)d_out; p.ws = (unsigned char*)d_ws;
#if MK_MULTI
    for (int ph = 0; ph < N_PHASES; ++ph) { p.ph_lo = ph; p.ph_hi = ph + 1; hipLaunchKernelGGL(fwd_megakernel, dim3(grid), dim3(NTHR), LDS_BYTES, stream, p); }
#else
    p.ph_lo = 0; p.ph_hi = N_PHASES;
    void* args[] = {&p};
    hipError_t e = hipLaunchCooperativeKernel((const void*)fwd_megakernel, dim3(grid), dim3(NTHR), args, LDS_BYTES, stream);
    if (e != hipSuccess) fprintf(stderr, "cooperative launch failed: %s (grid %d)\n", hipGetErrorString(e), grid);
#endif
}
```

```cpp
#include <hip/hip_runtime.h>
#include <hip/hip_cooperative_groups.h>
#include <cstdio>
#include <cstdint>
namespace cg = cooperative_groups;
namespace pg8 {
#define PG8_LAS __attribute__((address_space(3)))
typedef unsigned short bf16_t;
typedef short bf16x8 __attribute__((ext_vector_type(8)));
typedef float f32x4 __attribute__((ext_vector_type(4)));
typedef unsigned u32x4 __attribute__((ext_vector_type(4)));
constexpr int BM = 256, BK = 64, HALF = 128, HTB = HALF * BK * 2  , STAGE_BYTES = 8 * HTB, NXCD = 8, WGM = 8;

__host__ __device__ __forceinline__ int lds_byte(int r, int c) { const int st = (r >> 4) * 2 + (c >> 5), rr = r & 15, cc = c & 31, ob = rr * 64 + cc * 2; return st * 1024 + (ob ^ (((ob >> 9) & 1) << 5)); }
__host__ __device__ __forceinline__ void stage_rc(int b, int& R, int& C) { const int st = b / 1024, sb = b % 1024, swz = sb ^ (((sb >> 9) & 1) << 5); R = (st >> 1) * 16 + swz / 64; C = (st & 1) * 32 + (swz % 64) / 2; }
__host__ __device__ __forceinline__ int perm32(int rho) { const int n = rho >> 4, i = rho & 15; return 8 * (i >> 2) + 4 * n + (i & 3); }

struct Unit { int pm, pn, k0, nk, part; };
struct Gemm { const bf16_t* A; const bf16_t* Bt; int M, N, K; };

struct StaticOrder {
    int nN, nwg, G, c, nt, nfull, S, nMf; bool lat;
    __host__ __device__ void init(int M, int N, int G_, int c_, int nt_, bool split, bool lat_) {
        const int nM = M / BM; nN = N / BM; nwg = nM * nN; G = G_; c = c_; nt = nt_; lat = lat_; nfull = nwg; S = 1;
        if (split) { const int rem = nwg % G; if (rem > 0 && rem * 2 <= G && ((nwg - rem) % nN) == 0) { S = G / rem; if (S > 4) S = 4; if (S > nt / 2) S = nt / 2; nfull = nwg - rem; } }
        nMf = nfull / nN;
    }
    __host__ __device__ bool next(int i, Unit& u) const {
        const long L = (long)i * G + c;
        int pm, pn, k0 = 0, nk = nt, part = -1; bool ok = true;
        if (L < nfull) {
            int wgid = (int)L;
            { const int q = nfull / NXCD, r = nfull % NXCD, xcd = wgid % NXCD, off = wgid / NXCD; wgid = (xcd < r ? xcd * (q + 1) : r * (q + 1) + (xcd - r) * q) + off; }
            const int nig = WGM * nN, gid = wgid / nig, fm = gid * WGM, gsz = (nMf - fm) < WGM ? (nMf - fm) : WGM;
            pm = fm + ((wgid % nig) % gsz); pn = (wgid % nig) / gsz;
        } else {
            const long q = L - nfull; const int t = (int)(q / S); part = (int)(q % S); ok = (nfull + t < nwg);
            pm = nMf + t / nN; pn = t % nN;
            const int pairs = nt / 2, base = pairs / S, extra = pairs % S; const int p0 = part * base + (part < extra ? part : extra), np = base + (part < extra ? 1 : 0); k0 = 2 * p0; nk = 2 * np;
        }
        if (lat) pm = (pm >> 3) * 9 + 1 + (pm & 7);
        u.pm = pm; u.pn = pn; u.k0 = k0; u.nk = nk; u.part = part;
        return ok;
    }
    __device__ __forceinline__ void a_ready(const Unit&) const {}
    __device__ __forceinline__ void done(const Unit&) const {}
};
template <class Epi, class Sched, bool ALIGN_EPI = false, bool SP2 = false>
__device__ __forceinline__ void gemm_phase(PG8_LAS unsigned char* lds, const Gemm g, const Sched& S, const Epi& E) {
    int tid_ = threadIdx.x; asm volatile("" : "+v"(tid_));
    const int tid = tid_, wid = __builtin_amdgcn_readfirstlane(tid >> 6), lane = tid & 63, wr = wid >> 2, wc = wid & 3, fr = lane & 15, fq = lane >> 4;
    const int K = g.K;
    unsigned voffA[2], voffB[2];
#pragma unroll
    for (int i = 0; i < 2; ++i) { int R, C; stage_rc(tid * 16 + i * 8192, R, C); const int Rb = Epi::PERM ? ((R & ~31) + perm32(R & 31)) : R;
        voffA[i] = (unsigned)(R * K + C) * 2u; voffB[i] = (unsigned)(Rb * K + C) * 2u; }
    const size_t kstep = (size_t)(BK * 2);
    const size_t hstep = (size_t)HALF * K * 2;
    const size_t tstep = 2 * hstep;
    const unsigned ldsw = (unsigned)wid * 1024u;
    const int aoff = lds_byte(wr * 64 + fr, fq * 8), boff = lds_byte(wc * 32 + fr, fq * 8);
#define PG8_SA(b, h) (((b) * 2 + (h)) * HTB)
#define PG8_SB(b, h) ((4 + (b) * 2 + (h)) * HTB)
#define PG8_STAGE(bufoff, gbase, voff) do { _Pragma("unroll") for (int _i = 0; _i < 2; ++_i) \
        __builtin_amdgcn_global_load_lds((const unsigned*)((const char*)(gbase) + (voff)[_i]), (PG8_LAS unsigned*)(lds + (bufoff) + ldsw + _i * 8192), 16, 0, 0); } while (0)
#define PG8_LDA(dst, b, h) do { _Pragma("unroll") for (int m = 0; m < 4; ++m) _Pragma("unroll") for (int k = 0; k < 2; ++k) dst[m][k] = *(const PG8_LAS bf16x8*)(lds + PG8_SA(b, h) + aoff + m * 2048 + k * 1024); } while (0)
#define PG8_LDB(dst, b, h) do { _Pragma("unroll") for (int n = 0; n < 2; ++n) _Pragma("unroll") for (int k = 0; k < 2; ++k) dst[n][k] = *(const PG8_LAS bf16x8*)(lds + PG8_SB(b, h) + boff + n * 2048 + k * 1024); } while (0)
#define PG8_MMA(ai, bj, At, Bt) do { __builtin_amdgcn_s_setprio(1); _Pragma("unroll") for (int m = 0; m < 4; ++m) _Pragma("unroll") for (int n = 0; n < 2; ++n) _Pragma("unroll") for (int k = 0; k < 2; ++k) \
        acc[ai][bj][m][n] = __builtin_amdgcn_mfma_f32_16x16x32_bf16(Bt[n][k], At[m][k], acc[ai][bj][m][n], 0, 0, 0); __builtin_amdgcn_s_setprio(0); } while (0)
#define PG8_WAIT_V(n) asm volatile("s_waitcnt vmcnt(" #n ")" ::: "memory")
#define PG8_WAIT_L(n) asm volatile("s_waitcnt lgkmcnt(" #n ")" ::: "memory")
#define PG8_BAR __builtin_amdgcn_s_barrier()
#define PG8_SCHED __builtin_amdgcn_sched_barrier(0)
    Unit cur, nxt; int ui = 0;
    if (!S.next(0, cur)) return;
    f32x4 acc[2][2][4][2];
#pragma unroll
    for (int a = 0; a < 2; ++a)
#pragma unroll
        for (int b = 0; b < 2; ++b)
#pragma unroll
            for (int m = 0; m < 4; ++m)
#pragma unroll
                for (int n = 0; n < 2; ++n) acc[a][b][m][n] = (f32x4){0.f, 0.f, 0.f, 0.f};
    bf16x8 At[4][2], B0[2][2], B1[2][2];
    const char* cA = (const char*)g.A + (size_t)cur.pm * tstep + (size_t)cur.k0 * kstep; const char* cB = (const char*)g.Bt + (size_t)cur.pn * tstep + (size_t)cur.k0 * kstep;
    S.a_ready(cur);
    if constexpr (SP2) {
        PG8_STAGE(PG8_SB(0, 0), cB, voffB); PG8_STAGE(PG8_SB(0, 1), cB + hstep, voffB); PG8_STAGE(PG8_SA(0, 0), cA, voffA); PG8_STAGE(PG8_SA(0, 1), cA + hstep, voffA);
        if (wr == 1) PG8_BAR;
        PG8_WAIT_V(2); PG8_BAR;
        PG8_STAGE(PG8_SB(1, 0), cB + kstep, voffB); PG8_STAGE(PG8_SA(1, 0), cA + kstep, voffA); PG8_STAGE(PG8_SB(1, 1), cB + hstep + kstep, voffB);
        PG8_WAIT_V(6); PG8_BAR;
    } else {
        PG8_STAGE(PG8_SB(0, 0), cB, voffB); PG8_STAGE(PG8_SA(0, 0), cA, voffA); PG8_STAGE(PG8_SB(0, 1), cB + hstep, voffB); PG8_STAGE(PG8_SA(0, 1), cA + hstep, voffA);
        if (wr == 1) PG8_BAR;
        PG8_WAIT_V(4); PG8_BAR;
        PG8_STAGE(PG8_SB(1, 0), cB + kstep, voffB); PG8_STAGE(PG8_SA(1, 0), cA + kstep, voffA); PG8_STAGE(PG8_SB(1, 1), cB + hstep + kstep, voffB);
        PG8_WAIT_V(6); PG8_BAR;
    }
    for (;;) {
        const bool has_next = S.next(ui + 1, nxt);
        const char* nA = has_next ? (const char*)g.A + (size_t)nxt.pm * tstep + (size_t)nxt.k0 * kstep : cA; const char* nB = has_next ? (const char*)g.Bt + (size_t)nxt.pn * tstep + (size_t)nxt.k0 * kstep : cB;
        const int nt = cur.nk;
#pragma unroll 1
        for (int t = 0; t < nt; t += 2) {
            const bool last = (t == nt - 2);
            const char* a1 = cA + (size_t)(t + 1) * kstep;
            const char* a2 = last ? nA : cA + (size_t)(t + 2) * kstep; const char* b2 = last ? nB : cB + (size_t)(t + 2) * kstep;
            const char* a3 = a2 + kstep; const char* b3 = b2 + kstep;
            if (last && has_next) S.a_ready(nxt);
            if constexpr (SP2) {
            PG8_LDB(B0, 0, 0); PG8_LDB(B1, 0, 1); PG8_SCHED; PG8_LDA(At, 0, 0); PG8_STAGE(PG8_SA(1, 1), a1 + hstep, voffA);
            PG8_WAIT_V(8); PG8_WAIT_L(0); PG8_BAR; PG8_MMA(0, 0, At, B0); PG8_MMA(0, 1, At, B1); PG8_BAR; PG8_SCHED;
            PG8_LDA(At, 0, 1); PG8_STAGE(PG8_SB(0, 0), b2, voffB); PG8_STAGE(PG8_SB(0, 1), b2 + hstep, voffB); PG8_STAGE(PG8_SA(0, 0), a2, voffA);
            PG8_WAIT_V(8); PG8_WAIT_L(0); PG8_BAR; PG8_MMA(1, 0, At, B0); PG8_MMA(1, 1, At, B1); PG8_BAR; PG8_SCHED;
            PG8_LDB(B0, 1, 0); PG8_LDB(B1, 1, 1); PG8_SCHED; PG8_LDA(At, 1, 0); PG8_STAGE(PG8_SA(0, 1), a2 + hstep, voffA);
            PG8_WAIT_V(8); PG8_WAIT_L(0); PG8_BAR; PG8_MMA(0, 0, At, B0); PG8_MMA(0, 1, At, B1); PG8_BAR; PG8_SCHED;
            PG8_LDA(At, 1, 1); PG8_STAGE(PG8_SB(1, 0), b3, voffB); PG8_STAGE(PG8_SB(1, 1), b3 + hstep, voffB); PG8_STAGE(PG8_SA(1, 0), a3, voffA);
            PG8_WAIT_V(8); PG8_WAIT_L(0); PG8_BAR; PG8_MMA(1, 0, At, B0); PG8_MMA(1, 1, At, B1); PG8_BAR; PG8_SCHED;
            } else {
            PG8_LDB(B0, 0, 0); PG8_SCHED; PG8_LDA(At, 0, 0); PG8_STAGE(PG8_SA(1, 1), a1 + hstep, voffA);
            PG8_WAIT_L(8); PG8_BAR; PG8_WAIT_L(0); PG8_MMA(0, 0, At, B0); PG8_BAR; PG8_SCHED;
            PG8_LDB(B1, 0, 1); PG8_STAGE(PG8_SB(0, 0), b2, voffB);
            PG8_BAR; PG8_WAIT_L(0); PG8_MMA(0, 1, At, B1); PG8_BAR;
            PG8_LDA(At, 0, 1); PG8_STAGE(PG8_SA(0, 0), a2, voffA);
            PG8_BAR; PG8_WAIT_L(0); PG8_MMA(1, 0, At, B0); PG8_BAR; PG8_SCHED;
            PG8_STAGE(PG8_SB(0, 1), b2 + hstep, voffB);
            PG8_WAIT_V(6); PG8_BAR; PG8_MMA(1, 1, At, B1); PG8_BAR;
            PG8_LDB(B0, 1, 0); PG8_SCHED; PG8_LDA(At, 1, 0); PG8_STAGE(PG8_SA(0, 1), a2 + hstep, voffA);
            PG8_WAIT_L(8); PG8_BAR; PG8_WAIT_L(0); PG8_MMA(0, 0, At, B0); PG8_BAR; PG8_SCHED;
            PG8_LDB(B1, 1, 1); PG8_STAGE(PG8_SB(1, 0), b3, voffB);
            PG8_BAR; PG8_WAIT_L(0); PG8_MMA(0, 1, At, B1); PG8_BAR;
            PG8_LDA(At, 1, 1); PG8_STAGE(PG8_SA(1, 0), a3, voffA);
            PG8_BAR; PG8_WAIT_L(0); PG8_MMA(1, 0, At, B0); PG8_BAR; PG8_SCHED;
            PG8_STAGE(PG8_SB(1, 1), b3 + hstep, voffB);
            PG8_WAIT_V(6); PG8_BAR; PG8_MMA(1, 1, At, B1); PG8_BAR;
            }
        }
        if constexpr (ALIGN_EPI) { if (wr == 0) PG8_BAR; }
        if constexpr (!Epi::AFTER_DRAIN) { E(acc, cur, wr, wc, fr, fq); S.done(cur); }
        if (!has_next) break;
#pragma unroll
        for (int a = 0; a < 2; ++a)
#pragma unroll
            for (int b = 0; b < 2; ++b)
#pragma unroll
                for (int m = 0; m < 4; ++m)
#pragma unroll
                    for (int n = 0; n < 2; ++n) acc[a][b][m][n] = (f32x4){0.f, 0.f, 0.f, 0.f};
        cur = nxt; cA = nA; cB = nB; ++ui;
        if constexpr (ALIGN_EPI) { if (wr == 1) PG8_BAR; }
    }
    PG8_WAIT_V(0);
    if constexpr (!ALIGN_EPI) { if (wr == 0) PG8_BAR; }
    PG8_BAR;
    if constexpr (Epi::AFTER_DRAIN) { E.fused(acc, cur, wr, wc, fr, fq, lds, wid, lane); S.done(cur); }
#undef PG8_SA
#undef PG8_SB
#undef PG8_STAGE
#undef PG8_LDA
#undef PG8_LDB
#undef PG8_MMA
#undef PG8_WAIT_V
#undef PG8_WAIT_L
#undef PG8_BAR
#undef PG8_SCHED
}
}

#define LAS __attribute__((address_space(3)))
#define GAS __attribute__((address_space(1)))
using pg8::bf16_t; using pg8::bf16x8; using pg8::f32x4; using pg8::u32x4;
typedef float f32x16 __attribute__((ext_vector_type(16)));
typedef unsigned u32x2 __attribute__((ext_vector_type(2)));
typedef float f32x2v __attribute__((ext_vector_type(2)));
typedef __bf16 bf16x2v __attribute__((ext_vector_type(2)));

constexpr int NB = 16, SQ = 2048, CL = 256, TB = SQ + CL, TT = NB * TB, DM = 1024, FF = 2816, NMODV = 9216;
constexpr int NTHR = 512, GRID = 256;
constexpr size_t MiB = (size_t)1 << 20;
constexpr size_t U72 = 72 * MiB;
constexpr size_t WS_MOD = 0;
constexpr size_t WS_ROPEH = 3 * MiB;
constexpr size_t WS_ROPEM = 3 * MiB + 512 * 1024;
constexpr size_t WS_LB = 3 * MiB + 768 * 1024;
constexpr size_t WS_LAM = WS_LB + 4096;
constexpr size_t WS_BAR = 4 * MiB - 64 * 1024;
constexpr size_t WS_HX = 4 * MiB;
constexpr size_t WS_BIG = 148 * MiB;
constexpr size_t WS_END = 508 * MiB;
constexpr size_t DO_A = 0;
constexpr size_t DO_W = 72 * MiB;
constexpr size_t W_F1GU = DO_W, W_F1D = DO_W + 11 * MiB, W_F2GU = DO_W + 33 * MiB / 2, W_F2D = DO_W + 55 * MiB / 2;
constexpr size_t W_MIN = DO_W + 33 * MiB, W_MOUT = DO_W + 43 * MiB, W_UQ = DO_W + 45 * MiB, W_UKV = DO_W + 46 * MiB;
constexpr int LDS_BYTES = 147456;
constexpr float LOG2E = 1.4426950408889634f;

struct Params {
    const float *x, *c, *ctx, *c_ctx, *ada_w, *ada_b, *norm_w, *final_norm_w, *ffn_g, *ffn_u, *ffn_d,
        *gqa_in, *gqa_out, *gqa_sinks, *diff_in, *diff_out, *diff_lambda, *diff_subln,
        *hgrn_in, *hgrn_out, *hgrn_norm, *hgrn_lb, *mla_down, *mla_qn, *mla_kvn, *mla_uq, *mla_ukv, *mla_out;
    float* out; unsigned char* ws; int ph_lo, ph_hi;
};

__device__ __forceinline__ int fresh_bid() { int t = blockIdx.x; asm volatile("" : "+s"(t)); return t; }
__device__ __forceinline__ int fresh_gdim() { int t = gridDim.x; asm volatile("" : "+s"(t)); return t; }
__device__ __forceinline__ int fresh_tid() { int t = threadIdx.x; asm volatile("" : "+v"(t)); return t; }
__device__ __forceinline__ unsigned pk2(float lo, float hi) { f32x2v v = {lo, hi}; bf16x2v b = __builtin_convertvector(v, bf16x2v); return __builtin_bit_cast(unsigned, b); }
__device__ __forceinline__ unsigned short f2bf(float f) { return (unsigned short)(pk2(f, 0.f) & 0xffffu); }
__device__ __forceinline__ float bf2f(unsigned short u) { return __uint_as_float((unsigned)u << 16); }
__device__ __forceinline__ float bflo(unsigned w) { return __uint_as_float(w << 16); }
__device__ __forceinline__ float bfhi(unsigned w) { return __uint_as_float(w & 0xffff0000u); }
__device__ __forceinline__ unsigned short f2h(float f) { _Float16 h = (_Float16)f; return __builtin_bit_cast(unsigned short, h); }
__device__ __forceinline__ float h2f(unsigned short u) { return (float)__builtin_bit_cast(_Float16, u); }
__device__ __forceinline__ float silu_f(float v) { return v * __builtin_amdgcn_rcpf(1.f + __expf(-v)); }
__device__ __forceinline__ float wave_sum(float v) {
#pragma unroll
    for (int o = 1; o < 64; o <<= 1) v += __shfl_xor(v, o);
    return v;
}
__device__ __forceinline__ int crow(int r, int hi) { return (r & 3) + 8 * (r >> 2) + 4 * hi; }
__device__ __forceinline__ void store4bf(bf16_t* p, f32x4 v) { u32x2 w; w.x = pk2(v[0], v[1]); w.y = pk2(v[2], v[3]); *(GAS u32x2*)p = w; }
__device__ __forceinline__ f32x4 ldg4(const float* p) { return *(const GAS f32x4*)p; }
__device__ __forceinline__ void stg4(float* p, f32x4 v) { *(GAS f32x4*)p = v; }

template <class F> __device__ __forceinline__ void epi_loop(const f32x4 (&acc)[2][2][4][2], const pg8::Unit& u, int wr, int wc, int fr, int fq, const F& f) {
#pragma unroll
    for (int ai = 0; ai < 2; ++ai)
#pragma unroll
        for (int m = 0; m < 4; ++m) {
            const int row = u.pm * 256 + ai * 128 + wr * 64 + m * 16 + fr;
#pragma unroll
            for (int bj = 0; bj < 2; ++bj) f.item(row, u.pn * 256 + bj * 128 + wc * 32 + 4 * fq, acc[ai][bj][m][0], acc[ai][bj][m][1]);
        }
}
struct EpiSwiglu {
    static constexpr bool PERM = true, AFTER_DRAIN = false;
    bf16_t* H;
    __device__ __forceinline__ void operator()(const f32x4 (&acc)[2][2][4][2], const pg8::Unit& u, int wr, int wc, int fr, int fq) const {
        const int row0 = u.pm * 256 + wr * 64 + fr, col0 = u.pn * 128 + wc * 32 + 8 * fq;
#pragma unroll
        for (int ai = 0; ai < 2; ++ai)
#pragma unroll
            for (int m = 0; m < 4; ++m) {
                bf16_t* rp = H + (size_t)(row0 + ai * 128 + m * 16) * FF + col0;
                const f32x4 g0 = acc[ai][0][m][0], g1 = acc[ai][0][m][1], u0 = acc[ai][1][m][0], u1 = acc[ai][1][m][1];
                u32x4 w;
                w.x = pk2(silu_f(g0[0]) * u0[0], silu_f(g0[1]) * u0[1]); w.y = pk2(silu_f(g0[2]) * u0[2], silu_f(g0[3]) * u0[3]);
                w.z = pk2(silu_f(g1[0]) * u1[0], silu_f(g1[1]) * u1[1]); w.w = pk2(silu_f(g1[2]) * u1[2], silu_f(g1[3]) * u1[3]);
                *(GAS u32x4*)rp = w;
                asm volatile("" ::: "memory");
            }
    }
};
constexpr int SPLIT_PM0 = 128, SPLIT_ROWS = 4096;
struct EpiResid {
    static constexpr bool PERM = false, AFTER_DRAIN = false;
    float* HX; const float* modl; int midx; float coef; float* P;
    __device__ __forceinline__ void operator()(const f32x4 (&acc)[2][2][4][2], const pg8::Unit& u, int wr, int wc, int fr, int fq) const {
        const int bi = u.pm / 9, mr = (u.pm - bi * 9) == 0 ? 16 : bi;
        const int col0 = u.pn * 256 + wc * 32 + 4 * fq;
        const float* g = modl + (size_t)mr * NMODV + midx * 1024 + col0;
        f32x4 gv[2][2];
#pragma unroll
        for (int bj = 0; bj < 2; ++bj)
#pragma unroll
            for (int n = 0; n < 2; ++n) gv[bj][n] = coef * ldg4(g + bj * 128 + n * 16);
        if (u.part < 0) {
#pragma unroll
            for (int ai = 0; ai < 2; ++ai)
#pragma unroll
                for (int m = 0; m < 4; ++m) {
                    float* hp = HX + (size_t)(u.pm * 256 + ai * 128 + wr * 64 + m * 16 + fr) * DM + col0;
#pragma unroll
                    for (int bj = 0; bj < 2; ++bj)
#pragma unroll
                        for (int n = 0; n < 2; ++n) { float* h = hp + bj * 128 + n * 16; stg4(h, ldg4(h) + gv[bj][n] * acc[ai][bj][m][n]); }
                }
        } else {
#pragma unroll
            for (int ai = 0; ai < 2; ++ai)
#pragma unroll
                for (int m = 0; m < 4; ++m) {
                    bf16_t* hp = (bf16_t*)P + ((size_t)u.part * SPLIT_ROWS + (size_t)((u.pm - SPLIT_PM0) * 256 + ai * 128 + wr * 64 + m * 16 + fr)) * DM + col0;
#pragma unroll
                    for (int bj = 0; bj < 2; ++bj)
#pragma unroll
                        for (int n = 0; n < 2; ++n) store4bf(hp + bj * 128 + n * 16, gv[bj][n] * acc[ai][bj][m][n]);
                    if (m & 1) asm volatile("" ::: "memory");
                }
        }
    }
};
__device__ __forceinline__ void rope64(f32x4& a, f32x4& b, const float* tab, int s, int col) {
    const int half = (col >> 5) & 1, i0 = col & 31;
    const GAS f32x4* tp = (const GAS f32x4*)(tab + ((size_t)s * 32 + half * 16 + i0) * 2);
    const f32x4 t0 = tp[0], t1 = tp[1];
    f32x4 na, nb;
    na[0] = a[0] * t0[0] - b[0] * t0[1]; nb[0] = b[0] * t0[0] + a[0] * t0[1];
    na[1] = a[1] * t0[2] - b[1] * t0[3]; nb[1] = b[1] * t0[2] + a[1] * t0[3];
    na[2] = a[2] * t1[0] - b[2] * t1[1]; nb[2] = b[2] * t1[0] + a[2] * t1[1];
    na[3] = a[3] * t1[2] - b[3] * t1[3]; nb[3] = b[3] * t1[2] + a[3] * t1[3];
    a = na; b = nb;
}
__device__ __forceinline__ void store_vt(bf16_t* vt, const f32x4& a, const f32x4& b) {
#pragma unroll
    for (int j = 0; j < 4; ++j) ((GAS bf16_t*)vt)[(size_t)j * TB] = f2bf(a[j]);
    asm volatile("" ::: "memory");
    GAS bf16_t* v2 = (GAS bf16_t*)vt + (size_t)16 * TB;
#pragma unroll
    for (int j = 0; j < 4; ++j) v2[(size_t)j * TB] = f2bf(b[j]);
    asm volatile("" ::: "memory");
}
struct EpiGqaIn {
    static constexpr bool PERM = false, AFTER_DRAIN = false;
    bf16_t *Q, *K, *Vt; const float* ropeH;
    __device__ __forceinline__ void item(int row, int col, const f32x4& a_, const f32x4& b_) const {
        f32x4 a = a_, b = b_; const int bi = row / TB, t = row - bi * TB;
        if (col < 1280) {
            if (t >= CL) rope64(a, b, ropeH, t - CL, col);
            if (col < 1024) { const float c2 = 0.125f * LOG2E; a = a * c2; b = b * c2; bf16_t* q = Q + (size_t)row * 1024 + col; store4bf(q, a); store4bf(q + 16, b); }
            else { bf16_t* k = K + (size_t)row * 256 + (col - 1024); store4bf(k, a); store4bf(k + 16, b); }
        } else { const int cv = col - 1280, head = cv >> 6, dv = cv & 63; store_vt(Vt + ((size_t)(bi * 4 + head) * 64 + dv) * TB + t, a, b); }
    }
    __device__ __forceinline__ void operator()(const f32x4 (&acc)[2][2][4][2], const pg8::Unit& u, int wr, int wc, int fr, int fq) const { epi_loop(acc, u, wr, wc, fr, fq, *this); }
};
struct EpiDiffIn {
    static constexpr bool PERM = false, AFTER_DRAIN = false;
    bf16_t *Q, *K, *Vt; const float* ropeH;
    __device__ __forceinline__ void item(int row, int col, const f32x4& a_, const f32x4& b_) const {
        f32x4 a = a_, b = b_; const int bi = row / TB, t = row - bi * TB;
        if (col < 2048) {
            if (t >= CL) rope64(a, b, ropeH, t - CL, col);
            if (col < 1024) { const float c2 = 0.125f * LOG2E; a = a * c2; b = b * c2; bf16_t* q = Q + (size_t)row * 1024 + col; store4bf(q, a); store4bf(q + 16, b); }
            else { bf16_t* k = K + (size_t)row * 1024 + (col - 1024); store4bf(k, a); store4bf(k + 16, b); }
        } else { const int cv = col - 2048, head = cv >> 7, dv = cv & 127; store_vt(Vt + ((size_t)(bi * 8 + head) * 128 + dv) * TB + t, a, b); }
    }
    __device__ __forceinline__ void operator()(const f32x4 (&acc)[2][2][4][2], const pg8::Unit& u, int wr, int wc, int fr, int fq) const { epi_loop(acc, u, wr, wc, fr, fq, *this); }
};
struct EpiHgrnIn {
    static constexpr bool PERM = false, AFTER_DRAIN = false;
    bf16_t* Qh; unsigned short *LF, *LB; bf16_t *V, *Gt; const float* lb;
    __device__ __forceinline__ void item(int row, int col, const f32x4& a, const f32x4& b) const {
        const int sec = col >> 10, cc = col & 1023; const size_t o = (size_t)row * 1024 + cc;
        if (sec == 0 || sec == 4) { f32x4 x, y;
#pragma unroll
            for (int j = 0; j < 4; ++j) { x[j] = silu_f(a[j]); y[j] = silu_f(b[j]); }
            bf16_t* d = (sec == 0 ? Qh : Gt) + o; store4bf(d, x); store4bf(d + 16, y);
        } else if (sec == 3) { store4bf(V + o, a); store4bf(V + o + 16, b); }
        else { unsigned short* d = (sec == 1 ? LF : LB) + o; const f32x4 la = ldg4(lb + cc), lbb = ldg4(lb + cc + 16);
            unsigned short ha[4], hb[4];
#pragma unroll
            for (int j = 0; j < 4; ++j) { const float fa = la[j] + (1.f - la[j]) * __builtin_amdgcn_rcpf(1.f + __expf(-a[j])), fb = lbb[j] + (1.f - lbb[j]) * __builtin_amdgcn_rcpf(1.f + __expf(-b[j]));
                ha[j] = f2h(__builtin_amdgcn_logf(fa) * 0.6931471805599453f); hb[j] = f2h(__builtin_amdgcn_logf(fb) * 0.6931471805599453f); }
            u32x2 w; w.x = ha[0] | ((unsigned)ha[1] << 16); w.y = ha[2] | ((unsigned)ha[3] << 16); *(GAS u32x2*)d = w;
            w.x = hb[0] | ((unsigned)hb[1] << 16); w.y = hb[2] | ((unsigned)hb[3] << 16); *(GAS u32x2*)(d + 16) = w; }
    }
    __device__ __forceinline__ void operator()(const f32x4 (&acc)[2][2][4][2], const pg8::Unit& u, int wr, int wc, int fr, int fq) const { epi_loop(acc, u, wr, wc, fr, fq, *this); }
};
struct EpiF32 {
    static constexpr bool PERM = false, AFTER_DRAIN = false;
    float* O; int ld;
    __device__ __forceinline__ void item(int row, int col, const f32x4& a, const f32x4& b) const { float* d = O + (size_t)row * ld + col; stg4(d, a); stg4(d + 16, b); }
    __device__ __forceinline__ void operator()(const f32x4 (&acc)[2][2][4][2], const pg8::Unit& u, int wr, int wc, int fr, int fq) const { epi_loop(acc, u, wr, wc, fr, fq, *this); }
};
struct EpiMlaUq {
    static constexpr bool PERM = false, AFTER_DRAIN = false;
    bf16_t* Q; const float* ropeM;
    __device__ __forceinline__ void half(f32x4& a, const float* tp, bool first) const {
        const f32x4 t0 = ldg4(tp), t1 = ldg4(tp + 4);
        f32x4 pa;
#pragma unroll
        for (int j = 0; j < 4; ++j) { pa[j] = __shfl_xor(a[j], 32); if (first) pa[j] = -pa[j]; }
        a[0] = a[0] * t0[0] + pa[0] * t0[1]; a[1] = a[1] * t0[2] + pa[1] * t0[3]; a[2] = a[2] * t1[0] + pa[2] * t1[1]; a[3] = a[3] * t1[2] + pa[3] * t1[3];
    }
    __device__ __forceinline__ void item(int row, int col, const f32x4& a_, const f32x4& b_) const {
        f32x4 a = a_, b = b_; const int bi = row / TB, t = row - bi * TB; const int g32 = col >> 5;
        const float c2 = 0.10206207261596577f * LOG2E;
        bf16_t* q = Q + (size_t)row * 1536 + col;
        const bool rot = (g32 % 3) == 2 && t >= CL;
        const int fq = (col & 15) >> 2; const bool first = fq < 2; const int i0 = 4 * (fq & 1);
        const float* tp = ropeM + ((size_t)(rot ? t - CL : 0) * 16 + i0) * 2;
        if (rot) half(a, tp, first);
        a = a * c2; store4bf(q, a);
        asm volatile("" ::: "memory");
        if (rot) half(b, tp + 16, first);
        b = b * c2; store4bf(q + 16, b);
        asm volatile("" ::: "memory");
    }
    __device__ __forceinline__ void operator()(const f32x4 (&acc)[2][2][4][2], const pg8::Unit& u, int wr, int wc, int fr, int fq) const { epi_loop(acc, u, wr, wc, fr, fq, *this); }
};
struct EpiMlaUkv {
    static constexpr bool PERM = false, AFTER_DRAIN = false;
    bf16_t *K, *Vt;
    __device__ __forceinline__ void item(int row, int col, const f32x4& a, const f32x4& b) const {
        const int bi = row / TB, t = row - bi * TB; const int head = col >> 7, x = col & 127;
        if (x < 64) { bf16_t* k = K + (size_t)row * 1536 + head * 96 + x; store4bf(k, a); store4bf(k + 16, b); }
        else store_vt(Vt + ((size_t)(bi * 16 + head) * 64 + (x - 64)) * TB + t, a, b);
    }
    __device__ __forceinline__ void operator()(const f32x4 (&acc)[2][2][4][2], const pg8::Unit& u, int wr, int wc, int fr, int fq) const { epi_loop(acc, u, wr, wc, fr, fq, *this); }
};

template <class Epi> __device__ __forceinline__ void run_gemm(LAS unsigned char* lds, const bf16_t* A, const bf16_t* Bt, int N, int K, const Epi& E, bool split = false, bool lat = false) {
    pg8::Gemm g{A, Bt, lat ? NB * SQ : TT, N, K}; pg8::StaticOrder S; S.init(lat ? NB * SQ : TT, N, GRID, fresh_bid(), K / 64, split, lat);
    pg8::gemm_phase<Epi, pg8::StaticOrder, true, true>(lds, g, S, E);
}

__device__ __forceinline__ void transpose_item(const float* W, int K, int N, bf16_t* WT, int mode, LAS float* scr, int item, int lane) {
    const int nblk = N / 32, kb = item / nblk, nb = item - kb * nblk, k0 = 64 * kb, n0 = 32 * nb;
    float wv[32];
#pragma unroll
    for (int i = 0; i < 32; ++i) { const int kk = 2 * i + (lane >> 5); wv[i] = *(const GAS float*)(W + (size_t)(k0 + kk) * N + n0 + (lane & 31)); }
#pragma unroll
    for (int i = 0; i < 32; ++i) { const int kk = 2 * i + (lane >> 5); scr[kk * 33 + (lane & 31)] = wv[i]; }
    asm volatile("s_waitcnt lgkmcnt(0)" ::: "memory");
    const int drow0 = mode == 0 ? n0 : (n0 >> 7) * 256 + (n0 & 127) + (mode == 2 ? 128 : 0);
    const int c = lane & 7;
#pragma unroll
    for (int j = 0; j < 4; ++j) { const int n = (lane >> 3) + 8 * j; const LAS float* s = scr + (8 * c) * 33 + n;
        u32x4 o; o.x = pk2(s[0 * 33], s[1 * 33]); o.y = pk2(s[2 * 33], s[3 * 33]); o.z = pk2(s[4 * 33], s[5 * 33]); o.w = pk2(s[6 * 33], s[7 * 33]);
        *(u32x4*)(WT + (size_t)(drow0 + n) * K + k0 + 8 * c) = o; }
    asm volatile("s_waitcnt lgkmcnt(0)" ::: "memory");
}
__device__ __forceinline__ void conv_job(const float* W, int K, int N, bf16_t* WT, int mode, LAS float* scr, int gw, int NGW, int lane, int& base) {
    const int n = (K / 64) * (N / 32);
    int it = gw - (base % NGW); if (it < 0) it += NGW;
    for (; it < n; it += NGW) transpose_item(W, K, N, WT, mode, scr, it, lane);
    base += n;
}
__device__ __forceinline__ void convert_weights(const Params& p, int layer, LAS unsigned char* lds, unsigned char* dout) {
    const int tid = fresh_tid(), lane = tid & 63, wave = tid >> 6;
    const int gw = fresh_bid() * 8 + wave, NGW = fresh_gdim() * 8;
    LAS float* scr = (LAS float*)(lds + wave * 16384);
    int base = 0;
    const size_t fgu = (size_t)DM * FF;
    for (int f = 0; f < 2; ++f) {
        const size_t off = ((size_t)layer * 2 + f) * fgu;
        bf16_t* gu = (bf16_t*)(dout + (f == 0 ? W_F1GU : W_F2GU)); bf16_t* dn = (bf16_t*)(dout + (f == 0 ? W_F1D : W_F2D));
        conv_job(p.ffn_g + off, DM, FF, gu, 1, scr, gw, NGW, lane, base);
        conv_job(p.ffn_u + off, DM, FF, gu, 2, scr, gw, NGW, lane, base);
        conv_job(p.ffn_d + off, FF, DM, dn, 0, scr, gw, NGW, lane, base);
    }
    bf16_t* win = (bf16_t*)(dout + W_MIN); bf16_t* wout = (bf16_t*)(dout + W_MOUT);
    if (layer == 0) { conv_job(p.gqa_in, DM, 1536, win, 0, scr, gw, NGW, lane, base); conv_job(p.gqa_out, DM, DM, wout, 0, scr, gw, NGW, lane, base); }
    else if (layer == 1) { conv_job(p.diff_in, DM, 3072, win, 0, scr, gw, NGW, lane, base); conv_job(p.diff_out, DM, DM, wout, 0, scr, gw, NGW, lane, base); }
    else if (layer == 2) { conv_job(p.hgrn_in, DM, 5120, win, 0, scr, gw, NGW, lane, base); conv_job(p.hgrn_out, DM, DM, wout, 0, scr, gw, NGW, lane, base); }
    else {
        conv_job(p.mla_down, DM, 544, win, 0, scr, gw, NGW, lane, base);
        conv_job(p.mla_uq, 256, 1536, (bf16_t*)(dout + W_UQ), 0, scr, gw, NGW, lane, base);
        conv_job(p.mla_ukv, 256, 2048, (bf16_t*)(dout + W_UKV), 0, scr, gw, NGW, lane, base);
        conv_job(p.mla_out, DM, DM, wout, 0, scr, gw, NGW, lane, base);
    }
}

__device__ __forceinline__ void prologue(const Params& p, LAS unsigned char* lds) {
    const int tid = fresh_tid(), G = fresh_gdim(), bid = fresh_bid();
    float* HX = (float*)(p.ws + WS_HX);
    for (size_t i0 = (size_t)bid * NTHR + tid; i0 < (size_t)TT * 256; i0 += (size_t)G * NTHR * 8) {
        f32x4 v[8];
#pragma unroll
        for (int q = 0; q < 8; ++q) { const size_t i = i0 + (size_t)q * G * NTHR; const int row = (int)(i >> 8), c4 = (int)(i & 255); const int b = row / TB, t = row - b * TB;
            const float* src = t < CL ? p.ctx + ((size_t)(b * CL + t)) * DM : p.x + ((size_t)(b * SQ + t - CL)) * DM; v[q] = ((const GAS f32x4*)src)[c4]; }
#pragma unroll
        for (int q = 0; q < 8; ++q) ((GAS f32x4*)HX)[i0 + (size_t)q * G * NTHR] = v[q];
    }
    float* ropeH = (float*)(p.ws + WS_ROPEH); float* ropeM = (float*)(p.ws + WS_ROPEM);
    for (int i = bid * NTHR + tid; i < 2048 * 32; i += G * NTHR) { const int s = i >> 5, e = i & 31; const float pos = (e < 16) ? (float)(s >> 6) : (float)(s & 63);
        const float inv = powf(10000.f, -(float)(2 * (e & 15)) / 32.f); const float ang = pos * inv; ropeH[2 * i] = cosf(ang); ropeH[2 * i + 1] = sinf(ang); }
    for (int i = bid * NTHR + tid; i < 2048 * 16; i += G * NTHR) { const int s = i >> 4, e = i & 15; const float pos = (e < 8) ? (float)(s >> 6) : (float)(s & 63);
        const float inv = powf(10000.f, -(float)(2 * (e & 7)) / 16.f); const float ang = pos * inv; ropeM[2 * i] = cosf(ang); ropeM[2 * i + 1] = sinf(ang); }
    if (bid == 0) {
        float* lbv = (float*)(p.ws + WS_LB);
        for (int d = tid; d < 1024; d += NTHR) { const float a0 = p.hgrn_lb[d], a1 = p.hgrn_lb[1024 + d], a2 = p.hgrn_lb[2048 + d], a3 = p.hgrn_lb[3072 + d];
            const float mx = fmaxf(fmaxf(a0, a1), fmaxf(a2, a3)); const float e0 = expf(a0 - mx), e1 = expf(a1 - mx), e2 = expf(a2 - mx), e3 = expf(a3 - mx);
            lbv[d] = (e1 + e2) / (e0 + e1 + e2 + e3); }
        if (tid == 0) { float s1 = 0.f, s2 = 0.f; for (int d = 0; d < 64; ++d) { s1 += p.diff_lambda[d] * p.diff_lambda[64 + d]; s2 += p.diff_lambda[128 + d] * p.diff_lambda[192 + d]; }
            const float lambda_init = 0.8f - 0.6f * expf(-0.3f);
            ((float*)(p.ws + WS_LAM))[0] = expf(s1) - expf(s2) + lambda_init; ((float*)(p.ws + WS_LAM))[1] = lambda_init; }
    }
    LAS float* sS = (LAS float*)lds; LAS float* red = (LAS float*)(lds + 17 * 1024 * 4);
    for (int i = tid; i < 17 * 1024; i += NTHR) { const int r = i >> 10, k = i & 1023; const float v = r < 16 ? p.c[r * 1024 + k] : p.c_ctx[k]; sS[i] = v / (1.f + expf(-v)); }
    __syncthreads();
    float* mod = (float*)(p.ws + WS_MOD);
    for (int item = bid; item < 4 * 144; item += G) {
        const int l = item / 144, n0 = (item - l * 144) * 64, col = tid & 63, kq = tid >> 6;
        const float* W = p.ada_w + (size_t)l * 1024 * NMODV + n0 + col;
        float acc[17];
#pragma unroll
        for (int r = 0; r < 17; ++r) acc[r] = 0.f;
        for (int k = kq * 128; k < kq * 128 + 128; k += 8) {
            float w[8];
#pragma unroll
            for (int i = 0; i < 8; ++i) w[i] = *(const GAS float*)(W + (size_t)(k + i) * NMODV);
#pragma unroll
            for (int i = 0; i < 8; i += 4)
#pragma unroll
                for (int r = 0; r < 17; ++r) { const f32x4 s4 = *(const LAS f32x4*)(sS + r * 1024 + k + i); acc[r] += (s4[0] * w[i] + s4[1] * w[i + 1]) + (s4[2] * w[i + 2] + s4[3] * w[i + 3]); }
        }
#pragma unroll
        for (int r = 0; r < 17; ++r) red[(kq * 17 + r) * 64 + col] = acc[r];
        __syncthreads();
        for (int o = tid; o < 17 * 64; o += NTHR) { const int r = o >> 6, cc = o & 63;
            float s = 0.f;
#pragma unroll
            for (int q = 0; q < 8; ++q) s += red[(q * 17 + r) * 64 + cc];
            mod[((size_t)l * 17 + r) * NMODV + n0 + cc] = s + p.ada_b[(size_t)l * NMODV + n0 + cc]; }
        __syncthreads();
    }
}

__device__ __forceinline__ void norm_phase(float* HX, const float* nw, const float* modl, int shift_idx, int scale_idx, bf16_t* A, const float* P, bool skip_ctx = false) {
    const int tid = fresh_tid(), lane = tid & 63, gw = fresh_bid() * 8 + (tid >> 6), NGW = fresh_gdim() * 8;
    f32x4 w4[4];
#pragma unroll
    for (int j = 0; j < 4; ++j) w4[j] = ldg4(nw + lane * 4 + 256 * j);
    for (int row0 = gw; row0 < TT; row0 += 2 * NGW) {
        f32x4 v[2][4]; int mr[2]; bool act[2];
#pragma unroll
        for (int q = 0; q < 2; ++q) {
            const int row = row0 + q * NGW, b = row / TB, t = row - b * TB; mr[q] = t < CL ? 16 : b; act[q] = !(skip_ctx && t < CL);
            const float* xr = HX + (size_t)row * DM + lane * 4;
            if (act[q]) {
#pragma unroll
                for (int j = 0; j < 4; ++j) v[q][j] = ldg4(xr + 256 * j);
            }
        }
#pragma unroll
        for (int q = 0; q < 2; ++q) {
            const int row = row0 + q * NGW;
            if (act[q] && P != nullptr && row >= SPLIT_PM0 * 256) {
                const GAS u32x2* pr = (const GAS u32x2*)((const bf16_t*)P + (size_t)(row - SPLIT_PM0 * 256) * DM) + lane;
                float* xr = HX + (size_t)row * DM + lane * 4;
#pragma unroll
                for (int j = 0; j < 4; ++j) {
                    f32x4 a = {0.f, 0.f, 0.f, 0.f};
#pragma unroll
                    for (int k = 0; k < 4; ++k) { const u32x2 w = pr[(size_t)k * SPLIT_ROWS * 256 + 64 * j]; a[0] += bflo(w.x); a[1] += bfhi(w.x); a[2] += bflo(w.y); a[3] += bfhi(w.y); }
                    v[q][j] = v[q][j] + a; stg4(xr + 256 * j, v[q][j]); }
            }
        }
#pragma unroll
        for (int q = 0; q < 2; ++q) {
            if (!act[q]) continue;
            const int row = row0 + q * NGW; float ss = 0.f;
#pragma unroll
            for (int j = 0; j < 4; ++j) ss += (v[q][j][0] * v[q][j][0] + v[q][j][1] * v[q][j][1]) + (v[q][j][2] * v[q][j][2] + v[q][j][3] * v[q][j][3]);
            const float rstd = rsqrtf(wave_sum(ss) * (1.f / 1024.f) + 1e-6f);
            const float* sh = modl + (size_t)mr[q] * NMODV + shift_idx * 1024 + lane * 4; const float* sc = modl + (size_t)mr[q] * NMODV + scale_idx * 1024 + lane * 4;
            bf16_t* ar = A + (size_t)row * DM + lane * 4;
#pragma unroll
            for (int j = 0; j < 4; ++j) { const f32x4 s4 = ldg4(sc + 256 * j), h4 = ldg4(sh + 256 * j);
                const f32x4 y = v[q][j] * rstd * w4[j] * (1.f + s4) + h4; store4bf(ar + 256 * j, y); }
        }
    }
}
__device__ __forceinline__ void final_phase(const float* HX, const float* nw, float* out) {
    const int tid = fresh_tid(), lane = tid & 63, gw = fresh_bid() * 8 + (tid >> 6), NGW = fresh_gdim() * 8;
    f32x4 w4[4];
#pragma unroll
    for (int j = 0; j < 4; ++j) w4[j] = ldg4(nw + lane * 4 + 256 * j);
    for (int r0 = gw; r0 < NB * SQ; r0 += 2 * NGW) {
        f32x4 v[2][4];
#pragma unroll
        for (int q = 0; q < 2; ++q) { const int r = r0 + q * NGW, b = r >> 11, sidx = r & 2047; const float* xr = HX + (size_t)(b * TB + CL + sidx) * DM + lane * 4;
#pragma unroll
            for (int j = 0; j < 4; ++j) v[q][j] = ldg4(xr + 256 * j); }
#pragma unroll
        for (int q = 0; q < 2; ++q) { const int r = r0 + q * NGW; float ss = 0.f;
#pragma unroll
            for (int j = 0; j < 4; ++j) ss += (v[q][j][0] * v[q][j][0] + v[q][j][1] * v[q][j][1]) + (v[q][j][2] * v[q][j][2] + v[q][j][3] * v[q][j][3]);
            const float rstd = rsqrtf(wave_sum(ss) * (1.f / 1024.f) + 1e-6f);
            float* o = out + (size_t)r * DM + lane * 4;
#pragma unroll
            for (int j = 0; j < 4; ++j) stg4(o + 256 * j, v[q][j] * rstd * w4[j]); }
    }
}
__device__ __forceinline__ void diff_combine(const bf16_t* O16, const float* subln, const float* lamp, bf16_t* A) {
    const int tid = fresh_tid(), lane = tid & 63, gw = fresh_bid() * 8 + (tid >> 6), NGW = fresh_gdim() * 8;
    const float lam = lamp[0], om = 1.f - lamp[1];
    const int h = lane >> 3, e0 = (lane & 7) * 16;
    float sw[16];
#pragma unroll
    for (int j = 0; j < 16; ++j) sw[j] = subln[e0 + j] * om;
    for (int row = gw; row < TT; row += NGW) {
        const u32x4* o1 = (const u32x4*)(O16 + (size_t)row * 2048 + (2 * h) * 128 + e0); const u32x4* o2 = (const u32x4*)(O16 + (size_t)row * 2048 + (2 * h + 1) * 128 + e0);
        float v[16]; float ss = 0.f;
#pragma unroll
        for (int q = 0; q < 2; ++q) { const u32x4 a = o1[q], b = o2[q];
#pragma unroll
            for (int k = 0; k < 4; ++k) { v[q * 8 + 2 * k] = bflo(a[k]) - lam * bflo(b[k]); v[q * 8 + 2 * k + 1] = bfhi(a[k]) - lam * bfhi(b[k]); } }
#pragma unroll
        for (int j = 0; j < 16; ++j) ss += v[j] * v[j];
        ss += __shfl_xor(ss, 1); ss += __shfl_xor(ss, 2); ss += __shfl_xor(ss, 4);
        const float rstd = rsqrtf(ss * (1.f / 128.f) + 1e-6f);
        u32x4 w0, w1;
        w0.x = pk2(v[0] * rstd * sw[0], v[1] * rstd * sw[1]); w0.y = pk2(v[2] * rstd * sw[2], v[3] * rstd * sw[3]); w0.z = pk2(v[4] * rstd * sw[4], v[5] * rstd * sw[5]); w0.w = pk2(v[6] * rstd * sw[6], v[7] * rstd * sw[7]);
        w1.x = pk2(v[8] * rstd * sw[8], v[9] * rstd * sw[9]); w1.y = pk2(v[10] * rstd * sw[10], v[11] * rstd * sw[11]); w1.z = pk2(v[12] * rstd * sw[12], v[13] * rstd * sw[13]); w1.w = pk2(v[14] * rstd * sw[14], v[15] * rstd * sw[15]);
        u32x4* d = (u32x4*)(A + (size_t)row * 1024 + h * 128 + e0); d[0] = w0; d[1] = w1;
    }
}
__device__ __forceinline__ void hgrn_combine(const bf16_t* OF, const bf16_t* OB, const bf16_t* Gt, const float* nw, bf16_t* A) {
    const int tid = fresh_tid(), lane = tid & 63, gw = fresh_bid() * 8 + (tid >> 6), NGW = fresh_gdim() * 8;
    const int e0 = (lane & 7) * 16;
    float sw[16];
#pragma unroll
    for (int j = 0; j < 16; ++j) sw[j] = nw[e0 + j];
    for (int row = gw; row < TT; row += NGW) {
        const size_t off = (size_t)row * 1024 + lane * 16;
        const u32x4* pf = (const u32x4*)(OF + off); const u32x4* pb = (const u32x4*)(OB + off); const u32x4* pg = (const u32x4*)(Gt + off);
        float v[16], g[16]; float ss = 0.f;
#pragma unroll
        for (int q = 0; q < 2; ++q) { const u32x4 a = pf[q], b = pb[q], c = pg[q];
#pragma unroll
            for (int k = 0; k < 4; ++k) { v[q * 8 + 2 * k] = bflo(a[k]) + bflo(b[k]); v[q * 8 + 2 * k + 1] = bfhi(a[k]) + bfhi(b[k]); g[q * 8 + 2 * k] = bflo(c[k]); g[q * 8 + 2 * k + 1] = bfhi(c[k]); } }
#pragma unroll
        for (int j = 0; j < 16; ++j) ss += v[j] * v[j];
        ss += __shfl_xor(ss, 1); ss += __shfl_xor(ss, 2); ss += __shfl_xor(ss, 4);
        const float rstd = rsqrtf(ss * (1.f / 128.f) + 1e-6f);
        u32x4 w0, w1;
#define HC(j) (v[j] * rstd * sw[j] * g[j])
        w0.x = pk2(HC(0), HC(1)); w0.y = pk2(HC(2), HC(3)); w0.z = pk2(HC(4), HC(5)); w0.w = pk2(HC(6), HC(7));
        w1.x = pk2(HC(8), HC(9)); w1.y = pk2(HC(10), HC(11)); w1.z = pk2(HC(12), HC(13)); w1.w = pk2(HC(14), HC(15));
#undef HC
        u32x4* d = (u32x4*)(A + off); d[0] = w0; d[1] = w1;
    }
}
__device__ __forceinline__ void mla_rows(const float* DN, const float* qn, const float* kvn, const float* ropeM, bf16_t* CQ, bf16_t* CKV, bf16_t* K) {
    const int tid = fresh_tid(), lane = tid & 63, gw = fresh_bid() * 8 + (tid >> 6), NGW = fresh_gdim() * 8;
    const f32x4 wq = ldg4(qn + lane * 4), wk = ldg4(kvn + lane * 4);
    for (int row0 = gw; row0 < TT; row0 += 3 * NGW) {
        f32x4 a3[3], c3[3]; float kr3[3];
#pragma unroll
        for (int q = 0; q < 3; ++q) { const float* dr = DN + (size_t)(row0 + q * NGW) * 768; a3[q] = ldg4(dr + lane * 4); c3[q] = ldg4(dr + 256 + lane * 4); kr3[q] = *(const GAS float*)(dr + 512 + (lane & 31)); }
#pragma unroll
        for (int q = 0; q < 3; ++q) {
        const int row = row0 + q * NGW;
        const int b = row / TB, t = row - b * TB;
        const f32x4 a = a3[q], c = c3[q]; const float kr = kr3[q];
        float sa = (a[0] * a[0] + a[1] * a[1]) + (a[2] * a[2] + a[3] * a[3]), sc = (c[0] * c[0] + c[1] * c[1]) + (c[2] * c[2] + c[3] * c[3]);
        sa = wave_sum(sa); sc = wave_sum(sc);
        const float ra = rsqrtf(sa * (1.f / 256.f) + 1e-6f), rc = rsqrtf(sc * (1.f / 256.f) + 1e-6f);
        store4bf(CQ + (size_t)row * 256 + lane * 4, a * ra * wq); store4bf(CKV + (size_t)row * 256 + lane * 4, c * rc * wk);
        const int d = lane & 31; float kv = kr;
        const float part = __shfl_xor(kr, 8);
        if (t >= CL) { const int e = (d >> 4) * 8 + (d & 7); const float cs = ropeM[((size_t)(t - CL) * 16 + e) * 2], sn = ropeM[((size_t)(t - CL) * 16 + e) * 2 + 1];
            kv = kr * cs + ((d & 8) ? part : -part) * sn; }
        float o8[8];
#pragma unroll
        for (int jj = 0; jj < 8; ++jj) o8[jj] = __shfl(kv, (lane & 3) * 8 + jj);
        u32x4 w; w.x = pk2(o8[0], o8[1]); w.y = pk2(o8[2], o8[3]); w.z = pk2(o8[4], o8[5]); w.w = pk2(o8[6], o8[7]);
        *(GAS u32x4*)(K + (size_t)row * 1536 + (lane >> 2) * 96 + 64 + (lane & 3) * 8) = w;
        }
    }
}

template <int DQK, int DV>
__device__ __forceinline__ void attn_unit(LAS unsigned char* lds, const bf16_t* Qr, int qs, const bf16_t* Kb, int ks, const bf16_t* Vtb, bf16_t* Or, int os,
                                          int lt0, int lt1, bool windowed, int qpos0, float m_init, float l_init,
                                          int dmode = 0  , float lam = 0.f, float om = 0.f, const float* subw = nullptr) {
    constexpr int KST = DQK * 2 + 16, VST = 144, KBUF = 64 * KST, VBUF = DV * VST, KCH = DQK / 8, NKC = 64 * KCH, KPT = (NKC + NTHR - 1) / NTHR, VPT = DV / 64, ND = DQK / 16, NO = DV / 32;
    const int tid = fresh_tid(), lane = tid & 63, r32 = lane & 31, hi = lane >> 5, wid = tid >> 6;
    LAS unsigned char* Kl = lds; LAS unsigned char* Vl = lds + 2 * KBUF;
    const int ntiles = 4 + (lt1 - lt0);
    const GAS bf16_t* Qg = (const GAS bf16_t*)Qr; const GAS bf16_t* Kg = (const GAS bf16_t*)Kb; const GAS bf16_t* Vg = (const GAS bf16_t*)Vtb; GAS bf16_t* Og = (GAS bf16_t*)Or;
    bf16x8 qf[ND];
#pragma unroll
    for (int d0 = 0; d0 < ND; ++d0) qf[d0] = *(const GAS bf16x8*)(Qg + (size_t)(wid * 32 + r32) * qs + d0 * 16 + hi * 8);
    f32x16 o[NO];
#pragma unroll
    for (int nb = 0; nb < NO; ++nb)
#pragma unroll
        for (int r = 0; r < 16; ++r) o[nb][r] = 0.f;
    const bool have_ref = l_init > 0.f;
    float m = have_ref ? m_init : 0.f, l = (hi == 0) ? l_init : 0.f;
    u32x4 kreg[KPT], vreg[VPT];
#define ATT_KT(tt_) ((tt_) < 4 ? (tt_) : lt0 + (tt_) - 4)
#define ATT_LOADK(tt_) do { const int kt_ = ATT_KT(tt_); \
        _Pragma("unroll") for (int i_ = 0; i_ < KPT; ++i_) { const int c_ = tid + NTHR * i_; if (c_ < NKC) { const int key_ = c_ / KCH, part_ = c_ - key_ * KCH; kreg[i_] = *(const GAS u32x4*)(Kg + (size_t)(kt_ * 64 + key_) * ks + part_ * 8); } } } while (0)
#define ATT_LOADV(tt_) do { const int kt_ = ATT_KT(tt_); \
        _Pragma("unroll") for (int i_ = 0; i_ < VPT; ++i_) { const int c_ = tid + NTHR * i_; const int dv_ = c_ >> 3, part_ = c_ & 7; vreg[i_] = *(const GAS u32x4*)(Vg + (size_t)dv_ * TB + kt_ * 64 + part_ * 8); } } while (0)
#define ATT_STOREK(buf_) do { \
        _Pragma("unroll") for (int i_ = 0; i_ < KPT; ++i_) { const int c_ = tid + NTHR * i_; if (c_ < NKC) { const int key_ = c_ / KCH, part_ = c_ - key_ * KCH; *(LAS u32x4*)(Kl + (buf_) * KBUF + key_ * KST + part_ * 16) = kreg[i_]; } } } while (0)
#define ATT_STOREV(buf_) do { \
        _Pragma("unroll") for (int i_ = 0; i_ < VPT; ++i_) { const int c_ = tid + NTHR * i_; const int dv_ = c_ >> 3, part_ = c_ & 7; LAS unsigned char* d_ = Vl + (buf_) * VBUF + dv_ * VST + (part_ >> 1) * 32 + (part_ & 1) * 8;     \
            *(LAS u32x2*)d_ = (u32x2){vreg[i_].x, vreg[i_].y}; *(LAS u32x2*)(d_ + 16) = (u32x2){vreg[i_].z, vreg[i_].w}; } } while (0)
#define SCHED_FENCE() __builtin_amdgcn_sched_barrier(0)
#define ATT_KFRAG(buf_) do { const LAS unsigned char* kb_ = Kl + (buf_) * KBUF + r32 * KST + hi * 16; \
        _Pragma("unroll") for (int d0 = 0; d0 < ND; ++d0) { kf[2 * d0] = *(const LAS bf16x8*)(kb_ + d0 * 32); kf[2 * d0 + 1] = *(const LAS bf16x8*)(kb_ + 32 * KST + d0 * 32); } } while (0)
#define ATT_QKM(P0_, P1_) do { \
        _Pragma("unroll") for (int d0 = 0; d0 < ND; ++d0) { \
            if (d0 == 0) { const f32x16 z_ = {0.f, 0.f, 0.f, 0.f, 0.f, 0.f, 0.f, 0.f, 0.f, 0.f, 0.f, 0.f, 0.f, 0.f, 0.f, 0.f}; P0_ = __builtin_amdgcn_mfma_f32_32x32x16_bf16(kf[0], qf[0], z_, 0, 0, 0); P1_ = __builtin_amdgcn_mfma_f32_32x32x16_bf16(kf[1], qf[0], z_, 0, 0, 0); } \
            else { P0_ = __builtin_amdgcn_mfma_f32_32x32x16_bf16(kf[2 * d0], qf[d0], P0_, 0, 0, 0); P1_ = __builtin_amdgcn_mfma_f32_32x32x16_bf16(kf[2 * d0 + 1], qf[d0], P1_, 0, 0, 0); } } } while (0)
#define ATT_VFRAG(dst_, nb_) do { _Pragma("unroll") for (int j_ = 0; j_ < 4; ++j_) dst_[j_] = *(const LAS u32x4*)(vb + (nb_) * 32 * VST + j_ * 32); } while (0)
    bf16x8 kf[2 * ND];
    f32x16 n0, n1;
    ATT_LOADK(0); ATT_LOADV(0); ATT_STOREK(0); ATT_STOREV(0);
    __syncthreads();
    ATT_LOADK(1); ATT_KFRAG(0); ATT_QKM(n0, n1); ATT_STOREK(1);
    __syncthreads();
    for (int tt = 0; tt < ntiles; ++tt) {
        const int cur = tt & 1;
        f32x16 p0 = n0, p1 = n1;
        if (tt + 2 < ntiles) ATT_LOADK(tt + 2);
        if (tt + 1 < ntiles) ATT_LOADV(tt + 1);
#define ATT_OUTSIDE(t_) (windowed && (t_) >= 4 && (((lt0 + (t_) - 4) * 64 - CL) > qhi_w + 128 || ((lt0 + (t_) - 4) * 64 - CL + 63) < qlo_w - 128))
        const int qlo_w = qpos0 + __builtin_amdgcn_readfirstlane(wid) * 32, qhi_w = qlo_w + 31;
        const bool skip_cur = ATT_OUTSIDE(tt), skip_next = ATT_OUTSIDE(tt + 1);
        u32x4 pw[4];
        if (!skip_cur) {
        if (windowed && tt >= 4) {
            const int kt = lt0 + tt - 4; const int kbase = kt * 64 - CL, qp = qpos0 + wid * 32 + r32;
#pragma unroll
            for (int r = 0; r < 16; ++r) { const int d0 = qp - (kbase + crow(r, hi)); if (d0 > 128 || d0 < -128) p0[r] = -1e30f; const int d1 = d0 - 32; if (d1 > 128 || d1 < -128) p1[r] = -1e30f; }
        }
        float mx = __builtin_fmaxf(__builtin_fmaxf(p0[0], p1[0]), p0[1]);
#pragma unroll
        for (int r = 1; r < 16; ++r) { if (r > 1) mx = __builtin_fmaxf(__builtin_fmaxf(mx, p0[r]), p1[r]); else mx = __builtin_fmaxf(mx, p1[1]); }
        mx = __builtin_fmaxf(mx, __shfl_xor(mx, 32)) - m;
        const bool force = (tt == 0) && !have_ref;
        if (force || __any(mx > 8.f)) {
            const float delta = force ? mx : __builtin_fmaxf(mx, 0.f);
            m += delta;
            if (!force) { const float alpha = __builtin_amdgcn_exp2f(-delta); l *= alpha;
#pragma unroll
                for (int nb = 0; nb < NO; ++nb)
#pragma unroll
                    for (int r = 0; r < 16; ++r) o[nb][r] *= alpha; }
        }
        float ls = 0.f;
#pragma unroll
        for (int r = 0; r < 16; ++r) { p0[r] = __builtin_amdgcn_exp2f(p0[r] - m); p1[r] = __builtin_amdgcn_exp2f(p1[r] - m); ls += p0[r] + p1[r]; }
        l += ls;
        pw[0] = (u32x4){pk2(p0[0], p0[1]), pk2(p0[2], p0[3]), pk2(p0[4], p0[5]), pk2(p0[6], p0[7])};
        pw[1] = (u32x4){pk2(p0[8], p0[9]), pk2(p0[10], p0[11]), pk2(p0[12], p0[13]), pk2(p0[14], p0[15])};
        pw[2] = (u32x4){pk2(p1[0], p1[1]), pk2(p1[2], p1[3]), pk2(p1[4], p1[5]), pk2(p1[6], p1[7])};
        pw[3] = (u32x4){pk2(p1[8], p1[9]), pk2(p1[10], p1[11]), pk2(p1[12], p1[13]), pk2(p1[14], p1[15])};
        SCHED_FENCE();
        }
        const LAS unsigned char* vb = Vl + cur * VBUF + r32 * VST + hi * 16;
        u32x4 vf[2][4];
        if (!skip_next) ATT_KFRAG(cur ^ 1);
        if (!skip_cur) ATT_VFRAG(vf[0], 0);
        SCHED_FENCE();
        if (!skip_next) ATT_QKM(n0, n1);
        if (!skip_cur) {
#pragma unroll
        for (int nb = 0; nb < NO; ++nb) {
            if (nb + 1 < NO) ATT_VFRAG(vf[(nb + 1) & 1], nb + 1);
            SCHED_FENCE();
#pragma unroll
            for (int j = 0; j < 4; ++j) o[nb] = __builtin_amdgcn_mfma_f32_32x32x16_bf16(__builtin_bit_cast(bf16x8, vf[nb & 1][j]), __builtin_bit_cast(bf16x8, pw[j]), o[nb], 0, 0, 0);
            SCHED_FENCE();
        }
        }
#undef ATT_OUTSIDE
        if (tt + 2 < ntiles) ATT_STOREK(cur);
        if (tt + 1 < ntiles) ATT_STOREV(cur ^ 1);
        __syncthreads();
    }
#undef SCHED_FENCE
#undef ATT_KFRAG
#undef ATT_QKM
#undef ATT_VFRAG
#undef ATT_KT
#undef ATT_LOADK
#undef ATT_LOADV
#undef ATT_STOREK
#undef ATT_STOREV
    l += __shfl_xor(l, 32);
    const float inv = 1.f / l;
    GAS bf16_t* orow = Og + (size_t)(wid * 32 + r32) * os + 4 * hi;
    LAS unsigned char* stash = lds + 2 * KBUF + 2 * VBUF + (wid * 32 + r32) * 264 + 8 * hi;
    if (DV == 128 && dmode == 1) {
#pragma unroll
        for (int nb = 0; nb < NO; ++nb)
#pragma unroll
            for (int g = 0; g < 4; ++g) { u32x2 w; w.x = pk2(o[nb][4 * g] * inv, o[nb][4 * g + 1] * inv); w.y = pk2(o[nb][4 * g + 2] * inv, o[nb][4 * g + 3] * inv); *(LAS u32x2*)(stash + nb * 64 + 16 * g) = w; }
    } else if (DV == 128 && dmode == 2) {
        const float li = lam * inv; float ss = 0.f;
#pragma unroll
        for (int nb = 0; nb < NO; ++nb)
#pragma unroll
            for (int g = 0; g < 4; ++g) { const u32x2 a = *(const LAS u32x2*)(stash + nb * 64 + 16 * g);
                const float x0 = bflo(a.x) - li * o[nb][4 * g], x1 = bfhi(a.x) - li * o[nb][4 * g + 1], x2 = bflo(a.y) - li * o[nb][4 * g + 2], x3 = bfhi(a.y) - li * o[nb][4 * g + 3];
                o[nb][4 * g] = x0; o[nb][4 * g + 1] = x1; o[nb][4 * g + 2] = x2; o[nb][4 * g + 3] = x3; ss += (x0 * x0 + x1 * x1) + (x2 * x2 + x3 * x3); }
        ss += __shfl_xor(ss, 32);
        const float rs = rsqrtf(ss * (1.f / 128.f) + 1e-6f) * om;
#pragma unroll
        for (int nb = 0; nb < NO; ++nb)
#pragma unroll
            for (int g = 0; g < 4; ++g) { const f32x4 w4 = ldg4(subw + nb * 32 + 8 * g + 4 * hi); u32x2 w;
                w.x = pk2(o[nb][4 * g] * rs * w4[0], o[nb][4 * g + 1] * rs * w4[1]); w.y = pk2(o[nb][4 * g + 2] * rs * w4[2], o[nb][4 * g + 3] * rs * w4[3]); *(GAS u32x2*)(orow + nb * 32 + 8 * g) = w; }
    } else {
#pragma unroll
    for (int nb = 0; nb < NO; ++nb)
#pragma unroll
        for (int g = 0; g < 4; ++g) { u32x2 w; w.x = pk2(o[nb][4 * g] * inv, o[nb][4 * g + 1] * inv); w.y = pk2(o[nb][4 * g + 2] * inv, o[nb][4 * g + 3] * inv); *(GAS u32x2*)(orow + nb * 32 + 8 * g) = w; }
    }
}

template <int KIND>
__device__ __forceinline__ void attn_phase(unsigned char* big, bf16_t* Abuf, const float* sinks  , const float* lamp, LAS unsigned char* lds, bool with_ctx) {
    constexpr int NHU = (KIND == 1) ? 8 : 16;
    const int NLAT = NB * NHU * 8, NU = NLAT + (with_ctx ? NB * NHU : 0);
    const int bid_ = fresh_bid(), vb_ = (bid_ & 7) * (GRID / 8) + (bid_ >> 3);
    for (int u = vb_; u < NU; u += GRID) {
        int b, head, j;
        if (u < NLAT) { j = 1 + (u & 7); head = (u >> 3) % NHU; b = (u >> 3) / NHU; } else { const int v = u - NLAT; j = 0; head = v % NHU; b = v / NHU; }
        const size_t row0 = (size_t)b * TB + j * 256;
        int lt0 = 4, lt1 = 4; const int qpos0 = (j - 1) * 256;
        if (j > 0) { if (KIND == 0) { int lo = qpos0 - 128; if (lo < 0) lo = 0; int hi = qpos0 + 255 + 128; if (hi > SQ - 1) hi = SQ - 1; lt0 = 4 + lo / 64; lt1 = 4 + hi / 64 + 1; } else { lt0 = 4; lt1 = 36; } }
        if (KIND == 0) {
            const bf16_t* Q = (const bf16_t*)big; const bf16_t* K = (const bf16_t*)(big + U72); const bf16_t* Vt = (const bf16_t*)(big + U72 + 18 * MiB);
            const float sink = sinks[head] * LOG2E;
            attn_unit<64, 64>(lds, Q + row0 * 1024 + head * 64, 1024, K + (size_t)b * TB * 256 + (head >> 2) * 64, 256, Vt + (size_t)(b * 4 + (head >> 2)) * 64 * TB,
                              Abuf + row0 * 1024 + head * 64, 1024, lt0, lt1, true, qpos0, sink, 1.f);
        } else if (KIND == 1) {
            const bf16_t* Q = (const bf16_t*)big; const bf16_t* K = (const bf16_t*)(big + U72); const bf16_t* Vt = (const bf16_t*)(big + 2 * U72);
            const float lam = lamp[0], om = 1.f - lamp[1];
            attn_unit<64, 128>(lds, Q + row0 * 1024 + (2 * head) * 64, 1024, K + (size_t)b * TB * 1024 + (2 * head) * 64, 1024, Vt + (size_t)(b * 8 + head) * 128 * TB,
                               Abuf + row0 * 1024 + head * 128, 1024, lt0, lt1, false, qpos0, -1e30f, 0.f, 1);
            attn_unit<64, 128>(lds, Q + row0 * 1024 + (2 * head + 1) * 64, 1024, K + (size_t)b * TB * 1024 + (2 * head + 1) * 64, 1024, Vt + (size_t)(b * 8 + head) * 128 * TB,
                               Abuf + row0 * 1024 + head * 128, 1024, lt0, lt1, false, qpos0, -1e30f, 0.f, 2, lam, om, sinks);
        } else {
            const bf16_t* Vt = (const bf16_t*)big; const bf16_t* Q = (const bf16_t*)(big + 2 * U72); const bf16_t* K = (const bf16_t*)(big + 2 * U72 + 108 * MiB);
            attn_unit<96, 64>(lds, Q + row0 * 1536 + head * 96, 1536, K + (size_t)b * TB * 1536 + head * 96, 1536, Vt + (size_t)(b * 16 + head) * 64 * TB,
                              Abuf + row0 * 1024 + head * 64, 1024, lt0, lt1, false, qpos0, -1e30f, 0.f);
        }
    }
}

__device__ __forceinline__ void hgrn_scan(unsigned char* big, bf16_t* OF, bf16_t* OB, LAS unsigned char* lds) {
    constexpr int GST = 132;
    constexpr int O_G = 0, O_QT = 34816, O_KT = O_QT + 17408, O_KTT = O_KT + 17408, O_VT = O_KTT + 18432, O_AB = O_VT + 18432, O_SEG = O_AB + 9216, O_GM = O_SEG + 2048, O_GL = O_GM + 512;
    const bf16_t* Qh = (const bf16_t*)big; const bf16_t* Vv = (const bf16_t*)(big + 3 * U72);
    const int tid = fresh_tid(), lane = tid & 63, r32 = lane & 31, hi = lane >> 5, wid = tid >> 6;
    LAS float* Gs = (LAS float*)(lds + O_G); LAS unsigned char* STb = lds + O_G;
    LAS unsigned char* QTb = lds + O_QT; LAS unsigned char* KTb = lds + O_KT; LAS unsigned short* KTT = (LAS unsigned short*)(lds + O_KTT); LAS unsigned short* VT = (LAS unsigned short*)(lds + O_VT);
    LAS unsigned short* AB = (LAS unsigned short*)(lds + O_AB); LAS float* SEG = (LAS float*)(lds + O_SEG); LAS float* GM = (LAS float*)(lds + O_GM); LAS float* GL = (LAS float*)(lds + O_GL);
    for (int u = fresh_bid(); u < 256; u += fresh_gdim()) {
        const int dir = u & 1, h = (u >> 1) & 7, b = u >> 4;
        const unsigned short* LFd = (const unsigned short*)(big + (dir == 0 ? U72 : 2 * U72));
        bf16_t* Od = dir == 0 ? OF : OB;
        f32x16 S[2];
#pragma unroll
        for (int nb = 0; nb < 2; ++nb)
#pragma unroll
            for (int r = 0; r < 16; ++r) S[nb][r] = 0.f;
        const int db = wid >> 1, eh = wid & 1, ti = wid >> 2, ei = wid & 3;
        u32x4 q8[2], lf8[2], v8[2];
#define HG_TOK(ci_, tp_) ((size_t)b * TB + (size_t)((dir == 0) ? (ci_) : ((ci_) < 4 ? 3 - (ci_) : 39 - (ci_))) * 64 + ((dir == 0) ? (tp_) : 63 - (tp_)))
#define HG_LOAD(ci_) do { _Pragma("unroll") for (int i_ = 0; i_ < 2; ++i_) { const int ch_ = tid + NTHR * i_; const int tp_ = ch_ & 63, dc_ = ch_ >> 6; const size_t o_ = HG_TOK(ci_, tp_) * 1024 + h * 128 + dc_ * 8; \
            q8[i_] = *(const GAS u32x4*)((const GAS bf16_t*)Qh + o_); lf8[i_] = *(const GAS u32x4*)((const GAS unsigned short*)LFd + o_); v8[i_] = *(const GAS u32x4*)((const GAS bf16_t*)Vv + o_); } } while (0)
        HG_LOAD(0);
        for (int ci = 0; ci < 36; ++ci) {
#pragma unroll
            for (int i = 0; i < 2; ++i) { const int ch = tid + NTHR * i, tp = ch & 63, dc = ch >> 6; LAS float* g = Gs + tp * GST + dc * 8;
#pragma unroll
                for (int k = 0; k < 4; ++k) { g[2 * k] = h2f((unsigned short)(lf8[i][k] & 0xffffu)); g[2 * k + 1] = h2f((unsigned short)(lf8[i][k] >> 16)); } }
            __syncthreads();
            { const int d = tid & 127, seg = tid >> 7; float run = 0.f;
#pragma unroll
              for (int t = 0; t < 16; ++t) { LAS float* g = Gs + (seg * 16 + t) * GST + d; run += *g; *g = run; }
              SEG[seg * 128 + d] = run; }
            __syncthreads();
#pragma unroll
            for (int i = 0; i < 2; ++i) { const int ch = tid + NTHR * i, tp = ch & 63, dc = ch >> 6, seg = tp >> 4;
                float qt[8], kt[8];
#pragma unroll
                for (int k = 0; k < 8; ++k) { const int d = dc * 8 + k; const float s0 = SEG[d], s1 = SEG[128 + d], s2 = SEG[256 + d];
                    const float off = (seg > 0 ? s0 : 0.f) + (seg > 1 ? s1 : 0.f) + (seg > 2 ? s2 : 0.f);
                    const float g = Gs[tp * GST + d] + off, gm = s0 + s1 + Gs[32 * GST + d];
                    const unsigned lw = lf8[i][k >> 1], qw = q8[i][k >> 1], vw = v8[i][k >> 1];
                    const float lf = h2f((unsigned short)((k & 1) ? (lw >> 16) : (lw & 0xffffu)));
                    const float qv = (k & 1) ? bfhi(qw) : bflo(qw);
                    const float kk = 1.f - __expf(lf);
                    qt[k] = qv * __expf(g - gm); kt[k] = kk * __expf(gm - g);
                    KTT[d * 72 + tp] = f2bf(kt[k]); VT[d * 72 + tp] = (unsigned short)((k & 1) ? (vw >> 16) : (vw & 0xffffu)); }
                *(LAS u32x4*)(QTb + tp * 272 + dc * 16) = (u32x4){pk2(qt[0], qt[1]), pk2(qt[2], qt[3]), pk2(qt[4], qt[5]), pk2(qt[6], qt[7])};
                *(LAS u32x4*)(KTb + tp * 272 + dc * 16) = (u32x4){pk2(kt[0], kt[1]), pk2(kt[2], kt[3]), pk2(kt[4], kt[5]), pk2(kt[6], kt[7])}; }
            if (tid < 128) { const float s0 = SEG[tid], s1 = SEG[128 + tid], s2 = SEG[256 + tid], s3 = SEG[384 + tid]; GM[tid] = s0 + s1 + Gs[32 * GST + tid]; GL[tid] = (s0 + s1) + (s2 + s3); }
            if (ci + 1 < 36) HG_LOAD(ci + 1);
            __syncthreads();
#pragma unroll
            for (int nb = 0; nb < 2; ++nb)
#pragma unroll
                for (int g4 = 0; g4 < 4; ++g4) { const int d0 = 32 * db + 8 * g4 + 4 * hi; const f32x4 gm4 = *(const LAS f32x4*)(GM + d0);
#pragma unroll
                    for (int k = 0; k < 4; ++k) S[nb][4 * g4 + k] *= __expf(gm4[k]);
                    *(LAS u32x2*)(STb + (64 * eh + 32 * nb + r32) * 272 + d0 * 2) = (u32x2){pk2(S[nb][4 * g4], S[nb][4 * g4 + 1]), pk2(S[nb][4 * g4 + 2], S[nb][4 * g4 + 3])}; }
            __syncthreads();
            f32x16 o;
#pragma unroll
            for (int r = 0; r < 16; ++r) o[r] = 0.f;
#pragma unroll
            for (int kk = 0; kk < 8; ++kk) { const bf16x8 a = *(const LAS bf16x8*)(QTb + (32 * ti + r32) * 272 + kk * 32 + hi * 16), bb = *(const LAS bf16x8*)(STb + (32 * ei + r32) * 272 + kk * 32 + hi * 16);
                o = __builtin_amdgcn_mfma_f32_32x32x16_bf16(a, bb, o, 0, 0, 0); }
            if (wid < 4) { const int ti2 = wid >> 1, si = wid & 1; f32x16 a2;
#pragma unroll
                for (int r = 0; r < 16; ++r) a2[r] = 0.f;
#pragma unroll
                for (int kk = 0; kk < 8; ++kk) { const bf16x8 a = *(const LAS bf16x8*)(QTb + (32 * ti2 + r32) * 272 + kk * 32 + hi * 16), bb = *(const LAS bf16x8*)(KTb + (32 * si + r32) * 272 + kk * 32 + hi * 16);
                    a2 = __builtin_amdgcn_mfma_f32_32x32x16_bf16(a, bb, a2, 0, 0, 0); }
#pragma unroll
                for (int r = 0; r < 16; ++r) { const int t = 32 * ti2 + crow(r, hi), s = 32 * si + r32; AB[t * 72 + s] = (t >= s) ? f2bf(a2[r]) : (unsigned short)0; } }
            __syncthreads();
#pragma unroll
            for (int kk = 0; kk < 4; ++kk) { const bf16x8 a = *(const LAS bf16x8*)((LAS unsigned char*)AB + (32 * ti + r32) * 144 + kk * 32 + hi * 16), bb = *(const LAS bf16x8*)((LAS unsigned char*)VT + (32 * ei + r32) * 144 + kk * 32 + hi * 16);
                o = __builtin_amdgcn_mfma_f32_32x32x16_bf16(a, bb, o, 0, 0, 0); }
#pragma unroll
            for (int r = 0; r < 16; ++r) { const int t = 32 * ti + crow(r, hi); ((GAS bf16_t*)Od)[HG_TOK(ci, t) * 1024 + h * 128 + 32 * ei + r32] = f2bf(o[r]); }
#pragma unroll
            for (int nb = 0; nb < 2; ++nb)
#pragma unroll
                for (int kk = 0; kk < 4; ++kk) { const bf16x8 a = *(const LAS bf16x8*)((LAS unsigned char*)KTT + (32 * db + r32) * 144 + kk * 32 + hi * 16), bb = *(const LAS bf16x8*)((LAS unsigned char*)VT + (64 * eh + 32 * nb + r32) * 144 + kk * 32 + hi * 16);
                    S[nb] = __builtin_amdgcn_mfma_f32_32x32x16_bf16(a, bb, S[nb], 0, 0, 0); }
#pragma unroll
            for (int g4 = 0; g4 < 4; ++g4) { const int d0 = 32 * db + 8 * g4 + 4 * hi; const f32x4 gm4 = *(const LAS f32x4*)(GM + d0), gl4 = *(const LAS f32x4*)(GL + d0);
#pragma unroll
                for (int k = 0; k < 4; ++k) { const float sc = __expf(gl4[k] - gm4[k]); S[0][4 * g4 + k] *= sc; S[1][4 * g4 + k] *= sc; } }
            __syncthreads();
        }
#undef HG_LOAD
#undef HG_TOK
    }
}


#define XB_TMO      128
#define XB_XCNT(j)  (256  + 64 * (j))
#define XB_XSUB(j)  (1280 + 64 * (j))
#define XB_XGEN(j)  (2304 + 64 * (j))
#define XB_TOP      3328
#define XB_TOPGEN   3392
#define XCD_BAR_WORDS 3456
#define XB_SPIN_CAP (1u << 18)

__device__ __forceinline__ unsigned xb_ld(unsigned* p)              { return __hip_atomic_load(p, __ATOMIC_RELAXED, __HIP_MEMORY_SCOPE_AGENT); }
__device__ __forceinline__ unsigned xb_add(unsigned* p, unsigned v) { return __hip_atomic_fetch_add(p, v, __ATOMIC_RELAXED, __HIP_MEMORY_SCOPE_AGENT); }
__device__ __forceinline__ unsigned xb_xcc_id() { return (unsigned)__builtin_amdgcn_s_getreg((3 << 11) | 20) & 0xFu; }
#define XB_SPIN(cond, bar) do { unsigned _sp = 0; while (cond) { __builtin_amdgcn_s_sleep(1); \
    if ((++_sp & 255u) == 0u) { if (xb_ld(&(bar)[XB_TMO])) break; if (_sp > XB_SPIN_CAP) { atomicAdd(&(bar)[XB_TMO], 1u); break; } } } } while (0)

struct XcdBarrier {
    unsigned* bar; unsigned x;
    volatile LAS unsigned* st;
};

__device__ __forceinline__ XcdBarrier xcd_barrier_post(unsigned* bar, volatile LAS unsigned* st) {
    XcdBarrier b; b.bar = bar; b.x = xb_xcc_id(); b.st = st;
    if (threadIdx.x == 0) (void)xb_add(&bar[XB_XCNT(b.x)], 1u);
    return b;
}
__device__ __forceinline__ void xcd_barrier_complete(unsigned* bar, unsigned x, unsigned& nloc, unsigned& nx) {
    const unsigned G = gridDim.x * gridDim.y * gridDim.z;
    unsigned sum, cnt, mine, sp = 0u;
    for (;;) {
        sum = 0u; cnt = 0u; mine = 0u;
#pragma unroll
        for (unsigned j = 0; j < 16; ++j) { const unsigned c = xb_ld(&bar[XB_XCNT(j)]); sum += c; cnt += (c > 0u) ? 1u : 0u; mine = (j == x) ? c : mine; }
        if (sum == G) break;
        __builtin_amdgcn_s_sleep(1);
        if ((++sp & 255u) == 0u) { if (xb_ld(&bar[XB_TMO])) break; if (sp > XB_SPIN_CAP) { atomicAdd(&bar[XB_TMO], 1u); break; } }
    }
    nloc = mine > 0u ? mine : 1u; nx = cnt > 0u ? cnt : 1u;
}

__device__ __forceinline__ void xcd_barrier(const XcdBarrier& b) {
    asm volatile("s_waitcnt vmcnt(0)" ::: "memory");
    __syncthreads();
    if (threadIdx.x == 0) {
        unsigned* bar = b.bar;
        __builtin_amdgcn_s_waitcnt(0);
        unsigned nloc = b.st[0], nx = b.st[1];
        if (nloc == 0u) { xcd_barrier_complete(bar, b.x, nloc, nx); b.st[0] = nloc; b.st[1] = nx; }
        const unsigned old = xb_add(&bar[XB_XSUB(b.x)], 1u);
        const unsigned gen = old / nloc;
        if (old + 1u == (gen + 1u) * nloc) {
            __builtin_amdgcn_fence(__ATOMIC_RELEASE, "agent");
            asm volatile("s_waitcnt vmcnt(0)" ::: "memory");
            const unsigned og = xb_add(&bar[XB_TOP], 1u);
            const unsigned tg = og / nx;
            if (og + 1u == (tg + 1u) * nx) xb_add(&bar[XB_TOPGEN], 1u);
            else XB_SPIN(xb_ld(&bar[XB_TOPGEN]) == tg, bar);
            __builtin_amdgcn_fence(__ATOMIC_ACQUIRE, "agent");
            xb_add(&bar[XB_XGEN(b.x)], 1u);
            asm volatile("s_waitcnt vmcnt(0)" ::: "memory");
        } else {
            XB_SPIN(xb_ld(&bar[XB_XGEN(b.x)]) == gen, bar);
            __builtin_amdgcn_fence(__ATOMIC_ACQUIRE, "agent");
            asm volatile("s_waitcnt vmcnt(0)" ::: "memory");
        }
    }
    __syncthreads();
}

enum { K_X = 0, K_C, K_CTX, K_CCTX, K_ADAW, K_ADAB, K_NORMW, K_FNORMW, K_FFNG, K_FFNU, K_FFND, K_GQAIN, K_GQAOUT, K_GQASINK, K_DIFFIN, K_DIFFOUT, K_DIFFLAM, K_DIFFSUB,
       K_HGRNIN, K_HGRNOUT, K_HGRNNORM, K_HGRNLB, K_MLADOWN, K_MLAQN, K_MLAKVN, K_MLAUQ, K_MLAUKV, K_MLAOUT, K_OUT, K_WS };
__device__ __forceinline__ const float* karg_ptr(int idx) {
    const __attribute__((address_space(4))) unsigned long long* ka = (const __attribute__((address_space(4))) unsigned long long*)__builtin_amdgcn_kernarg_segment_ptr();
    int i = idx; asm volatile("" : "+s"(i));
    return (const float*)ka[i];
}
__device__ __forceinline__ Params load_params() {
    Params q;
    const float** qq = (const float**)&q;
#pragma unroll
    for (int i = 0; i < 30; ++i) qq[i] = karg_ptr(i);
    q.ph_lo = 0; q.ph_hi = 0;
    return q;
}
__global__ void __launch_bounds__(NTHR, 2) fwd_megakernel(Params p) {
    extern __shared__ __attribute__((aligned(16))) unsigned char lds_raw[];
    LAS unsigned char* lds = (LAS unsigned char*)lds_raw;
    cg::grid_group grid = cg::this_grid();
    const int ph_lo = p.ph_lo, ph_hi = p.ph_hi;
    volatile LAS unsigned* bst = (volatile LAS unsigned*)(lds + LDS_BYTES - 64);
    if (threadIdx.x < 2) bst[threadIdx.x] = 0u;
    __syncthreads();
    XcdBarrier bar = xcd_barrier_post((unsigned*)((unsigned char*)karg_ptr(K_WS) + WS_BAR), bst);
    int nsync = 0;
#define GRID_SYNC() do { xcd_barrier(bar); ++nsync; } while (0)
    if (ph_lo < 0) grid.sync();
    int ph = 0;
#ifndef PH_MASK
#define PH_MASK 0xffffffffu
#endif
#define COMP(k) (((PH_MASK) >> (k)) & 1u)
#ifndef DUP_MASK
#define DUP_MASK 0u
#endif
#define NREP(k) (1 + (int)(((DUP_MASK) >> (k)) & 1u))
#define PHASE_BEGIN(k) if (ph >= ph_lo && ph < ph_hi) { unsigned char* dout = (unsigned char*)karg_ptr(K_OUT); unsigned char* ws = (unsigned char*)karg_ptr(K_WS); \
        unsigned char* big = ws + WS_BIG; float* HX = (float*)(ws + WS_HX); const float* mod = (const float*)(ws + WS_MOD); bf16_t* Abuf = (bf16_t*)(dout + DO_A); \
        const float* modl = mod + (size_t)layer * 17 * NMODV; (void)big; (void)HX; (void)modl; (void)Abuf; \
        for (int rep_ = 0; rep_ < NREP(k); ++rep_) { if (rep_) GRID_SYNC();
#define PHASE_END   } if (ph + 1 < ph_hi) GRID_SYNC(); } ++ph;
    int layer = 0;
    PHASE_BEGIN(0) if (COMP(0)) { const Params q = load_params(); prologue(q, lds); } PHASE_END
#pragma unroll 1
    for (layer = 0; layer < 4; ++layer) {
        const bool with_ctx = layer < 3;
        PHASE_BEGIN(1) if (COMP(1)) { { const Params q = load_params(); convert_weights(q, layer, lds, dout); } __syncthreads(); norm_phase(HX, karg_ptr(K_NORMW) + (size_t)layer * 3 * DM, modl, 0, 1, Abuf, (layer > 0 && rep_ == 0) ? (const float*)(big + 200 * MiB) : nullptr); } PHASE_END
        PHASE_BEGIN(2) if (COMP(2)) { EpiSwiglu E{(bf16_t*)big}; run_gemm(lds, Abuf, (const bf16_t*)(dout + W_F1GU), 2 * FF, DM, E); } PHASE_END
        PHASE_BEGIN(3) if (COMP(3)) { EpiResid E{HX, modl, 2, rep_ + 1 < NREP(3) ? 0.f : 0.5f, (float*)(big + 200 * MiB)}; run_gemm(lds, (const bf16_t*)big, (const bf16_t*)(dout + W_F1D), DM, FF, E, true, false); } PHASE_END
        PHASE_BEGIN(1) if (COMP(1)) norm_phase(HX, karg_ptr(K_NORMW) + (size_t)layer * 3 * DM + DM, modl, 3, 4, Abuf, rep_ == 0 ? (const float*)(big + 200 * MiB) : nullptr); PHASE_END
        if (layer == 0) {
            PHASE_BEGIN(4) if (COMP(4)) { EpiGqaIn E{(bf16_t*)big, (bf16_t*)(big + U72), (bf16_t*)(big + U72 + 18 * MiB), (const float*)(ws + WS_ROPEH)}; run_gemm(lds, Abuf, (const bf16_t*)(dout + W_MIN), 1536, DM, E); } PHASE_END
            PHASE_BEGIN(5) if (COMP(5)) attn_phase<0>(big, Abuf, karg_ptr(K_GQASINK), nullptr, lds, true); PHASE_END
        } else if (layer == 1) {
            PHASE_BEGIN(6) if (COMP(6)) { EpiDiffIn E{(bf16_t*)big, (bf16_t*)(big + U72), (bf16_t*)(big + 2 * U72), (const float*)(ws + WS_ROPEH)}; run_gemm(lds, Abuf, (const bf16_t*)(dout + W_MIN), 3072, DM, E); } PHASE_END
            PHASE_BEGIN(7) if (COMP(7)) attn_phase<1>(big, Abuf, karg_ptr(K_DIFFSUB), (const float*)(ws + WS_LAM), lds, true); PHASE_END
        } else if (layer == 2) {
            PHASE_BEGIN(9) if (COMP(9)) { EpiHgrnIn E{(bf16_t*)big, (unsigned short*)(big + U72), (unsigned short*)(big + 2 * U72), (bf16_t*)(big + 3 * U72), (bf16_t*)(big + 4 * U72), (const float*)(ws + WS_LB)};
                          run_gemm(lds, Abuf, (const bf16_t*)(dout + W_MIN), 5120, DM, E); } PHASE_END
            PHASE_BEGIN(10) if (COMP(10)) hgrn_scan(big, (bf16_t*)(ws + WS_END), Abuf, lds); PHASE_END
            PHASE_BEGIN(11) if (COMP(11)) hgrn_combine((const bf16_t*)(ws + WS_END), Abuf, (const bf16_t*)(big + 4 * U72), karg_ptr(K_HGRNNORM), Abuf); PHASE_END
        } else {
            PHASE_BEGIN(12) if (COMP(12)) { EpiF32 E{(float*)big, 768}; run_gemm(lds, Abuf, (const bf16_t*)(dout + W_MIN), 768, DM, E); } PHASE_END
            PHASE_BEGIN(13) if (COMP(13)) mla_rows((const float*)big, karg_ptr(K_MLAQN), karg_ptr(K_MLAKVN), (const float*)(ws + WS_ROPEM), (bf16_t*)(big + 108 * MiB), (bf16_t*)(big + 126 * MiB), (bf16_t*)(big + 2 * U72 + 108 * MiB)); PHASE_END
            PHASE_BEGIN(14) if (COMP(14)) { EpiMlaUq E1{(bf16_t*)(big + 2 * U72), (const float*)(ws + WS_ROPEM)}; run_gemm(lds, (const bf16_t*)(big + 108 * MiB), (const bf16_t*)(dout + W_UQ), 1536, 256, E1);
                          EpiMlaUkv E2{(bf16_t*)(big + 2 * U72 + 108 * MiB), (bf16_t*)big}; run_gemm(lds, (const bf16_t*)(big + 126 * MiB), (const bf16_t*)(dout + W_UKV), 2048, 256, E2); } PHASE_END
            PHASE_BEGIN(15) if (COMP(15)) attn_phase<3>(big, Abuf, karg_ptr(K_GQASINK), nullptr, lds, false); PHASE_END
        }
        PHASE_BEGIN(3) if (COMP(3)) { EpiResid E{HX, modl, 5, rep_ + 1 < NREP(3) ? 0.f : 1.0f, (float*)(big + 200 * MiB)}; run_gemm(lds, Abuf, (const bf16_t*)(dout + W_MOUT), DM, DM, E, true, layer == 3); } PHASE_END
        PHASE_BEGIN(1) if (COMP(1)) norm_phase(HX, karg_ptr(K_NORMW) + (size_t)layer * 3 * DM + 2 * DM, modl, 6, 7, Abuf, (layer < 3 && rep_ == 0) ? (const float*)(big + 200 * MiB) : nullptr, layer == 3); PHASE_END
        PHASE_BEGIN(2) if (COMP(2)) { EpiSwiglu E{(bf16_t*)big}; run_gemm(lds, Abuf, (const bf16_t*)(dout + W_F2GU), 2 * FF, DM, E, false, layer == 3); } PHASE_END
        PHASE_BEGIN(3) if (COMP(3)) { EpiResid E{HX, modl, 8, rep_ + 1 < NREP(3) ? 0.f : 0.5f, (float*)(big + 200 * MiB)}; run_gemm(lds, (const bf16_t*)big, (const bf16_t*)(dout + W_F2D), DM, FF, E, true, layer == 3); } PHASE_END
    }
    layer = 0;
    if (NREP(17) > 1) { for (int i = 0; i < 20; ++i) GRID_SYNC(); }
    PHASE_BEGIN(16) if (COMP(16)) final_phase(HX, karg_ptr(K_FNORMW), (float*)dout); PHASE_END
#undef PHASE_BEGIN
#undef PHASE_END
}

#ifndef MK_MULTI
#define MK_MULTI 0
#endif
constexpr int N_PHASES = 1 + (10 + 10 + 11 + 12) + 1;

extern "C" void kernel_launch(void* const* d_in, const int* in_sizes, int n_in, void* d_out, int out_size, void* d_ws, size_t ws_size, hipStream_t stream) {
    static int grid = 0;
    if (grid == 0) {
        if (n_in != 28 || ws_size < WS_END + U72 || out_size != NB * SQ * DM) { fprintf(stderr, "kernel_launch: unexpected sizes n_in %d out %d ws %zu\n", n_in, out_size, ws_size); grid = -1; return; }
        int dev = 0, cus = 0, per_cu = 0;
        hipGetDevice(&dev); hipDeviceGetAttribute(&cus, hipDeviceAttributeMultiprocessorCount, dev);
        if (hipFuncSetAttribute((const void*)fwd_megakernel, hipFuncAttributeMaxDynamicSharedMemorySize, LDS_BYTES) != hipSuccess) { fprintf(stderr, "kernel_launch: hipFuncSetAttribute failed\n"); grid = -1; return; }
        if (hipOccupancyMaxActiveBlocksPerMultiprocessor(&per_cu, (const void*)fwd_megakernel, NTHR, LDS_BYTES) != hipSuccess || per_cu < 1) { fprintf(stderr, "kernel_launch: occupancy query says %d\n", per_cu); per_cu = 1; }
        (void)hipGetLastError();
        grid = cus * (per_cu > 1 ? 1 : per_cu);
        if (grid != GRID) { fprintf(stderr, "kernel_launch: this kernel is built for a %d-workgroup cooperative grid (one per CU), device offers %d\n", GRID, grid); grid = -1; return; }
    }
    if (grid < 0) return;
    if (hipMemsetAsync((char*)d_ws + WS_BAR, 0, XCD_BAR_WORDS * 4, stream) != hipSuccess) { fprintf(stderr, "kernel_launch: memset failed\n"); return; }
    Params p{};
    const float** pp = (const float**)&p;
    for (int i = 0; i < 28; ++i) pp[i] = (const float*)d_in[i];
    p.out = (float*)d_out; p.ws = (unsigned char*)d_ws;
#if MK_MULTI
    for (int ph = 0; ph < N_PHASES; ++ph) { p.ph_lo = ph; p.ph_hi = ph + 1; hipLaunchKernelGGL(fwd_megakernel, dim3(grid), dim3(NTHR), LDS_BYTES, stream, p); }
#else
    p.ph_lo = 0; p.ph_hi = N_PHASES;
    void* args[] = {&p};
    hipError_t e = hipLaunchCooperativeKernel((const void*)fwd_megakernel, dim3(grid), dim3(NTHR), args, LDS_BYTES, stream);
    if (e != hipSuccess) fprintf(stderr, "cooperative launch failed: %s (grid %d)\n", hipGetErrorString(e), grid);
#endif
}
```

```cpp
#include <hip/hip_runtime.h>
#include <hip/hip_cooperative_groups.h>
#include <cstdio>
#include <cstdint>
namespace cg = cooperative_groups;
namespace pg8 {
#define PG8_LAS __attribute__((address_space(3)))
typedef unsigned short bf16_t;
typedef short bf16x8 __attribute__((ext_vector_type(8)));
typedef float f32x4 __attribute__((ext_vector_type(4)));
typedef unsigned u32x4 __attribute__((ext_vector_type(4)));
constexpr int BM = 256, BK = 64, HALF = 128, HTB = HALF * BK * 2  , STAGE_BYTES = 8 * HTB, NXCD = 8, WGM = 8;

__host__ __device__ __forceinline__ int lds_byte(int r, int c) { const int st = (r >> 4) * 2 + (c >> 5), rr = r & 15, cc = c & 31, ob = rr * 64 + cc * 2; return st * 1024 + (ob ^ (((ob >> 9) & 1) << 5)); }
__host__ __device__ __forceinline__ void stage_rc(int b, int& R, int& C) { const int st = b / 1024, sb = b % 1024, swz = sb ^ (((sb >> 9) & 1) << 5); R = (st >> 1) * 16 + swz / 64; C = (st & 1) * 32 + (swz % 64) / 2; }
__host__ __device__ __forceinline__ int perm32(int rho) { const int n = rho >> 4, i = rho & 15; return 8 * (i >> 2) + 4 * n + (i & 3); }

struct Unit { int pm, pn, k0, nk, part; };
struct Gemm { const bf16_t* A; const bf16_t* Bt; int M, N, K; };

struct StaticOrder {
    int nN, nwg, G, c, nt, nfull, S, nMf; bool lat;
    __host__ __device__ void init(int M, int N, int G_, int c_, int nt_, bool split, bool lat_) {
        const int nM = M / BM; nN = N / BM; nwg = nM * nN; G = G_; c = c_; nt = nt_; lat = lat_; nfull = nwg; S = 1;
        if (split) { const int rem = nwg % G; if (rem > 0 && rem * 2 <= G && ((nwg - rem) % nN) == 0) { S = G / rem; if (S > 4) S = 4; if (S > nt / 2) S = nt / 2; nfull = nwg - rem; } }
        nMf = nfull / nN;
    }
    __host__ __device__ bool next(int i, Unit& u) const {
        const long L = (long)i * G + c;
        int pm, pn, k0 = 0, nk = nt, part = -1; bool ok = true;
        if (L < nfull) {
            int wgid = (int)L;
            { const int q = nfull / NXCD, r = nfull % NXCD, xcd = wgid % NXCD, off = wgid / NXCD; wgid = (xcd < r ? xcd * (q + 1) : r * (q + 1) + (xcd - r) * q) + off; }
            const int nig = WGM * nN, gid = wgid / nig, fm = gid * WGM, gsz = (nMf - fm) < WGM ? (nMf - fm) : WGM;
            pm = fm + ((wgid % nig) % gsz); pn = (wgid % nig) / gsz;
        } else {
            const long q = L - nfull; const int t = (int)(q / S); part = (int)(q % S); ok = (nfull + t < nwg);
            pm = nMf + t / nN; pn = t % nN;
            const int pairs = nt / 2, base = pairs / S, extra = pairs % S; const int p0 = part * base + (part < extra ? part : extra), np = base + (part < extra ? 1 : 0); k0 = 2 * p0; nk = 2 * np;
        }
        if (lat) pm = (pm >> 3) * 9 + 1 + (pm & 7);
        u.pm = pm; u.pn = pn; u.k0 = k0; u.nk = nk; u.part = part;
        return ok;
    }
    __device__ __forceinline__ void a_ready(const Unit&) const {}
    __device__ __forceinline__ void done(const Unit&) const {}
};
template <class Epi, class Sched, bool ALIGN_EPI = false, bool SP2 = false>
__device__ __forceinline__ void gemm_phase(PG8_LAS unsigned char* lds, const Gemm g, const Sched& S, const Epi& E) {
    int tid_ = threadIdx.x; asm volatile("" : "+v"(tid_));
    const int tid = tid_, wid = __builtin_amdgcn_readfirstlane(tid >> 6), lane = tid & 63, wr = wid >> 2, wc = wid & 3, fr = lane & 15, fq = lane >> 4;
    const int K = g.K;
    unsigned voffA[2], voffB[2];
#pragma unroll
    for (int i = 0; i < 2; ++i) { int R, C; stage_rc(tid * 16 + i * 8192, R, C); const int Rb = Epi::PERM ? ((R & ~31) + perm32(R & 31)) : R;
        voffA[i] = (unsigned)(R * K + C) * 2u; voffB[i] = (unsigned)(Rb * K + C) * 2u; }
    const size_t kstep = (size_t)(BK * 2);
    const size_t hstep = (size_t)HALF * K * 2;
    const size_t tstep = 2 * hstep;
    const unsigned ldsw = (unsigned)wid * 1024u;
    const int aoff = lds_byte(wr * 64 + fr, fq * 8), boff = lds_byte(wc * 32 + fr, fq * 8);
#define PG8_SA(b, h) (((b) * 2 + (h)) * HTB)
#define PG8_SB(b, h) ((4 + (b) * 2 + (h)) * HTB)
#define PG8_STAGE(bufoff, gbase, voff) do { _Pragma("unroll") for (int _i = 0; _i < 2; ++_i) \
        __builtin_amdgcn_global_load_lds((const unsigned*)((const char*)(gbase) + (voff)[_i]), (PG8_LAS unsigned*)(lds + (bufoff) + ldsw + _i * 8192), 16, 0, 0); } while (0)
#define PG8_LDA(dst, b, h) do { _Pragma("unroll") for (int m = 0; m < 4; ++m) _Pragma("unroll") for (int k = 0; k < 2; ++k) dst[m][k] = *(const PG8_LAS bf16x8*)(lds + PG8_SA(b, h) + aoff + m * 2048 + k * 1024); } while (0)
#define PG8_LDB(dst, b, h) do { _Pragma("unroll") for (int n = 0; n < 2; ++n) _Pragma("unroll") for (int k = 0; k < 2; ++k) dst[n][k] = *(const PG8_LAS bf16x8*)(lds + PG8_SB(b, h) + boff + n * 2048 + k * 1024); } while (0)
#define PG8_MMA(ai, bj, At, Bt) do { __builtin_amdgcn_s_setprio(1); _Pragma("unroll") for (int m = 0; m < 4; ++m) _Pragma("unroll") for (int n = 0; n < 2; ++n) _Pragma("unroll") for (int k = 0; k < 2; ++k) \
        acc[ai][bj][m][n] = __builtin_amdgcn_mfma_f32_16x16x32_bf16(Bt[n][k], At[m][k], acc[ai][bj][m][n], 0, 0, 0); __builtin_amdgcn_s_setprio(0); } while (0)
#define PG8_WAIT_V(n) asm volatile("s_waitcnt vmcnt(" #n ")" ::: "memory")
#define PG8_WAIT_L(n) asm volatile("s_waitcnt lgkmcnt(" #n ")" ::: "memory")
#define PG8_BAR __builtin_amdgcn_s_barrier()
#define PG8_SCHED __builtin_amdgcn_sched_barrier(0)
    Unit cur, nxt; int ui = 0;
    if (!S.next(0, cur)) return;
    f32x4 acc[2][2][4][2];
#pragma unroll
    for (int a = 0; a < 2; ++a)
#pragma unroll
        for (int b = 0; b < 2; ++b)
#pragma unroll
            for (int m = 0; m < 4; ++m)
#pragma unroll
                for (int n = 0; n < 2; ++n) acc[a][b][m][n] = (f32x4){0.f, 0.f, 0.f, 0.f};
    bf16x8 At[4][2], B0[2][2], B1[2][2];
    const char* cA = (const char*)g.A + (size_t)cur.pm * tstep + (size_t)cur.k0 * kstep; const char* cB = (const char*)g.Bt + (size_t)cur.pn * tstep + (size_t)cur.k0 * kstep;
    S.a_ready(cur);
    if constexpr (SP2) {
        PG8_STAGE(PG8_SB(0, 0), cB, voffB); PG8_STAGE(PG8_SB(0, 1), cB + hstep, voffB); PG8_STAGE(PG8_SA(0, 0), cA, voffA); PG8_STAGE(PG8_SA(0, 1), cA + hstep, voffA);
        if (wr == 1) PG8_BAR;
        PG8_WAIT_V(2); PG8_BAR;
        PG8_STAGE(PG8_SB(1, 0), cB + kstep, voffB); PG8_STAGE(PG8_SA(1, 0), cA + kstep, voffA); PG8_STAGE(PG8_SB(1, 1), cB + hstep + kstep, voffB);
        PG8_WAIT_V(6); PG8_BAR;
    } else {
        PG8_STAGE(PG8_SB(0, 0), cB, voffB); PG8_STAGE(PG8_SA(0, 0), cA, voffA); PG8_STAGE(PG8_SB(0, 1), cB + hstep, voffB); PG8_STAGE(PG8_SA(0, 1), cA + hstep, voffA);
        if (wr == 1) PG8_BAR;
        PG8_WAIT_V(4); PG8_BAR;
        PG8_STAGE(PG8_SB(1, 0), cB + kstep, voffB); PG8_STAGE(PG8_SA(1, 0), cA + kstep, voffA); PG8_STAGE(PG8_SB(1, 1), cB + hstep + kstep, voffB);
        PG8_WAIT_V(6); PG8_BAR;
    }
    for (;;) {
        const bool has_next = S.next(ui + 1, nxt);
        const char* nA = has_next ? (const char*)g.A + (size_t)nxt.pm * tstep + (size_t)nxt.k0 * kstep : cA; const char* nB = has_next ? (const char*)g.Bt + (size_t)nxt.pn * tstep + (size_t)nxt.k0 * kstep : cB;
        const int nt = cur.nk;
#pragma unroll 1
        for (int t = 0; t < nt; t += 2) {
            const bool last = (t == nt - 2);
            const char* a1 = cA + (size_t)(t + 1) * kstep;
            const char* a2 = last ? nA : cA + (size_t)(t + 2) * kstep; const char* b2 = last ? nB : cB + (size_t)(t + 2) * kstep;
            const char* a3 = a2 + kstep; const char* b3 = b2 + kstep;
            if (last && has_next) S.a_ready(nxt);
            if constexpr (SP2) {
            PG8_LDB(B0, 0, 0); PG8_LDB(B1, 0, 1); PG8_SCHED; PG8_LDA(At, 0, 0); PG8_STAGE(PG8_SA(1, 1), a1 + hstep, voffA);
            PG8_WAIT_V(8); PG8_WAIT_L(0); PG8_BAR; PG8_MMA(0, 0, At, B0); PG8_MMA(0, 1, At, B1); PG8_BAR; PG8_SCHED;
            PG8_LDA(At, 0, 1); PG8_STAGE(PG8_SB(0, 0), b2, voffB); PG8_STAGE(PG8_SB(0, 1), b2 + hstep, voffB); PG8_STAGE(PG8_SA(0, 0), a2, voffA);
            PG8_WAIT_V(8); PG8_WAIT_L(0); PG8_BAR; PG8_MMA(1, 0, At, B0); PG8_MMA(1, 1, At, B1); PG8_BAR; PG8_SCHED;
            PG8_LDB(B0, 1, 0); PG8_LDB(B1, 1, 1); PG8_SCHED; PG8_LDA(At, 1, 0); PG8_STAGE(PG8_SA(0, 1), a2 + hstep, voffA);
            PG8_WAIT_V(8); PG8_WAIT_L(0); PG8_BAR; PG8_MMA(0, 0, At, B0); PG8_MMA(0, 1, At, B1); PG8_BAR; PG8_SCHED;
            PG8_LDA(At, 1, 1); PG8_STAGE(PG8_SB(1, 0), b3, voffB); PG8_STAGE(PG8_SB(1, 1), b3 + hstep, voffB); PG8_STAGE(PG8_SA(1, 0), a3, voffA);
            PG8_WAIT_V(8); PG8_WAIT_L(0); PG8_BAR; PG8_MMA(1, 0, At, B0); PG8_MMA(1, 1, At, B1); PG8_BAR; PG8_SCHED;
            } else {
            PG8_LDB(B0, 0, 0); PG8_SCHED; PG8_LDA(At, 0, 0); PG8_STAGE(PG8_SA(1, 1), a1 + hstep, voffA);
            PG8_WAIT_L(8); PG8_BAR; PG8_WAIT_L(0); PG8_MMA(0, 0, At, B0); PG8_BAR; PG8_SCHED;
            PG8_LDB(B1, 0, 1); PG8_STAGE(PG8_SB(0, 0), b2, voffB);
            PG8_BAR; PG8_WAIT_L(0); PG8_MMA(0, 1, At, B1); PG8_BAR;
            PG8_LDA(At, 0, 1); PG8_STAGE(PG8_SA(0, 0), a2, voffA);
            PG8_BAR; PG8_WAIT_L(0); PG8_MMA(1, 0, At, B0); PG8_BAR; PG8_SCHED;
            PG8_STAGE(PG8_SB(0, 1), b2 + hstep, voffB);
            PG8_WAIT_V(6); PG8_BAR; PG8_MMA(1, 1, At, B1); PG8_BAR;
            PG8_LDB(B0, 1, 0); PG8_SCHED; PG8_LDA(At, 1, 0); PG8_STAGE(PG8_SA(0, 1), a2 + hstep, voffA);
            PG8_WAIT_L(8); PG8_BAR; PG8_WAIT_L(0); PG8_MMA(0, 0, At, B0); PG8_BAR; PG8_SCHED;
            PG8_LDB(B1, 1, 1); PG8_STAGE(PG8_SB(1, 0), b3, voffB);
            PG8_BAR; PG8_WAIT_L(0); PG8_MMA(0, 1, At, B1); PG8_BAR;
            PG8_LDA(At, 1, 1); PG8_STAGE(PG8_SA(1, 0), a3, voffA);
            PG8_BAR; PG8_WAIT_L(0); PG8_MMA(1, 0, At, B0); PG8_BAR; PG8_SCHED;
            PG8_STAGE(PG8_SB(1, 1), b3 + hstep, voffB);
            PG8_WAIT_V(6); PG8_BAR; PG8_MMA(1, 1, At, B1); PG8_BAR;
            }
        }
        if constexpr (ALIGN_EPI) { if (wr == 0) PG8_BAR; }
        if constexpr (!Epi::AFTER_DRAIN) { E(acc, cur, wr, wc, fr, fq); S.done(cur); }
        if (!has_next) break;
#pragma unroll
        for (int a = 0; a < 2; ++a)
#pragma unroll
            for (int b = 0; b < 2; ++b)
#pragma unroll
                for (int m = 0; m < 4; ++m)
#pragma unroll
                    for (int n = 0; n < 2; ++n) acc[a][b][m][n] = (f32x4){0.f, 0.f, 0.f, 0.f};
        cur = nxt; cA = nA; cB = nB; ++ui;
        if constexpr (ALIGN_EPI) { if (wr == 1) PG8_BAR; }
    }
    PG8_WAIT_V(0);
    if constexpr (!ALIGN_EPI) { if (wr == 0) PG8_BAR; }
    PG8_BAR;
    if constexpr (Epi::AFTER_DRAIN) { E.fused(acc, cur, wr, wc, fr, fq, lds, wid, lane); S.done(cur); }
#undef PG8_SA
#undef PG8_SB
#undef PG8_STAGE
#undef PG8_LDA
#undef PG8_LDB
#undef PG8_MMA
#undef PG8_WAIT_V
#undef PG8_WAIT_L
#undef PG8_BAR
#undef PG8_SCHED
}
}

#define LAS __attribute__((address_space(3)))
#define GAS __attribute__((address_space(1)))
using pg8::bf16_t; using pg8::bf16x8; using pg8::f32x4; using pg8::u32x4;
typedef float f32x16 __attribute__((ext_vector_type(16)));
typedef unsigned u32x2 __attribute__((ext_vector_type(2)));
typedef float f32x2v __attribute__((ext_vector_type(2)));
typedef __bf16 bf16x2v __attribute__((ext_vector_type(2)));

constexpr int NB = 16, SQ = 2048, CL = 256, TB = SQ + CL, TT = NB * TB, DM = 1024, FF = 2816, NMODV = 9216;
constexpr int NTHR = 512, GRID = 256;
constexpr size_t MiB = (size_t)1 << 20;
constexpr size_t U72 = 72 * MiB;
constexpr size_t WS_MOD = 0;
constexpr size_t WS_ROPEH = 3 * MiB;
constexpr size_t WS_ROPEM = 3 * MiB + 512 * 1024;
constexpr size_t WS_LB = 3 * MiB + 768 * 1024;
constexpr size_t WS_LAM = WS_LB + 4096;
constexpr size_t WS_BAR = 4 * MiB - 64 * 1024;
constexpr size_t WS_HX = 4 * MiB;
constexpr size_t WS_BIG = 148 * MiB;
constexpr size_t WS_END = 508 * MiB;
constexpr size_t DO_A = 0;
constexpr size_t DO_W = 72 * MiB;
constexpr size_t W_F1GU = DO_W, W_F1D = DO_W + 11 * MiB, W_F2GU = DO_W + 33 * MiB / 2, W_F2D = DO_W + 55 * MiB / 2;
constexpr size_t W_MIN = DO_W + 33 * MiB, W_MOUT = DO_W + 43 * MiB, W_UQ = DO_W + 45 * MiB, W_UKV = DO_W + 46 * MiB;
constexpr int LDS_BYTES = 147456;
constexpr float LOG2E = 1.4426950408889634f;

struct Params {
    const float *x, *c, *ctx, *c_ctx, *ada_w, *ada_b, *norm_w, *final_norm_w, *ffn_g, *ffn_u, *ffn_d,
        *gqa_in, *gqa_out, *gqa_sinks, *diff_in, *diff_out, *diff_lambda, *diff_subln,
        *hgrn_in, *hgrn_out, *hgrn_norm, *hgrn_lb, *mla_down, *mla_qn, *mla_kvn, *mla_uq, *mla_ukv, *mla_out;
    float* out; unsigned char* ws; int ph_lo, ph_hi;
};

__device__ __forceinline__ int fresh_bid() { int t = blockIdx.x; asm volatile("" : "+s"(t)); return t; }
__device__ __forceinline__ int fresh_gdim() { int t = gridDim.x; asm volatile("" : "+s"(t)); return t; }
__device__ __forceinline__ int fresh_tid() { int t = threadIdx.x; asm volatile("" : "+v"(t)); return t; }
__device__ __forceinline__ unsigned pk2(float lo, float hi) { f32x2v v = {lo, hi}; bf16x2v b = __builtin_convertvector(v, bf16x2v); return __builtin_bit_cast(unsigned, b); }
__device__ __forceinline__ unsigned short f2bf(float f) { return (unsigned short)(pk2(f, 0.f) & 0xffffu); }
__device__ __forceinline__ float bf2f(unsigned short u) { return __uint_as_float((unsigned)u << 16); }
__device__ __forceinline__ float bflo(unsigned w) { return __uint_as_float(w << 16); }
__device__ __forceinline__ float bfhi(unsigned w) { return __uint_as_float(w & 0xffff0000u); }
__device__ __forceinline__ unsigned short f2h(float f) { _Float16 h = (_Float16)f; return __builtin_bit_cast(unsigned short, h); }
__device__ __forceinline__ float h2f(unsigned short u) { return (float)__builtin_bit_cast(_Float16, u); }
__device__ __forceinline__ float silu_f(float v) { return v * __builtin_amdgcn_rcpf(1.f + __expf(-v)); }
__device__ __forceinline__ float wave_sum(float v) {
#pragma unroll
    for (int o = 1; o < 64; o <<= 1) v += __shfl_xor(v, o);
    return v;
}
__device__ __forceinline__ int crow(int r, int hi) { return (r & 3) + 8 * (r >> 2) + 4 * hi; }
__device__ __forceinline__ void store4bf(bf16_t* p, f32x4 v) { u32x2 w; w.x = pk2(v[0], v[1]); w.y = pk2(v[2], v[3]); *(GAS u32x2*)p = w; }
__device__ __forceinline__ f32x4 ldg4(const float* p) { return *(const GAS f32x4*)p; }
__device__ __forceinline__ void stg4(float* p, f32x4 v) { *(GAS f32x4*)p = v; }

template <class F> __device__ __forceinline__ void epi_loop(const f32x4 (&acc)[2][2][4][2], const pg8::Unit& u, int wr, int wc, int fr, int fq, const F& f) {
#pragma unroll
    for (int ai = 0; ai < 2; ++ai)
#pragma unroll
        for (int m = 0; m < 4; ++m) {
            const int row = u.pm * 256 + ai * 128 + wr * 64 + m * 16 + fr;
#pragma unroll
            for (int bj = 0; bj < 2; ++bj) f.item(row, u.pn * 256 + bj * 128 + wc * 32 + 4 * fq, acc[ai][bj][m][0], acc[ai][bj][m][1]);
        }
}
struct EpiSwiglu {
    static constexpr bool PERM = true, AFTER_DRAIN = false;
    bf16_t* H;
    __device__ __forceinline__ void operator()(const f32x4 (&acc)[2][2][4][2], const pg8::Unit& u, int wr, int wc, int fr, int fq) const {
        const int row0 = u.pm * 256 + wr * 64 + fr, col0 = u.pn * 128 + wc * 32 + 8 * fq;
#pragma unroll
        for (int ai = 0; ai < 2; ++ai)
#pragma unroll
            for (int m = 0; m < 4; ++m) {
                bf16_t* rp = H + (size_t)(row0 + ai * 128 + m * 16) * FF + col0;
                const f32x4 g0 = acc[ai][0][m][0], g1 = acc[ai][0][m][1], u0 = acc[ai][1][m][0], u1 = acc[ai][1][m][1];
                u32x4 w;
                w.x = pk2(silu_f(g0[0]) * u0[0], silu_f(g0[1]) * u0[1]); w.y = pk2(silu_f(g0[2]) * u0[2], silu_f(g0[3]) * u0[3]);
                w.z = pk2(silu_f(g1[0]) * u1[0], silu_f(g1[1]) * u1[1]); w.w = pk2(silu_f(g1[2]) * u1[2], silu_f(g1[3]) * u1[3]);
                *(GAS u32x4*)rp = w;
                asm volatile("" ::: "memory");
            }
    }
};
constexpr int SPLIT_PM0 = 128, SPLIT_ROWS = 4096;
struct EpiResid {
    static constexpr bool PERM = false, AFTER_DRAIN = false;
    float* HX; const float* modl; int midx; float coef; float* P;
    __device__ __forceinline__ void operator()(const f32x4 (&acc)[2][2][4][2], const pg8::Unit& u, int wr, int wc, int fr, int fq) const {
        const int bi = u.pm / 9, mr = (u.pm - bi * 9) == 0 ? 16 : bi;
        const int col0 = u.pn * 256 + wc * 32 + 4 * fq;
        const float* g = modl + (size_t)mr * NMODV + midx * 1024 + col0;
        f32x4 gv[2][2];
#pragma unroll
        for (int bj = 0; bj < 2; ++bj)
#pragma unroll
            for (int n = 0; n < 2; ++n) gv[bj][n] = coef * ldg4(g + bj * 128 + n * 16);
        if (u.part < 0) {
#pragma unroll
            for (int ai = 0; ai < 2; ++ai)
#pragma unroll
                for (int m = 0; m < 4; ++m) {
                    float* hp = HX + (size_t)(u.pm * 256 + ai * 128 + wr * 64 + m * 16 + fr) * DM + col0;
#pragma unroll
                    for (int bj = 0; bj < 2; ++bj)
#pragma unroll
                        for (int n = 0; n < 2; ++n) { float* h = hp + bj * 128 + n * 16; stg4(h, ldg4(h) + gv[bj][n] * acc[ai][bj][m][n]); }
                }
        } else {
#pragma unroll
            for (int ai = 0; ai < 2; ++ai)
#pragma unroll
                for (int m = 0; m < 4; ++m) {
                    bf16_t* hp = (bf16_t*)P + ((size_t)u.part * SPLIT_ROWS + (size_t)((u.pm - SPLIT_PM0) * 256 + ai * 128 + wr * 64 + m * 16 + fr)) * DM + col0;
#pragma unroll
                    for (int bj = 0; bj < 2; ++bj)
#pragma unroll
                        for (int n = 0; n < 2; ++n) store4bf(hp + bj * 128 + n * 16, gv[bj][n] * acc[ai][bj][m][n]);
                    if (m & 1) asm volatile("" ::: "memory");
                }
        }
    }
};
__device__ __forceinline__ void rope64(f32x4& a, f32x4& b, const float* tab, int s, int col) {
    const int half = (col >> 5) & 1, i0 = col & 31;
    const GAS f32x4* tp = (const GAS f32x4*)(tab + ((size_t)s * 32 + half * 16 + i0) * 2);
    const f32x4 t0 = tp[0], t1 = tp[1];
    f32x4 na, nb;
    na[0] = a[0] * t0[0] - b[0] * t0[1]; nb[0] = b[0] * t0[0] + a[0] * t0[1];
    na[1] = a[1] * t0[2] - b[1] * t0[3]; nb[1] = b[1] * t0[2] + a[1] * t0[3];
    na[2] = a[2] * t1[0] - b[2] * t1[1]; nb[2] = b[2] * t1[0] + a[2] * t1[1];
    na[3] = a[3] * t1[2] - b[3] * t1[3]; nb[3] = b[3] * t1[2] + a[3] * t1[3];
    a = na; b = nb;
}
__device__ __forceinline__ void store_vt(bf16_t* vt, const f32x4& a, const f32x4& b) {
#pragma unroll
    for (int j = 0; j < 4; ++j) ((GAS bf16_t*)vt)[(size_t)j * TB] = f2bf(a[j]);
    asm volatile("" ::: "memory");
    GAS bf16_t* v2 = (GAS bf16_t*)vt + (size_t)16 * TB;
#pragma unroll
    for (int j = 0; j < 4; ++j) v2[(size_t)j * TB] = f2bf(b[j]);
    asm volatile("" ::: "memory");
}
struct EpiGqaIn {
    static constexpr bool PERM = false, AFTER_DRAIN = false;
    bf16_t *Q, *K, *Vt; const float* ropeH;
    __device__ __forceinline__ void item(int row, int col, const f32x4& a_, const f32x4& b_) const {
        f32x4 a = a_, b = b_; const int bi = row / TB, t = row - bi * TB;
        if (col < 1280) {
            if (t >= CL) rope64(a, b, ropeH, t - CL, col);
            if (col < 1024) { const float c2 = 0.125f * LOG2E; a = a * c2; b = b * c2; bf16_t* q = Q + (size_t)row * 1024 + col; store4bf(q, a); store4bf(q + 16, b); }
            else { bf16_t* k = K + (size_t)row * 256 + (col - 1024); store4bf(k, a); store4bf(k + 16, b); }
        } else { const int cv = col - 1280, head = cv >> 6, dv = cv & 63; store_vt(Vt + ((size_t)(bi * 4 + head) * 64 + dv) * TB + t, a, b); }
    }
    __device__ __forceinline__ void operator()(const f32x4 (&acc)[2][2][4][2], const pg8::Unit& u, int wr, int wc, int fr, int fq) const { epi_loop(acc, u, wr, wc, fr, fq, *this); }
};
struct EpiDiffIn {
    static constexpr bool PERM = false, AFTER_DRAIN = false;
    bf16_t *Q, *K, *Vt; const float* ropeH;
    __device__ __forceinline__ void item(int row, int col, const f32x4& a_, const f32x4& b_) const {
        f32x4 a = a_, b = b_; const int bi = row / TB, t = row - bi * TB;
        if (col < 2048) {
            if (t >= CL) rope64(a, b, ropeH, t - CL, col);
            if (col < 1024) { const float c2 = 0.125f * LOG2E; a = a * c2; b = b * c2; bf16_t* q = Q + (size_t)row * 1024 + col; store4bf(q, a); store4bf(q + 16, b); }
            else { bf16_t* k = K + (size_t)row * 1024 + (col - 1024); store4bf(k, a); store4bf(k + 16, b); }
        } else { const int cv = col - 2048, head = cv >> 7, dv = cv & 127; store_vt(Vt + ((size_t)(bi * 8 + head) * 128 + dv) * TB + t, a, b); }
    }
    __device__ __forceinline__ void operator()(const f32x4 (&acc)[2][2][4][2], const pg8::Unit& u, int wr, int wc, int fr, int fq) const { epi_loop(acc, u, wr, wc, fr, fq, *this); }
};
struct EpiHgrnIn {
    static constexpr bool PERM = false, AFTER_DRAIN = false;
    bf16_t* Qh; unsigned short *LF, *LB; bf16_t *V, *Gt; const float* lb;
    __device__ __forceinline__ void item(int row, int col, const f32x4& a, const f32x4& b) const {
        const int sec = col >> 10, cc = col & 1023; const size_t o = (size_t)row * 1024 + cc;
        if (sec == 0 || sec == 4) { f32x4 x, y;
#pragma unroll
            for (int j = 0; j < 4; ++j) { x[j] = silu_f(a[j]); y[j] = silu_f(b[j]); }
            bf16_t* d = (sec == 0 ? Qh : Gt) + o; store4bf(d, x); store4bf(d + 16, y);
        } else if (sec == 3) { store4bf(V + o, a); store4bf(V + o + 16, b); }
        else { unsigned short* d = (sec == 1 ? LF : LB) + o; const f32x4 la = ldg4(lb + cc), lbb = ldg4(lb + cc + 16);
            unsigned short ha[4], hb[4];
#pragma unroll
            for (int j = 0; j < 4; ++j) { const float fa = la[j] + (1.f - la[j]) * __builtin_amdgcn_rcpf(1.f + __expf(-a[j])), fb = lbb[j] + (1.f - lbb[j]) * __builtin_amdgcn_rcpf(1.f + __expf(-b[j]));
                ha[j] = f2h(__builtin_amdgcn_logf(fa) * 0.6931471805599453f); hb[j] = f2h(__builtin_amdgcn_logf(fb) * 0.6931471805599453f); }
            u32x2 w; w.x = ha[0] | ((unsigned)ha[1] << 16); w.y = ha[2] | ((unsigned)ha[3] << 16); *(GAS u32x2*)d = w;
            w.x = hb[0] | ((unsigned)hb[1] << 16); w.y = hb[2] | ((unsigned)hb[3] << 16); *(GAS u32x2*)(d + 16) = w; }
    }
    __device__ __forceinline__ void operator()(const f32x4 (&acc)[2][2][4][2], const pg8::Unit& u, int wr, int wc, int fr, int fq) const { epi_loop(acc, u, wr, wc, fr, fq, *this); }
};
struct EpiF32 {
    static constexpr bool PERM = false, AFTER_DRAIN = false;
    float* O; int ld;
    __device__ __forceinline__ void item(int row, int col, const f32x4& a, const f32x4& b) const { float* d = O + (size_t)row * ld + col; stg4(d, a); stg4(d + 16, b); }
    __device__ __forceinline__ void operator()(const f32x4 (&acc)[2][2][4][2], const pg8::Unit& u, int wr, int wc, int fr, int fq) const { epi_loop(acc, u, wr, wc, fr, fq, *this); }
};
struct EpiMlaUq {
    static constexpr bool PERM = false, AFTER_DRAIN = false;
    bf16_t* Q; const float* ropeM;
    __device__ __forceinline__ void half(f32x4& a, const float* tp, bool first) const {
        const f32x4 t0 = ldg4(tp), t1 = ldg4(tp + 4);
        f32x4 pa;
#pragma unroll
        for (int j = 0; j < 4; ++j) { pa[j] = __shfl_xor(a[j], 32); if (first) pa[j] = -pa[j]; }
        a[0] = a[0] * t0[0] + pa[0] * t0[1]; a[1] = a[1] * t0[2] + pa[1] * t0[3]; a[2] = a[2] * t1[0] + pa[2] * t1[1]; a[3] = a[3] * t1[2] + pa[3] * t1[3];
    }
    __device__ __forceinline__ void item(int row, int col, const f32x4& a_, const f32x4& b_) const {
        f32x4 a = a_, b = b_; const int bi = row / TB, t = row - bi * TB; const int g32 = col >> 5;
        const float c2 = 0.10206207261596577f * LOG2E;
        bf16_t* q = Q + (size_t)row * 1536 + col;
        const bool rot = (g32 % 3) == 2 && t >= CL;
        const int fq = (col & 15) >> 2; const bool first = fq < 2; const int i0 = 4 * (fq & 1);
        const float* tp = ropeM + ((size_t)(rot ? t - CL : 0) * 16 + i0) * 2;
        if (rot) half(a, tp, first);
        a = a * c2; store4bf(q, a);
        asm volatile("" ::: "memory");
        if (rot) half(b, tp + 16, first);
        b = b * c2; store4bf(q + 16, b);
        asm volatile("" ::: "memory");
    }
    __device__ __forceinline__ void operator()(const f32x4 (&acc)[2][2][4][2], const pg8::Unit& u, int wr, int wc, int fr, int fq) const { epi_loop(acc, u, wr, wc, fr, fq, *this); }
};
struct EpiMlaUkv {
    static constexpr bool PERM = false, AFTER_DRAIN = false;
    bf16_t *K, *Vt;
    __device__ __forceinline__ void item(int row, int col, const f32x4& a, const f32x4& b) const {
        const int bi = row / TB, t = row - bi * TB; const int head = col >> 7, x = col & 127;
        if (x < 64) { bf16_t* k = K + (size_t)row * 1536 + head * 96 + x; store4bf(k, a); store4bf(k + 16, b); }
        else store_vt(Vt + ((size_t)(bi * 16 + head) * 64 + (x - 64)) * TB + t, a, b);
    }
    __device__ __forceinline__ void operator()(const f32x4 (&acc)[2][2][4][2], const pg8::Unit& u, int wr, int wc, int fr, int fq) const { epi_loop(acc, u, wr, wc, fr, fq, *this); }
};

template <class Epi> __device__ __forceinline__ void run_gemm(LAS unsigned char* lds, const bf16_t* A, const bf16_t* Bt, int N, int K, const Epi& E, bool split = false, bool lat = false) {
    pg8::Gemm g{A, Bt, lat ? NB * SQ : TT, N, K}; pg8::StaticOrder S; S.init(lat ? NB * SQ : TT, N, GRID, fresh_bid(), K / 64, split, lat);
    pg8::gemm_phase<Epi, pg8::StaticOrder, true, true>(lds, g, S, E);
}

__device__ __forceinline__ void transpose_item(const float* W, int K, int N, bf16_t* WT, int mode, LAS float* scr, int item, int lane) {
    const int nblk = N / 32, kb = item / nblk, nb = item - kb * nblk, k0 = 64 * kb, n0 = 32 * nb;
    float wv[32];
#pragma unroll
    for (int i = 0; i < 32; ++i) { const int kk = 2 * i + (lane >> 5); wv[i] = *(const GAS float*)(W + (size_t)(k0 + kk) * N + n0 + (lane & 31)); }
#pragma unroll
    for (int i = 0; i < 32; ++i) { const int kk = 2 * i + (lane >> 5); scr[kk * 33 + (lane & 31)] = wv[i]; }
    asm volatile("s_waitcnt lgkmcnt(0)" ::: "memory");
    const int drow0 = mode == 0 ? n0 : (n0 >> 7) * 256 + (n0 & 127) + (mode == 2 ? 128 : 0);
    const int c = lane & 7;
#pragma unroll
    for (int j = 0; j < 4; ++j) { const int n = (lane >> 3) + 8 * j; const LAS float* s = scr + (8 * c) * 33 + n;
        u32x4 o; o.x = pk2(s[0 * 33], s[1 * 33]); o.y = pk2(s[2 * 33], s[3 * 33]); o.z = pk2(s[4 * 33], s[5 * 33]); o.w = pk2(s[6 * 33], s[7 * 33]);
        *(u32x4*)(WT + (size_t)(drow0 + n) * K + k0 + 8 * c) = o; }
    asm volatile("s_waitcnt lgkmcnt(0)" ::: "memory");
}
__device__ __forceinline__ void conv_job(const float* W, int K, int N, bf16_t* WT, int mode, LAS float* scr, int gw, int NGW, int lane, int& base) {
    const int n = (K / 64) * (N / 32);
    int it = gw - (base % NGW); if (it < 0) it += NGW;
    for (; it < n; it += NGW) transpose_item(W, K, N, WT, mode, scr, it, lane);
    base += n;
}
__device__ __forceinline__ void convert_weights(const Params& p, int layer, LAS unsigned char* lds, unsigned char* dout) {
    const int tid = fresh_tid(), lane = tid & 63, wave = tid >> 6;
    const int gw = fresh_bid() * 8 + wave, NGW = fresh_gdim() * 8;
    LAS float* scr = (LAS float*)(lds + wave * 16384);
    int base = 0;
    const size_t fgu = (size_t)DM * FF;
    for (int f = 0; f < 2; ++f) {
        const size_t off = ((size_t)layer * 2 + f) * fgu;
        bf16_t* gu = (bf16_t*)(dout + (f == 0 ? W_F1GU : W_F2GU)); bf16_t* dn = (bf16_t*)(dout + (f == 0 ? W_F1D : W_F2D));
        conv_job(p.ffn_g + off, DM, FF, gu, 1, scr, gw, NGW, lane, base);
        conv_job(p.ffn_u + off, DM, FF, gu, 2, scr, gw, NGW, lane, base);
        conv_job(p.ffn_d + off, FF, DM, dn, 0, scr, gw, NGW, lane, base);
    }
    bf16_t* win = (bf16_t*)(dout + W_MIN); bf16_t* wout = (bf16_t*)(dout + W_MOUT);
    if (layer == 0) { conv_job(p.gqa_in, DM, 1536, win, 0, scr, gw, NGW, lane, base); conv_job(p.gqa_out, DM, DM, wout, 0, scr, gw, NGW, lane, base); }
    else if (layer == 1) { conv_job(p.diff_in, DM, 3072, win, 0, scr, gw, NGW, lane, base); conv_job(p.diff_out, DM, DM, wout, 0, scr, gw, NGW, lane, base); }
    else if (layer == 2) { conv_job(p.hgrn_in, DM, 5120, win, 0, scr, gw, NGW, lane, base); conv_job(p.hgrn_out, DM, DM, wout, 0, scr, gw, NGW, lane, base); }
    else {
        conv_job(p.mla_down, DM, 544, win, 0, scr, gw, NGW, lane, base);
        conv_job(p.mla_uq, 256, 1536, (bf16_t*)(dout + W_UQ), 0, scr, gw, NGW, lane, base);
        conv_job(p.mla_ukv, 256, 2048, (bf16_t*)(dout + W_UKV), 0, scr, gw, NGW, lane, base);
        conv_job(p.mla_out, DM, DM, wout, 0, scr, gw, NGW, lane, base);
    }
}

__device__ __forceinline__ void prologue(const Params& p, LAS unsigned char* lds) {
    const int tid = fresh_tid(), G = fresh_gdim(), bid = fresh_bid();
    float* ropeH = (float*)(p.ws + WS_ROPEH); float* ropeM = (float*)(p.ws + WS_ROPEM);
    for (int i = bid * NTHR + tid; i < 2048 * 32; i += G * NTHR) { const int s = i >> 5, e = i & 31; const float pos = (e < 16) ? (float)(s >> 6) : (float)(s & 63);
        const float inv = powf(10000.f, -(float)(2 * (e & 15)) / 32.f); const float ang = pos * inv; ropeH[2 * i] = cosf(ang); ropeH[2 * i + 1] = sinf(ang); }
    for (int i = bid * NTHR + tid; i < 2048 * 16; i += G * NTHR) { const int s = i >> 4, e = i & 15; const float pos = (e < 8) ? (float)(s >> 6) : (float)(s & 63);
        const float inv = powf(10000.f, -(float)(2 * (e & 7)) / 16.f); const float ang = pos * inv; ropeM[2 * i] = cosf(ang); ropeM[2 * i + 1] = sinf(ang); }
    if (bid == 0) {
        float* lbv = (float*)(p.ws + WS_LB);
        for (int d = tid; d < 1024; d += NTHR) { const float a0 = p.hgrn_lb[d], a1 = p.hgrn_lb[1024 + d], a2 = p.hgrn_lb[2048 + d], a3 = p.hgrn_lb[3072 + d];
            const float mx = fmaxf(fmaxf(a0, a1), fmaxf(a2, a3)); const float e0 = expf(a0 - mx), e1 = expf(a1 - mx), e2 = expf(a2 - mx), e3 = expf(a3 - mx);
            lbv[d] = (e1 + e2) / (e0 + e1 + e2 + e3); }
        if (tid == 0) { float s1 = 0.f, s2 = 0.f; for (int d = 0; d < 64; ++d) { s1 += p.diff_lambda[d] * p.diff_lambda[64 + d]; s2 += p.diff_lambda[128 + d] * p.diff_lambda[192 + d]; }
            const float lambda_init = 0.8f - 0.6f * expf(-0.3f);
            ((float*)(p.ws + WS_LAM))[0] = expf(s1) - expf(s2) + lambda_init; ((float*)(p.ws + WS_LAM))[1] = lambda_init; }
    }
    LAS float* sS = (LAS float*)lds; LAS float* red = (LAS float*)(lds + 17 * 1024 * 4);
    for (int i = tid; i < 17 * 1024; i += NTHR) { const int r = i >> 10, k = i & 1023; const float v = r < 16 ? p.c[r * 1024 + k] : p.c_ctx[k]; sS[i] = v / (1.f + expf(-v)); }
    __syncthreads();
    float* mod = (float*)(p.ws + WS_MOD);
    for (int item = bid; item < 4 * 144; item += G) {
        const int l = item / 144, n0 = (item - l * 144) * 64, col = tid & 63, kq = tid >> 6;
        const float* W = p.ada_w + (size_t)l * 1024 * NMODV + n0 + col;
        float acc[17];
#pragma unroll
        for (int r = 0; r < 17; ++r) acc[r] = 0.f;
        for (int k = kq * 128; k < kq * 128 + 128; k += 8) {
            float w[8];
#pragma unroll
            for (int i = 0; i < 8; ++i) w[i] = *(const GAS float*)(W + (size_t)(k + i) * NMODV);
#pragma unroll
            for (int i = 0; i < 8; i += 4)
#pragma unroll
                for (int r = 0; r < 17; ++r) { const f32x4 s4 = *(const LAS f32x4*)(sS + r * 1024 + k + i); acc[r] += (s4[0] * w[i] + s4[1] * w[i + 1]) + (s4[2] * w[i + 2] + s4[3] * w[i + 3]); }
        }
#pragma unroll
        for (int r = 0; r < 17; ++r) red[(kq * 17 + r) * 64 + col] = acc[r];
        __syncthreads();
        for (int o = tid; o < 17 * 64; o += NTHR) { const int r = o >> 6, cc = o & 63;
            float s = 0.f;
#pragma unroll
            for (int q = 0; q < 8; ++q) s += red[(q * 17 + r) * 64 + cc];
            mod[((size_t)l * 17 + r) * NMODV + n0 + cc] = s + p.ada_b[(size_t)l * NMODV + n0 + cc]; }
        __syncthreads();
    }
}

__device__ __forceinline__ void norm_phase(float* HX, const float* nw, const float* modl, int shift_idx, int scale_idx, bf16_t* A, const float* P, bool skip_ctx = false, const float* srcx = nullptr, const float* srcc = nullptr) {
    const int tid = fresh_tid(), lane = tid & 63, gw = fresh_bid() * 8 + (tid >> 6), NGW = fresh_gdim() * 8;
    f32x4 w4[4];
#pragma unroll
    for (int j = 0; j < 4; ++j) w4[j] = ldg4(nw + lane * 4 + 256 * j);
    for (int row0 = gw; row0 < TT; row0 += 2 * NGW) {
        f32x4 v[2][4]; int mr[2]; bool act[2];
#pragma unroll
        for (int q = 0; q < 2; ++q) {
            const int row = row0 + q * NGW, b = row / TB, t = row - b * TB; mr[q] = t < CL ? 16 : b; act[q] = !(skip_ctx && t < CL);
            const float* xr = srcx == nullptr ? HX + (size_t)row * DM + lane * 4 : (t < CL ? srcc + ((size_t)(b * CL + t)) * DM : srcx + ((size_t)(b * SQ + t - CL)) * DM) + lane * 4;
            if (act[q]) {
#pragma unroll
                for (int j = 0; j < 4; ++j) v[q][j] = ldg4(xr + 256 * j);
                if (srcx != nullptr) { float* hw = HX + (size_t)row * DM + lane * 4;
#pragma unroll
                    for (int j = 0; j < 4; ++j) stg4(hw + 256 * j, v[q][j]); }
            }
        }
#pragma unroll
        for (int q = 0; q < 2; ++q) {
            const int row = row0 + q * NGW;
            if (act[q] && P != nullptr && row >= SPLIT_PM0 * 256) {
                const GAS u32x2* pr = (const GAS u32x2*)((const bf16_t*)P + (size_t)(row - SPLIT_PM0 * 256) * DM) + lane;
                float* xr = HX + (size_t)row * DM + lane * 4;
#pragma unroll
                for (int j = 0; j < 4; ++j) {
                    f32x4 a = {0.f, 0.f, 0.f, 0.f};
#pragma unroll
                    for (int k = 0; k < 4; ++k) { const u32x2 w = pr[(size_t)k * SPLIT_ROWS * 256 + 64 * j]; a[0] += bflo(w.x); a[1] += bfhi(w.x); a[2] += bflo(w.y); a[3] += bfhi(w.y); }
                    v[q][j] = v[q][j] + a; stg4(xr + 256 * j, v[q][j]); }
            }
        }
#pragma unroll
        for (int q = 0; q < 2; ++q) {
            if (!act[q]) continue;
            const int row = row0 + q * NGW; float ss = 0.f;
#pragma unroll
            for (int j = 0; j < 4; ++j) ss += (v[q][j][0] * v[q][j][0] + v[q][j][1] * v[q][j][1]) + (v[q][j][2] * v[q][j][2] + v[q][j][3] * v[q][j][3]);
            const float rstd = rsqrtf(wave_sum(ss) * (1.f / 1024.f) + 1e-6f);
            const float* sh = modl + (size_t)mr[q] * NMODV + shift_idx * 1024 + lane * 4; const float* sc = modl + (size_t)mr[q] * NMODV + scale_idx * 1024 + lane * 4;
            bf16_t* ar = A + (size_t)row * DM + lane * 4;
#pragma unroll
            for (int j = 0; j < 4; ++j) { const f32x4 s4 = ldg4(sc + 256 * j), h4 = ldg4(sh + 256 * j);
                const f32x4 y = v[q][j] * rstd * w4[j] * (1.f + s4) + h4; store4bf(ar + 256 * j, y); }
        }
    }
}
__device__ __forceinline__ void final_phase(const float* HX, const float* nw, float* out) {
    const int tid = fresh_tid(), lane = tid & 63, gw = fresh_bid() * 8 + (tid >> 6), NGW = fresh_gdim() * 8;
    f32x4 w4[4];
#pragma unroll
    for (int j = 0; j < 4; ++j) w4[j] = ldg4(nw + lane * 4 + 256 * j);
    for (int r0 = gw; r0 < NB * SQ; r0 += 2 * NGW) {
        f32x4 v[2][4];
#pragma unroll
        for (int q = 0; q < 2; ++q) { const int r = r0 + q * NGW, b = r >> 11, sidx = r & 2047; const float* xr = HX + (size_t)(b * TB + CL + sidx) * DM + lane * 4;
#pragma unroll
            for (int j = 0; j < 4; ++j) v[q][j] = ldg4(xr + 256 * j); }
#pragma unroll
        for (int q = 0; q < 2; ++q) { const int r = r0 + q * NGW; float ss = 0.f;
#pragma unroll
            for (int j = 0; j < 4; ++j) ss += (v[q][j][0] * v[q][j][0] + v[q][j][1] * v[q][j][1]) + (v[q][j][2] * v[q][j][2] + v[q][j][3] * v[q][j][3]);
            const float rstd = rsqrtf(wave_sum(ss) * (1.f / 1024.f) + 1e-6f);
            float* o = out + (size_t)r * DM + lane * 4;
#pragma unroll
            for (int j = 0; j < 4; ++j) stg4(o + 256 * j, v[q][j] * rstd * w4[j]); }
    }
}
__device__ __forceinline__ void diff_combine(const bf16_t* O16, const float* subln, const float* lamp, bf16_t* A) {
    const int tid = fresh_tid(), lane = tid & 63, gw = fresh_bid() * 8 + (tid >> 6), NGW = fresh_gdim() * 8;
    const float lam = lamp[0], om = 1.f - lamp[1];
    const int h = lane >> 3, e0 = (lane & 7) * 16;
    float sw[16];
#pragma unroll
    for (int j = 0; j < 16; ++j) sw[j] = subln[e0 + j] * om;
    for (int row = gw; row < TT; row += NGW) {
        const u32x4* o1 = (const u32x4*)(O16 + (size_t)row * 2048 + (2 * h) * 128 + e0); const u32x4* o2 = (const u32x4*)(O16 + (size_t)row * 2048 + (2 * h + 1) * 128 + e0);
        float v[16]; float ss = 0.f;
#pragma unroll
        for (int q = 0; q < 2; ++q) { const u32x4 a = o1[q], b = o2[q];
#pragma unroll
            for (int k = 0; k < 4; ++k) { v[q * 8 + 2 * k] = bflo(a[k]) - lam * bflo(b[k]); v[q * 8 + 2 * k + 1] = bfhi(a[k]) - lam * bfhi(b[k]); } }
#pragma unroll
        for (int j = 0; j < 16; ++j) ss += v[j] * v[j];
        ss += __shfl_xor(ss, 1); ss += __shfl_xor(ss, 2); ss += __shfl_xor(ss, 4);
        const float rstd = rsqrtf(ss * (1.f / 128.f) + 1e-6f);
        u32x4 w0, w1;
        w0.x = pk2(v[0] * rstd * sw[0], v[1] * rstd * sw[1]); w0.y = pk2(v[2] * rstd * sw[2], v[3] * rstd * sw[3]); w0.z = pk2(v[4] * rstd * sw[4], v[5] * rstd * sw[5]); w0.w = pk2(v[6] * rstd * sw[6], v[7] * rstd * sw[7]);
        w1.x = pk2(v[8] * rstd * sw[8], v[9] * rstd * sw[9]); w1.y = pk2(v[10] * rstd * sw[10], v[11] * rstd * sw[11]); w1.z = pk2(v[12] * rstd * sw[12], v[13] * rstd * sw[13]); w1.w = pk2(v[14] * rstd * sw[14], v[15] * rstd * sw[15]);
        u32x4* d = (u32x4*)(A + (size_t)row * 1024 + h * 128 + e0); d[0] = w0; d[1] = w1;
    }
}
__device__ __forceinline__ void hgrn_combine(const bf16_t* OF, const bf16_t* OB, const bf16_t* Gt, const float* nw, bf16_t* A) {
    const int tid = fresh_tid(), lane = tid & 63, gw = fresh_bid() * 8 + (tid >> 6), NGW = fresh_gdim() * 8;
    const int e0 = (lane & 7) * 16;
    float sw[16];
#pragma unroll
    for (int j = 0; j < 16; ++j) sw[j] = nw[e0 + j];
    for (int row = gw; row < TT; row += NGW) {
        const size_t off = (size_t)row * 1024 + lane * 16;
        const u32x4* pf = (const u32x4*)(OF + off); const u32x4* pb = (const u32x4*)(OB + off); const u32x4* pg = (const u32x4*)(Gt + off);
        float v[16], g[16]; float ss = 0.f;
#pragma unroll
        for (int q = 0; q < 2; ++q) { const u32x4 a = pf[q], b = pb[q], c = pg[q];
#pragma unroll
            for (int k = 0; k < 4; ++k) { v[q * 8 + 2 * k] = bflo(a[k]) + bflo(b[k]); v[q * 8 + 2 * k + 1] = bfhi(a[k]) + bfhi(b[k]); g[q * 8 + 2 * k] = bflo(c[k]); g[q * 8 + 2 * k + 1] = bfhi(c[k]); } }
#pragma unroll
        for (int j = 0; j < 16; ++j) ss += v[j] * v[j];
        ss += __shfl_xor(ss, 1); ss += __shfl_xor(ss, 2); ss += __shfl_xor(ss, 4);
        const float rstd = rsqrtf(ss * (1.f / 128.f) + 1e-6f);
        u32x4 w0, w1;
#define HC(j) (v[j] * rstd * sw[j] * g[j])
        w0.x = pk2(HC(0), HC(1)); w0.y = pk2(HC(2), HC(3)); w0.z = pk2(HC(4), HC(5)); w0.w = pk2(HC(6), HC(7));
        w1.x = pk2(HC(8), HC(9)); w1.y = pk2(HC(10), HC(11)); w1.z = pk2(HC(12), HC(13)); w1.w = pk2(HC(14), HC(15));
#undef HC
        u32x4* d = (u32x4*)(A + off); d[0] = w0; d[1] = w1;
    }
}
__device__ __forceinline__ void mla_rows(const float* DN, const float* qn, const float* kvn, const float* ropeM, bf16_t* CQ, bf16_t* CKV, bf16_t* K) {
    const int tid = fresh_tid(), lane = tid & 63, gw = fresh_bid() * 8 + (tid >> 6), NGW = fresh_gdim() * 8;
    const f32x4 wq = ldg4(qn + lane * 4), wk = ldg4(kvn + lane * 4);
    for (int row0 = gw; row0 < TT; row0 += 3 * NGW) {
        f32x4 a3[3], c3[3]; float kr3[3];
#pragma unroll
        for (int q = 0; q < 3; ++q) { const float* dr = DN + (size_t)(row0 + q * NGW) * 768; a3[q] = ldg4(dr + lane * 4); c3[q] = ldg4(dr + 256 + lane * 4); kr3[q] = *(const GAS float*)(dr + 512 + (lane & 31)); }
#pragma unroll
        for (int q = 0; q < 3; ++q) {
        const int row = row0 + q * NGW;
        const int b = row / TB, t = row - b * TB;
        const f32x4 a = a3[q], c = c3[q]; const float kr = kr3[q];
        float sa = (a[0] * a[0] + a[1] * a[1]) + (a[2] * a[2] + a[3] * a[3]), sc = (c[0] * c[0] + c[1] * c[1]) + (c[2] * c[2] + c[3] * c[3]);
        sa = wave_sum(sa); sc = wave_sum(sc);
        const float ra = rsqrtf(sa * (1.f / 256.f) + 1e-6f), rc = rsqrtf(sc * (1.f / 256.f) + 1e-6f);
        store4bf(CQ + (size_t)row * 256 + lane * 4, a * ra * wq); store4bf(CKV + (size_t)row * 256 + lane * 4, c * rc * wk);
        const int d = lane & 31; float kv = kr;
        const float part = __shfl_xor(kr, 8);
        if (t >= CL) { const int e = (d >> 4) * 8 + (d & 7); const float cs = ropeM[((size_t)(t - CL) * 16 + e) * 2], sn = ropeM[((size_t)(t - CL) * 16 + e) * 2 + 1];
            kv = kr * cs + ((d & 8) ? part : -part) * sn; }
        float o8[8];
#pragma unroll
        for (int jj = 0; jj < 8; ++jj) o8[jj] = __shfl(kv, (lane & 3) * 8 + jj);
        u32x4 w; w.x = pk2(o8[0], o8[1]); w.y = pk2(o8[2], o8[3]); w.z = pk2(o8[4], o8[5]); w.w = pk2(o8[6], o8[7]);
        *(GAS u32x4*)(K + (size_t)row * 1536 + (lane >> 2) * 96 + 64 + (lane & 3) * 8) = w;
        }
    }
}

template <int DQK, int DV>
__device__ __forceinline__ void attn_unit(LAS unsigned char* lds, const bf16_t* Qr, int qs, const bf16_t* Kb, int ks, const bf16_t* Vtb, bf16_t* Or, int os,
                                          int lt0, int lt1, bool windowed, int qpos0, float m_init, float l_init,
                                          int dmode = 0  , float lam = 0.f, float om = 0.f, const float* subw = nullptr) {
    constexpr int KST = DQK * 2 + 16, VST = 144, KBUF = 64 * KST, VBUF = DV * VST, KCH = DQK / 8, NKC = 64 * KCH, KPT = (NKC + NTHR - 1) / NTHR, VPT = DV / 64, ND = DQK / 16, NO = DV / 32;
    const int tid = fresh_tid(), lane = tid & 63, r32 = lane & 31, hi = lane >> 5, wid = tid >> 6;
    LAS unsigned char* Kl = lds; LAS unsigned char* Vl = lds + 2 * KBUF;
    const int ntiles = 4 + (lt1 - lt0);
    const GAS bf16_t* Qg = (const GAS bf16_t*)Qr; const GAS bf16_t* Kg = (const GAS bf16_t*)Kb; const GAS bf16_t* Vg = (const GAS bf16_t*)Vtb; GAS bf16_t* Og = (GAS bf16_t*)Or;
    bf16x8 qf[ND];
#pragma unroll
    for (int d0 = 0; d0 < ND; ++d0) qf[d0] = *(const GAS bf16x8*)(Qg + (size_t)(wid * 32 + r32) * qs + d0 * 16 + hi * 8);
    f32x16 o[NO];
#pragma unroll
    for (int nb = 0; nb < NO; ++nb)
#pragma unroll
        for (int r = 0; r < 16; ++r) o[nb][r] = 0.f;
    const bool have_ref = l_init > 0.f;
    float m = have_ref ? m_init : 0.f, l = (hi == 0) ? l_init : 0.f;
    u32x4 kreg[KPT], vreg[VPT];
#define ATT_KT(tt_) ((tt_) < 4 ? (tt_) : lt0 + (tt_) - 4)
#define ATT_LOADK(tt_) do { const int kt_ = ATT_KT(tt_); \
        _Pragma("unroll") for (int i_ = 0; i_ < KPT; ++i_) { const int c_ = tid + NTHR * i_; if (c_ < NKC) { const int key_ = c_ / KCH, part_ = c_ - key_ * KCH; kreg[i_] = *(const GAS u32x4*)(Kg + (size_t)(kt_ * 64 + key_) * ks + part_ * 8); } } } while (0)
#define ATT_LOADV(tt_) do { const int kt_ = ATT_KT(tt_); \
        _Pragma("unroll") for (int i_ = 0; i_ < VPT; ++i_) { const int c_ = tid + NTHR * i_; const int dv_ = c_ >> 3, part_ = c_ & 7; vreg[i_] = *(const GAS u32x4*)(Vg + (size_t)dv_ * TB + kt_ * 64 + part_ * 8); } } while (0)
#define ATT_STOREK(buf_) do { \
        _Pragma("unroll") for (int i_ = 0; i_ < KPT; ++i_) { const int c_ = tid + NTHR * i_; if (c_ < NKC) { const int key_ = c_ / KCH, part_ = c_ - key_ * KCH; *(LAS u32x4*)(Kl + (buf_) * KBUF + key_ * KST + part_ * 16) = kreg[i_]; } } } while (0)
#define ATT_STOREV(buf_) do { \
        _Pragma("unroll") for (int i_ = 0; i_ < VPT; ++i_) { const int c_ = tid + NTHR * i_; const int dv_ = c_ >> 3, part_ = c_ & 7; LAS unsigned char* d_ = Vl + (buf_) * VBUF + dv_ * VST + (part_ >> 1) * 32 + (part_ & 1) * 8;     \
            *(LAS u32x2*)d_ = (u32x2){vreg[i_].x, vreg[i_].y}; *(LAS u32x2*)(d_ + 16) = (u32x2){vreg[i_].z, vreg[i_].w}; } } while (0)
#define SCHED_FENCE() __builtin_amdgcn_sched_barrier(0)
#define ATT_KFRAG(buf_) do { const LAS unsigned char* kb_ = Kl + (buf_) * KBUF + r32 * KST + hi * 16; \
        _Pragma("unroll") for (int d0 = 0; d0 < ND; ++d0) { kf[2 * d0] = *(const LAS bf16x8*)(kb_ + d0 * 32); kf[2 * d0 + 1] = *(const LAS bf16x8*)(kb_ + 32 * KST + d0 * 32); } } while (0)
#define ATT_QKM(P0_, P1_) do { \
        _Pragma("unroll") for (int d0 = 0; d0 < ND; ++d0) { \
            if (d0 == 0) { const f32x16 z_ = {0.f, 0.f, 0.f, 0.f, 0.f, 0.f, 0.f, 0.f, 0.f, 0.f, 0.f, 0.f, 0.f, 0.f, 0.f, 0.f}; P0_ = __builtin_amdgcn_mfma_f32_32x32x16_bf16(kf[0], qf[0], z_, 0, 0, 0); P1_ = __builtin_amdgcn_mfma_f32_32x32x16_bf16(kf[1], qf[0], z_, 0, 0, 0); } \
            else { P0_ = __builtin_amdgcn_mfma_f32_32x32x16_bf16(kf[2 * d0], qf[d0], P0_, 0, 0, 0); P1_ = __builtin_amdgcn_mfma_f32_32x32x16_bf16(kf[2 * d0 + 1], qf[d0], P1_, 0, 0, 0); } } } while (0)
#define ATT_VFRAG(dst_, nb_) do { _Pragma("unroll") for (int j_ = 0; j_ < 4; ++j_) dst_[j_] = *(const LAS u32x4*)(vb + (nb_) * 32 * VST + j_ * 32); } while (0)
    bf16x8 kf[2 * ND];
    f32x16 n0, n1;
    ATT_LOADK(0); ATT_LOADV(0); ATT_STOREK(0); ATT_STOREV(0);
    __syncthreads();
    ATT_LOADK(1); ATT_KFRAG(0); ATT_QKM(n0, n1); ATT_STOREK(1);
    __syncthreads();
    for (int tt = 0; tt < ntiles; ++tt) {
        const int cur = tt & 1;
        f32x16 p0 = n0, p1 = n1;
        if (tt + 2 < ntiles) ATT_LOADK(tt + 2);
        if (tt + 1 < ntiles) ATT_LOADV(tt + 1);
#define ATT_OUTSIDE(t_) (windowed && (t_) >= 4 && (((lt0 + (t_) - 4) * 64 - CL) > qhi_w + 128 || ((lt0 + (t_) - 4) * 64 - CL + 63) < qlo_w - 128))
        const int qlo_w = qpos0 + __builtin_amdgcn_readfirstlane(wid) * 32, qhi_w = qlo_w + 31;
        const bool skip_cur = ATT_OUTSIDE(tt), skip_next = ATT_OUTSIDE(tt + 1);
        u32x4 pw[4];
        if (!skip_cur) {
        if (windowed && tt >= 4) {
            const int kt = lt0 + tt - 4; const int kbase = kt * 64 - CL, qp = qpos0 + wid * 32 + r32;
#pragma unroll
            for (int r = 0; r < 16; ++r) { const int d0 = qp - (kbase + crow(r, hi)); if (d0 > 128 || d0 < -128) p0[r] = -1e30f; const int d1 = d0 - 32; if (d1 > 128 || d1 < -128) p1[r] = -1e30f; }
        }
        float mx = __builtin_fmaxf(__builtin_fmaxf(p0[0], p1[0]), p0[1]);
#pragma unroll
        for (int r = 1; r < 16; ++r) { if (r > 1) mx = __builtin_fmaxf(__builtin_fmaxf(mx, p0[r]), p1[r]); else mx = __builtin_fmaxf(mx, p1[1]); }
        mx = __builtin_fmaxf(mx, __shfl_xor(mx, 32)) - m;
        const bool force = (tt == 0) && !have_ref;
        if (force || __any(mx > 8.f)) {
            const float delta = force ? mx : __builtin_fmaxf(mx, 0.f);
            m += delta;
            if (!force) { const float alpha = __builtin_amdgcn_exp2f(-delta); l *= alpha;
#pragma unroll
                for (int nb = 0; nb < NO; ++nb)
#pragma unroll
                    for (int r = 0; r < 16; ++r) o[nb][r] *= alpha; }
        }
        float ls = 0.f;
#pragma unroll
        for (int r = 0; r < 16; ++r) { p0[r] = __builtin_amdgcn_exp2f(p0[r] - m); p1[r] = __builtin_amdgcn_exp2f(p1[r] - m); ls += p0[r] + p1[r]; }
        l += ls;
        pw[0] = (u32x4){pk2(p0[0], p0[1]), pk2(p0[2], p0[3]), pk2(p0[4], p0[5]), pk2(p0[6], p0[7])};
        pw[1] = (u32x4){pk2(p0[8], p0[9]), pk2(p0[10], p0[11]), pk2(p0[12], p0[13]), pk2(p0[14], p0[15])};
        pw[2] = (u32x4){pk2(p1[0], p1[1]), pk2(p1[2], p1[3]), pk2(p1[4], p1[5]), pk2(p1[6], p1[7])};
        pw[3] = (u32x4){pk2(p1[8], p1[9]), pk2(p1[10], p1[11]), pk2(p1[12], p1[13]), pk2(p1[14], p1[15])};
        SCHED_FENCE();
        }
        const LAS unsigned char* vb = Vl + cur * VBUF + r32 * VST + hi * 16;
        u32x4 vf[2][4];
        if (!skip_next) ATT_KFRAG(cur ^ 1);
        if (!skip_cur) ATT_VFRAG(vf[0], 0);
        SCHED_FENCE();
        if (!skip_next) ATT_QKM(n0, n1);
        if (!skip_cur) {
#pragma unroll
        for (int nb = 0; nb < NO; ++nb) {
            if (nb + 1 < NO) ATT_VFRAG(vf[(nb + 1) & 1], nb + 1);
            SCHED_FENCE();
#pragma unroll
            for (int j = 0; j < 4; ++j) o[nb] = __builtin_amdgcn_mfma_f32_32x32x16_bf16(__builtin_bit_cast(bf16x8, vf[nb & 1][j]), __builtin_bit_cast(bf16x8, pw[j]), o[nb], 0, 0, 0);
            SCHED_FENCE();
        }
        }
#undef ATT_OUTSIDE
        if (tt + 2 < ntiles) ATT_STOREK(cur);
        if (tt + 1 < ntiles) ATT_STOREV(cur ^ 1);
        __syncthreads();
    }
#undef SCHED_FENCE
#undef ATT_KFRAG
#undef ATT_QKM
#undef ATT_VFRAG
#undef ATT_KT
#undef ATT_LOADK
#undef ATT_LOADV
#undef ATT_STOREK
#undef ATT_STOREV
    l += __shfl_xor(l, 32);
    const float inv = 1.f / l;
    GAS bf16_t* orow = Og + (size_t)(wid * 32 + r32) * os + 4 * hi;
    LAS unsigned char* stash = lds + 2 * KBUF + 2 * VBUF + (wid * 32 + r32) * 264 + 8 * hi;
    if (DV == 128 && dmode == 1) {
#pragma unroll
        for (int nb = 0; nb < NO; ++nb)
#pragma unroll
            for (int g = 0; g < 4; ++g) { u32x2 w; w.x = pk2(o[nb][4 * g] * inv, o[nb][4 * g + 1] * inv); w.y = pk2(o[nb][4 * g + 2] * inv, o[nb][4 * g + 3] * inv); *(LAS u32x2*)(stash + nb * 64 + 16 * g) = w; }
    } else if (DV == 128 && dmode == 2) {
        const float li = lam * inv; float ss = 0.f;
#pragma unroll
        for (int nb = 0; nb < NO; ++nb)
#pragma unroll
            for (int g = 0; g < 4; ++g) { const u32x2 a = *(const LAS u32x2*)(stash + nb * 64 + 16 * g);
                const float x0 = bflo(a.x) - li * o[nb][4 * g], x1 = bfhi(a.x) - li * o[nb][4 * g + 1], x2 = bflo(a.y) - li * o[nb][4 * g + 2], x3 = bfhi(a.y) - li * o[nb][4 * g + 3];
                o[nb][4 * g] = x0; o[nb][4 * g + 1] = x1; o[nb][4 * g + 2] = x2; o[nb][4 * g + 3] = x3; ss += (x0 * x0 + x1 * x1) + (x2 * x2 + x3 * x3); }
        ss += __shfl_xor(ss, 32);
        const float rs = rsqrtf(ss * (1.f / 128.f) + 1e-6f) * om;
#pragma unroll
        for (int nb = 0; nb < NO; ++nb)
#pragma unroll
            for (int g = 0; g < 4; ++g) { const f32x4 w4 = ldg4(subw + nb * 32 + 8 * g + 4 * hi); u32x2 w;
                w.x = pk2(o[nb][4 * g] * rs * w4[0], o[nb][4 * g + 1] * rs * w4[1]); w.y = pk2(o[nb][4 * g + 2] * rs * w4[2], o[nb][4 * g + 3] * rs * w4[3]); *(GAS u32x2*)(orow + nb * 32 + 8 * g) = w; }
    } else {
#pragma unroll
    for (int nb = 0; nb < NO; ++nb)
#pragma unroll
        for (int g = 0; g < 4; ++g) { u32x2 w; w.x = pk2(o[nb][4 * g] * inv, o[nb][4 * g + 1] * inv); w.y = pk2(o[nb][4 * g + 2] * inv, o[nb][4 * g + 3] * inv); *(GAS u32x2*)(orow + nb * 32 + 8 * g) = w; }
    }
}

template <int KIND>
__device__ __forceinline__ void attn_phase(unsigned char* big, bf16_t* Abuf, const float* sinks  , const float* lamp, LAS unsigned char* lds, bool with_ctx) {
    constexpr int NHU = (KIND == 1) ? 8 : 16;
    const int NLAT = NB * NHU * 8, NU = NLAT + (with_ctx ? NB * NHU : 0);
    const int bid_ = fresh_bid(), vb_ = (bid_ & 7) * (GRID / 8) + (bid_ >> 3);
    for (int u = vb_; u < NU; u += GRID) {
        int b, head, j;
        if (u < NLAT) { j = 1 + (u & 7); head = (u >> 3) % NHU; b = (u >> 3) / NHU; } else { const int v = u - NLAT; j = 0; head = v % NHU; b = v / NHU; }
        const size_t row0 = (size_t)b * TB + j * 256;
        int lt0 = 4, lt1 = 4; const int qpos0 = (j - 1) * 256;
        if (j > 0) { if (KIND == 0) { int lo = qpos0 - 128; if (lo < 0) lo = 0; int hi = qpos0 + 255 + 128; if (hi > SQ - 1) hi = SQ - 1; lt0 = 4 + lo / 64; lt1 = 4 + hi / 64 + 1; } else { lt0 = 4; lt1 = 36; } }
        if (KIND == 0) {
            const bf16_t* Q = (const bf16_t*)big; const bf16_t* K = (const bf16_t*)(big + U72); const bf16_t* Vt = (const bf16_t*)(big + U72 + 18 * MiB);
            const float sink = sinks[head] * LOG2E;
            attn_unit<64, 64>(lds, Q + row0 * 1024 + head * 64, 1024, K + (size_t)b * TB * 256 + (head >> 2) * 64, 256, Vt + (size_t)(b * 4 + (head >> 2)) * 64 * TB,
                              Abuf + row0 * 1024 + head * 64, 1024, lt0, lt1, true, qpos0, sink, 1.f);
        } else if (KIND == 1) {
            const bf16_t* Q = (const bf16_t*)big; const bf16_t* K = (const bf16_t*)(big + U72); const bf16_t* Vt = (const bf16_t*)(big + 2 * U72);
            const float lam = lamp[0], om = 1.f - lamp[1];
            attn_unit<64, 128>(lds, Q + row0 * 1024 + (2 * head) * 64, 1024, K + (size_t)b * TB * 1024 + (2 * head) * 64, 1024, Vt + (size_t)(b * 8 + head) * 128 * TB,
                               Abuf + row0 * 1024 + head * 128, 1024, lt0, lt1, false, qpos0, -1e30f, 0.f, 1);
            attn_unit<64, 128>(lds, Q + row0 * 1024 + (2 * head + 1) * 64, 1024, K + (size_t)b * TB * 1024 + (2 * head + 1) * 64, 1024, Vt + (size_t)(b * 8 + head) * 128 * TB,
                               Abuf + row0 * 1024 + head * 128, 1024, lt0, lt1, false, qpos0, -1e30f, 0.f, 2, lam, om, sinks);
        } else {
            const bf16_t* Vt = (const bf16_t*)big; const bf16_t* Q = (const bf16_t*)(big + 2 * U72); const bf16_t* K = (const bf16_t*)(big + 2 * U72 + 108 * MiB);
            attn_unit<96, 64>(lds, Q + row0 * 1536 + head * 96, 1536, K + (size_t)b * TB * 1536 + head * 96, 1536, Vt + (size_t)(b * 16 + head) * 64 * TB,
                              Abuf + row0 * 1024 + head * 64, 1024, lt0, lt1, false, qpos0, -1e30f, 0.f);
        }
    }
}

__device__ __forceinline__ void hgrn_scan(unsigned char* big, bf16_t* OF, bf16_t* OB, LAS unsigned char* lds) {
    constexpr int GST = 132;
    constexpr int O_G = 0, O_QT = 34816, O_KT = O_QT + 17408, O_KTT = O_KT + 17408, O_VT = O_KTT + 18432, O_AB = O_VT + 18432, O_SEG = O_AB + 9216, O_GM = O_SEG + 2048, O_GL = O_GM + 512;
    const bf16_t* Qh = (const bf16_t*)big; const bf16_t* Vv = (const bf16_t*)(big + 3 * U72);
    const int tid = fresh_tid(), lane = tid & 63, r32 = lane & 31, hi = lane >> 5, wid = tid >> 6;
    LAS float* Gs = (LAS float*)(lds + O_G); LAS unsigned char* STb = lds + O_G;
    LAS unsigned char* QTb = lds + O_QT; LAS unsigned char* KTb = lds + O_KT; LAS unsigned short* KTT = (LAS unsigned short*)(lds + O_KTT); LAS unsigned short* VT = (LAS unsigned short*)(lds + O_VT);
    LAS unsigned short* AB = (LAS unsigned short*)(lds + O_AB); LAS float* SEG = (LAS float*)(lds + O_SEG); LAS float* GM = (LAS float*)(lds + O_GM); LAS float* GL = (LAS float*)(lds + O_GL);
    for (int u = fresh_bid(); u < 256; u += fresh_gdim()) {
        const int dir = u & 1, h = (u >> 1) & 7, b = u >> 4;
        const unsigned short* LFd = (const unsigned short*)(big + (dir == 0 ? U72 : 2 * U72));
        bf16_t* Od = dir == 0 ? OF : OB;
        f32x16 S[2];
#pragma unroll
        for (int nb = 0; nb < 2; ++nb)
#pragma unroll
            for (int r = 0; r < 16; ++r) S[nb][r] = 0.f;
        const int db = wid >> 1, eh = wid & 1, ti = wid >> 2, ei = wid & 3;
        u32x4 q8[2], lf8[2], v8[2];
#define HG_TOK(ci_, tp_) ((size_t)b * TB + (size_t)((dir == 0) ? (ci_) : ((ci_) < 4 ? 3 - (ci_) : 39 - (ci_))) * 64 + ((dir == 0) ? (tp_) : 63 - (tp_)))
#define HG_LOAD(ci_) do { _Pragma("unroll") for (int i_ = 0; i_ < 2; ++i_) { const int ch_ = tid + NTHR * i_; const int tp_ = ch_ & 63, dc_ = ch_ >> 6; const size_t o_ = HG_TOK(ci_, tp_) * 1024 + h * 128 + dc_ * 8; \
            q8[i_] = *(const GAS u32x4*)((const GAS bf16_t*)Qh + o_); lf8[i_] = *(const GAS u32x4*)((const GAS unsigned short*)LFd + o_); v8[i_] = *(const GAS u32x4*)((const GAS bf16_t*)Vv + o_); } } while (0)
        HG_LOAD(0);
        for (int ci = 0; ci < 36; ++ci) {
#pragma unroll
            for (int i = 0; i < 2; ++i) { const int ch = tid + NTHR * i, tp = ch & 63, dc = ch >> 6; LAS float* g = Gs + tp * GST + dc * 8;
#pragma unroll
                for (int k = 0; k < 4; ++k) { g[2 * k] = h2f((unsigned short)(lf8[i][k] & 0xffffu)); g[2 * k + 1] = h2f((unsigned short)(lf8[i][k] >> 16)); } }
            __syncthreads();
            { const int d = tid & 127, seg = tid >> 7; float run = 0.f;
#pragma unroll
              for (int t = 0; t < 16; ++t) { LAS float* g = Gs + (seg * 16 + t) * GST + d; run += *g; *g = run; }
              SEG[seg * 128 + d] = run; }
            __syncthreads();
#pragma unroll
            for (int i = 0; i < 2; ++i) { const int ch = tid + NTHR * i, tp = ch & 63, dc = ch >> 6, seg = tp >> 4;
                float qt[8], kt[8];
#pragma unroll
                for (int k = 0; k < 8; ++k) { const int d = dc * 8 + k; const float s0 = SEG[d], s1 = SEG[128 + d], s2 = SEG[256 + d];
                    const float off = (seg > 0 ? s0 : 0.f) + (seg > 1 ? s1 : 0.f) + (seg > 2 ? s2 : 0.f);
                    const float g = Gs[tp * GST + d] + off, gm = s0 + s1 + Gs[32 * GST + d];
                    const unsigned lw = lf8[i][k >> 1], qw = q8[i][k >> 1], vw = v8[i][k >> 1];
                    const float lf = h2f((unsigned short)((k & 1) ? (lw >> 16) : (lw & 0xffffu)));
                    const float qv = (k & 1) ? bfhi(qw) : bflo(qw);
                    const float kk = 1.f - __expf(lf);
                    qt[k] = qv * __expf(g - gm); kt[k] = kk * __expf(gm - g);
                    KTT[d * 72 + tp] = f2bf(kt[k]); VT[d * 72 + tp] = (unsigned short)((k & 1) ? (vw >> 16) : (vw & 0xffffu)); }
                *(LAS u32x4*)(QTb + tp * 272 + dc * 16) = (u32x4){pk2(qt[0], qt[1]), pk2(qt[2], qt[3]), pk2(qt[4], qt[5]), pk2(qt[6], qt[7])};
                *(LAS u32x4*)(KTb + tp * 272 + dc * 16) = (u32x4){pk2(kt[0], kt[1]), pk2(kt[2], kt[3]), pk2(kt[4], kt[5]), pk2(kt[6], kt[7])}; }
            if (tid < 128) { const float s0 = SEG[tid], s1 = SEG[128 + tid], s2 = SEG[256 + tid], s3 = SEG[384 + tid]; GM[tid] = s0 + s1 + Gs[32 * GST + tid]; GL[tid] = (s0 + s1) + (s2 + s3); }
            if (ci + 1 < 36) HG_LOAD(ci + 1);
            __syncthreads();
#pragma unroll
            for (int nb = 0; nb < 2; ++nb)
#pragma unroll
                for (int g4 = 0; g4 < 4; ++g4) { const int d0 = 32 * db + 8 * g4 + 4 * hi; const f32x4 gm4 = *(const LAS f32x4*)(GM + d0);
#pragma unroll
                    for (int k = 0; k < 4; ++k) S[nb][4 * g4 + k] *= __expf(gm4[k]);
                    *(LAS u32x2*)(STb + (64 * eh + 32 * nb + r32) * 272 + d0 * 2) = (u32x2){pk2(S[nb][4 * g4], S[nb][4 * g4 + 1]), pk2(S[nb][4 * g4 + 2], S[nb][4 * g4 + 3])}; }
            __syncthreads();
            f32x16 o;
#pragma unroll
            for (int r = 0; r < 16; ++r) o[r] = 0.f;
#pragma unroll
            for (int kk = 0; kk < 8; ++kk) { const bf16x8 a = *(const LAS bf16x8*)(QTb + (32 * ti + r32) * 272 + kk * 32 + hi * 16), bb = *(const LAS bf16x8*)(STb + (32 * ei + r32) * 272 + kk * 32 + hi * 16);
                o = __builtin_amdgcn_mfma_f32_32x32x16_bf16(a, bb, o, 0, 0, 0); }
            if (wid < 4) { const int ti2 = wid >> 1, si = wid & 1; f32x16 a2;
#pragma unroll
                for (int r = 0; r < 16; ++r) a2[r] = 0.f;
#pragma unroll
                for (int kk = 0; kk < 8; ++kk) { const bf16x8 a = *(const LAS bf16x8*)(QTb + (32 * ti2 + r32) * 272 + kk * 32 + hi * 16), bb = *(const LAS bf16x8*)(KTb + (32 * si + r32) * 272 + kk * 32 + hi * 16);
                    a2 = __builtin_amdgcn_mfma_f32_32x32x16_bf16(a, bb, a2, 0, 0, 0); }
#pragma unroll
                for (int r = 0; r < 16; ++r) { const int t = 32 * ti2 + crow(r, hi), s = 32 * si + r32; AB[t * 72 + s] = (t >= s) ? f2bf(a2[r]) : (unsigned short)0; } }
            __syncthreads();
#pragma unroll
            for (int kk = 0; kk < 4; ++kk) { const bf16x8 a = *(const LAS bf16x8*)((LAS unsigned char*)AB + (32 * ti + r32) * 144 + kk * 32 + hi * 16), bb = *(const LAS bf16x8*)((LAS unsigned char*)VT + (32 * ei + r32) * 144 + kk * 32 + hi * 16);
                o = __builtin_amdgcn_mfma_f32_32x32x16_bf16(a, bb, o, 0, 0, 0); }
#pragma unroll
            for (int r = 0; r < 16; ++r) { const int t = 32 * ti + crow(r, hi); ((GAS bf16_t*)Od)[HG_TOK(ci, t) * 1024 + h * 128 + 32 * ei + r32] = f2bf(o[r]); }
#pragma unroll
            for (int nb = 0; nb < 2; ++nb)
#pragma unroll
                for (int kk = 0; kk < 4; ++kk) { const bf16x8 a = *(const LAS bf16x8*)((LAS unsigned char*)KTT + (32 * db + r32) * 144 + kk * 32 + hi * 16), bb = *(const LAS bf16x8*)((LAS unsigned char*)VT + (64 * eh + 32 * nb + r32) * 144 + kk * 32 + hi * 16);
                    S[nb] = __builtin_amdgcn_mfma_f32_32x32x16_bf16(a, bb, S[nb], 0, 0, 0); }
#pragma unroll
            for (int g4 = 0; g4 < 4; ++g4) { const int d0 = 32 * db + 8 * g4 + 4 * hi; const f32x4 gm4 = *(const LAS f32x4*)(GM + d0), gl4 = *(const LAS f32x4*)(GL + d0);
#pragma unroll
                for (int k = 0; k < 4; ++k) { const float sc = __expf(gl4[k] - gm4[k]); S[0][4 * g4 + k] *= sc; S[1][4 * g4 + k] *= sc; } }
            __syncthreads();
        }
#undef HG_LOAD
#undef HG_TOK
    }
}


#define XB_TMO      128
#define XB_XCNT(j)  (256  + 64 * (j))
#define XB_XSUB(j)  (1280 + 64 * (j))
#define XB_XGEN(j)  (2304 + 64 * (j))
#define XB_TOP      3328
#define XB_TOPGEN   3392
#define XCD_BAR_WORDS 3456
#define XB_SPIN_CAP (1u << 18)

__device__ __forceinline__ unsigned xb_ld(unsigned* p)              { return __hip_atomic_load(p, __ATOMIC_RELAXED, __HIP_MEMORY_SCOPE_AGENT); }
__device__ __forceinline__ unsigned xb_add(unsigned* p, unsigned v) { return __hip_atomic_fetch_add(p, v, __ATOMIC_RELAXED, __HIP_MEMORY_SCOPE_AGENT); }
__device__ __forceinline__ unsigned xb_xcc_id() { return (unsigned)__builtin_amdgcn_s_getreg((3 << 11) | 20) & 0xFu; }
#define XB_SPIN(cond, bar) do { unsigned _sp = 0; while (cond) { __builtin_amdgcn_s_sleep(1); \
    if ((++_sp & 255u) == 0u) { if (xb_ld(&(bar)[XB_TMO])) break; if (_sp > XB_SPIN_CAP) { atomicAdd(&(bar)[XB_TMO], 1u); break; } } } } while (0)

struct XcdBarrier {
    unsigned* bar; unsigned x;
    volatile LAS unsigned* st;
};

__device__ __forceinline__ XcdBarrier xcd_barrier_post(unsigned* bar, volatile LAS unsigned* st) {
    XcdBarrier b; b.bar = bar; b.x = xb_xcc_id(); b.st = st;
    if (threadIdx.x == 0) (void)xb_add(&bar[XB_XCNT(b.x)], 1u);
    return b;
}
__device__ __forceinline__ void xcd_barrier_complete(unsigned* bar, unsigned x, unsigned& nloc, unsigned& nx) {
    const unsigned G = gridDim.x * gridDim.y * gridDim.z;
    unsigned sum, cnt, mine, sp = 0u;
    for (;;) {
        sum = 0u; cnt = 0u; mine = 0u;
#pragma unroll
        for (unsigned j = 0; j < 16; ++j) { const unsigned c = xb_ld(&bar[XB_XCNT(j)]); sum += c; cnt += (c > 0u) ? 1u : 0u; mine = (j == x) ? c : mine; }
        if (sum == G) break;
        __builtin_amdgcn_s_sleep(1);
        if ((++sp & 255u) == 0u) { if (xb_ld(&bar[XB_TMO])) break; if (sp > XB_SPIN_CAP) { atomicAdd(&bar[XB_TMO], 1u); break; } }
    }
    nloc = mine > 0u ? mine : 1u; nx = cnt > 0u ? cnt : 1u;
}

__device__ __forceinline__ void xcd_barrier(const XcdBarrier& b) {
    asm volatile("s_waitcnt vmcnt(0)" ::: "memory");
    __syncthreads();
    if (threadIdx.x == 0) {
        unsigned* bar = b.bar;
        __builtin_amdgcn_s_waitcnt(0);
        unsigned nloc = b.st[0], nx = b.st[1];
        if (nloc == 0u) { xcd_barrier_complete(bar, b.x, nloc, nx); b.st[0] = nloc; b.st[1] = nx; }
        const unsigned old = xb_add(&bar[XB_XSUB(b.x)], 1u);
        const unsigned gen = old / nloc;
        if (old + 1u == (gen + 1u) * nloc) {
            __builtin_amdgcn_fence(__ATOMIC_RELEASE, "agent");
            asm volatile("s_waitcnt vmcnt(0)" ::: "memory");
            const unsigned og = xb_add(&bar[XB_TOP], 1u);
            const unsigned tg = og / nx;
            if (og + 1u == (tg + 1u) * nx) xb_add(&bar[XB_TOPGEN], 1u);
            else XB_SPIN(xb_ld(&bar[XB_TOPGEN]) == tg, bar);
            __builtin_amdgcn_fence(__ATOMIC_ACQUIRE, "agent");
            xb_add(&bar[XB_XGEN(b.x)], 1u);
            asm volatile("s_waitcnt vmcnt(0)" ::: "memory");
        } else {
            XB_SPIN(xb_ld(&bar[XB_XGEN(b.x)]) == gen, bar);
            __builtin_amdgcn_fence(__ATOMIC_ACQUIRE, "agent");
            asm volatile("s_waitcnt vmcnt(0)" ::: "memory");
        }
    }
    __syncthreads();
}

enum { K_X = 0, K_C, K_CTX, K_CCTX, K_ADAW, K_ADAB, K_NORMW, K_FNORMW, K_FFNG, K_FFNU, K_FFND, K_GQAIN, K_GQAOUT, K_GQASINK, K_DIFFIN, K_DIFFOUT, K_DIFFLAM, K_DIFFSUB,
       K_HGRNIN, K_HGRNOUT, K_HGRNNORM, K_HGRNLB, K_MLADOWN, K_MLAQN, K_MLAKVN, K_MLAUQ, K_MLAUKV, K_MLAOUT, K_OUT, K_WS };
__device__ __forceinline__ const float* karg_ptr(int idx) {
    const __attribute__((address_space(4))) unsigned long long* ka = (const __attribute__((address_space(4))) unsigned long long*)__builtin_amdgcn_kernarg_segment_ptr();
    int i = idx; asm volatile("" : "+s"(i));
    return (const float*)ka[i];
}
__device__ __forceinline__ Params load_params() {
    Params q;
    const float** qq = (const float**)&q;
#pragma unroll
    for (int i = 0; i < 30; ++i) qq[i] = karg_ptr(i);
    q.ph_lo = 0; q.ph_hi = 0;
    return q;
}
__global__ void __launch_bounds__(NTHR, 2) fwd_megakernel(Params p) {
    extern __shared__ __attribute__((aligned(16))) unsigned char lds_raw[];
    LAS unsigned char* lds = (LAS unsigned char*)lds_raw;
    cg::grid_group grid = cg::this_grid();
    const int ph_lo = p.ph_lo, ph_hi = p.ph_hi;
    volatile LAS unsigned* bst = (volatile LAS unsigned*)(lds + LDS_BYTES - 64);
    if (threadIdx.x < 2) bst[threadIdx.x] = 0u;
    __syncthreads();
    XcdBarrier bar = xcd_barrier_post((unsigned*)((unsigned char*)karg_ptr(K_WS) + WS_BAR), bst);
    int nsync = 0;
#define GRID_SYNC() do { xcd_barrier(bar); ++nsync; } while (0)
    if (ph_lo < 0) grid.sync();
    int ph = 0;
#ifndef PH_MASK
#define PH_MASK 0xffffffffu
#endif
#define COMP(k) (((PH_MASK) >> (k)) & 1u)
#ifndef DUP_MASK
#define DUP_MASK 0u
#endif
#define NREP(k) (1 + (int)(((DUP_MASK) >> (k)) & 1u))
#define PHASE_BEGIN(k) if (ph >= ph_lo && ph < ph_hi) { unsigned char* dout = (unsigned char*)karg_ptr(K_OUT); unsigned char* ws = (unsigned char*)karg_ptr(K_WS); \
        unsigned char* big = ws + WS_BIG; float* HX = (float*)(ws + WS_HX); const float* mod = (const float*)(ws + WS_MOD); bf16_t* Abuf = (bf16_t*)(dout + DO_A); \
        const float* modl = mod + (size_t)layer * 17 * NMODV; (void)big; (void)HX; (void)modl; (void)Abuf; \
        for (int rep_ = 0; rep_ < NREP(k); ++rep_) { if (rep_) GRID_SYNC();
#define PHASE_END   } if (ph + 1 < ph_hi) GRID_SYNC(); } ++ph;
    int layer = 0;
    PHASE_BEGIN(0) if (COMP(0)) { const Params q = load_params(); prologue(q, lds); } PHASE_END
#pragma unroll 1
    for (layer = 0; layer < 4; ++layer) {
        const bool with_ctx = layer < 3;
        PHASE_BEGIN(1) if (COMP(1)) { { const Params q = load_params(); convert_weights(q, layer, lds, dout); } __syncthreads(); norm_phase(HX, karg_ptr(K_NORMW) + (size_t)layer * 3 * DM, modl, 0, 1, Abuf, (layer > 0 && rep_ == 0) ? (const float*)(big + 200 * MiB) : nullptr, false, layer == 0 ? karg_ptr(K_X) : nullptr, layer == 0 ? karg_ptr(K_CTX) : nullptr); } PHASE_END
        PHASE_BEGIN(2) if (COMP(2)) { EpiSwiglu E{(bf16_t*)big}; run_gemm(lds, Abuf, (const bf16_t*)(dout + W_F1GU), 2 * FF, DM, E); } PHASE_END
        PHASE_BEGIN(3) if (COMP(3)) { EpiResid E{HX, modl, 2, rep_ + 1 < NREP(3) ? 0.f : 0.5f, (float*)(big + 200 * MiB)}; run_gemm(lds, (const bf16_t*)big, (const bf16_t*)(dout + W_F1D), DM, FF, E, true, false); } PHASE_END
        PHASE_BEGIN(1) if (COMP(1)) norm_phase(HX, karg_ptr(K_NORMW) + (size_t)layer * 3 * DM + DM, modl, 3, 4, Abuf, rep_ == 0 ? (const float*)(big + 200 * MiB) : nullptr); PHASE_END
        if (layer == 0) {
            PHASE_BEGIN(4) if (COMP(4)) { EpiGqaIn E{(bf16_t*)big, (bf16_t*)(big + U72), (bf16_t*)(big + U72 + 18 * MiB), (const float*)(ws + WS_ROPEH)}; run_gemm(lds, Abuf, (const bf16_t*)(dout + W_MIN), 1536, DM, E); } PHASE_END
            PHASE_BEGIN(5) if (COMP(5)) attn_phase<0>(big, Abuf, karg_ptr(K_GQASINK), nullptr, lds, true); PHASE_END
        } else if (layer == 1) {
            PHASE_BEGIN(6) if (COMP(6)) { EpiDiffIn E{(bf16_t*)big, (bf16_t*)(big + U72), (bf16_t*)(big + 2 * U72), (const float*)(ws + WS_ROPEH)}; run_gemm(lds, Abuf, (const bf16_t*)(dout + W_MIN), 3072, DM, E); } PHASE_END
            PHASE_BEGIN(7) if (COMP(7)) attn_phase<1>(big, Abuf, karg_ptr(K_DIFFSUB), (const float*)(ws + WS_LAM), lds, true); PHASE_END
        } else if (layer == 2) {
            PHASE_BEGIN(9) if (COMP(9)) { EpiHgrnIn E{(bf16_t*)big, (unsigned short*)(big + U72), (unsigned short*)(big + 2 * U72), (bf16_t*)(big + 3 * U72), (bf16_t*)(big + 4 * U72), (const float*)(ws + WS_LB)};
                          run_gemm(lds, Abuf, (const bf16_t*)(dout + W_MIN), 5120, DM, E); } PHASE_END
            PHASE_BEGIN(10) if (COMP(10)) hgrn_scan(big, (bf16_t*)(ws + WS_END), Abuf, lds); PHASE_END
            PHASE_BEGIN(11) if (COMP(11)) hgrn_combine((const bf16_t*)(ws + WS_END), Abuf, (const bf16_t*)(big + 4 * U72), karg_ptr(K_HGRNNORM), Abuf); PHASE_END
        } else {
            PHASE_BEGIN(12) if (COMP(12)) { EpiF32 E{(float*)big, 768}; run_gemm(lds, Abuf, (const bf16_t*)(dout + W_MIN), 768, DM, E); } PHASE_END
            PHASE_BEGIN(13) if (COMP(13)) mla_rows((const float*)big, karg_ptr(K_MLAQN), karg_ptr(K_MLAKVN), (const float*)(ws + WS_ROPEM), (bf16_t*)(big + 108 * MiB), (bf16_t*)(big + 126 * MiB), (bf16_t*)(big + 2 * U72 + 108 * MiB)); PHASE_END
            PHASE_BEGIN(14) if (COMP(14)) { EpiMlaUq E1{(bf16_t*)(big + 2 * U72), (const float*)(ws + WS_ROPEM)}; run_gemm(lds, (const bf16_t*)(big + 108 * MiB), (const bf16_t*)(dout + W_UQ), 1536, 256, E1);
                          EpiMlaUkv E2{(bf16_t*)(big + 2 * U72 + 108 * MiB), (bf16_t*)big}; run_gemm(lds, (const bf16_t*)(big + 126 * MiB), (const bf16_t*)(dout + W_UKV), 2048, 256, E2); } PHASE_END
            PHASE_BEGIN(15) if (COMP(15)) attn_phase<3>(big, Abuf, karg_ptr(K_GQASINK), nullptr, lds, false); PHASE_END
        }
        PHASE_BEGIN(3) if (COMP(3)) { EpiResid E{HX, modl, 5, rep_ + 1 < NREP(3) ? 0.f : 1.0f, (float*)(big + 200 * MiB)}; run_gemm(lds, Abuf, (const bf16_t*)(dout + W_MOUT), DM, DM, E, true, layer == 3); } PHASE_END
        PHASE_BEGIN(1) if (COMP(1)) norm_phase(HX, karg_ptr(K_NORMW) + (size_t)layer * 3 * DM + 2 * DM, modl, 6, 7, Abuf, (layer < 3 && rep_ == 0) ? (const float*)(big + 200 * MiB) : nullptr, layer == 3); PHASE_END
        PHASE_BEGIN(2) if (COMP(2)) { EpiSwiglu E{(bf16_t*)big}; run_gemm(lds, Abuf, (const bf16_t*)(dout + W_F2GU), 2 * FF, DM, E, false, layer == 3); } PHASE_END
        PHASE_BEGIN(3) if (COMP(3)) { EpiResid E{HX, modl, 8, rep_ + 1 < NREP(3) ? 0.f : 0.5f, (float*)(big + 200 * MiB)}; run_gemm(lds, (const bf16_t*)big, (const bf16_t*)(dout + W_F2D), DM, FF, E, true, layer == 3); } PHASE_END
    }
    layer = 0;
    if (NREP(17) > 1) { for (int i = 0; i < 20; ++i) GRID_SYNC(); }
    PHASE_BEGIN(16) if (COMP(16)) final_phase(HX, karg_ptr(K_FNORMW), (float*)dout); PHASE_END
#undef PHASE_BEGIN
#undef PHASE_END
}

#ifndef MK_MULTI
#define MK_MULTI 0
#endif
constexpr int N_PHASES = 1 + (10 + 10 + 11 + 12) + 1;

extern "C" void kernel_launch(void* const* d_in, const int* in_sizes, int n_in, void* d_out, int out_size, void* d_ws, size_t ws_size, hipStream_t stream) {
    static int grid = 0;
    if (grid == 0) {
        if (n_in != 28 || ws_size < WS_END + U72 || out_size != NB * SQ * DM) { fprintf(stderr, "kernel_launch: unexpected sizes n_in %d out %d ws %zu\n", n_in, out_size, ws_size); grid = -1; return; }
        int dev = 0, cus = 0, per_cu = 0;
        hipGetDevice(&dev); hipDeviceGetAttribute(&cus, hipDeviceAttributeMultiprocessorCount, dev);
        if (hipFuncSetAttribute((const void*)fwd_megakernel, hipFuncAttributeMaxDynamicSharedMemorySize, LDS_BYTES) != hipSuccess) { fprintf(stderr, "kernel_launch: hipFuncSetAttribute failed\n"); grid = -1; return; }
        if (hipOccupancyMaxActiveBlocksPerMultiprocessor(&per_cu, (const void*)fwd_megakernel, NTHR, LDS_BYTES) != hipSuccess || per_cu < 1) { fprintf(stderr, "kernel_launch: occupancy query says %d\n", per_cu); per_cu = 1; }
        (void)hipGetLastError();
        grid = cus * (per_cu > 1 ? 1 : per_cu);
        if (grid != GRID) { fprintf(stderr, "kernel_launch: this kernel is built for a %d-workgroup cooperative grid (one per CU), device offers %d\n", GRID, grid); grid = -1; return; }
    }
    if (grid < 0) return;
    if (hipMemsetAsync((char*)d_ws + WS_BAR, 0, XCD_BAR_WORDS * 4, stream) != hipSuccess) { fprintf(stderr, "kernel_launch: memset failed\n"); return; }
    Params p{};
    const float** pp = (const float**)&p;
    for (int i = 0; i < 28; ++i) pp[i] = (const float*)d_in[i];
    p.out = (float*)d_out; p.ws = (unsigned char*)d_ws;
#if MK_MULTI
    for (int ph = 0; ph < N_PHASES; ++ph) { p.ph_lo = ph; p.ph_hi = ph + 1; hipLaunchKernelGGL(fwd_megakernel, dim3(grid), dim3(NTHR), LDS_BYTES, stream, p); }
#else
    p.ph_lo = 0; p.ph_hi = N_PHASES;
    void* args[] = {&p};
    hipError_t e = hipLaunchCooperativeKernel((const void*)fwd_megakernel, dim3(grid), dim3(NTHR), args, LDS_BYTES, stream);
    if (e != hipSuccess) fprintf(stderr, "cooperative launch failed: %s (grid %d)\n", hipGetErrorString(e), grid);
#endif
}
```

```cpp
#include <hip/hip_runtime.h>
#include <hip/hip_cooperative_groups.h>
#include <cstdio>
#include <cstdint>
namespace cg = cooperative_groups;
namespace pg8 {
#define PG8_LAS __attribute__((address_space(3)))
typedef unsigned short bf16_t;
typedef short bf16x8 __attribute__((ext_vector_type(8)));
typedef float f32x4 __attribute__((ext_vector_type(4)));
typedef unsigned u32x4 __attribute__((ext_vector_type(4)));
constexpr int BM = 256, BK = 64, HALF = 128, HTB = HALF * BK * 2  , STAGE_BYTES = 8 * HTB, NXCD = 8, WGM = 8;

__host__ __device__ __forceinline__ int lds_byte(int r, int c) { const int st = (r >> 4) * 2 + (c >> 5), rr = r & 15, cc = c & 31, ob = rr * 64 + cc * 2; return st * 1024 + (ob ^ (((ob >> 9) & 1) << 5)); }
__host__ __device__ __forceinline__ void stage_rc(int b, int& R, int& C) { const int st = b / 1024, sb = b % 1024, swz = sb ^ (((sb >> 9) & 1) << 5); R = (st >> 1) * 16 + swz / 64; C = (st & 1) * 32 + (swz % 64) / 2; }
__host__ __device__ __forceinline__ int perm32(int rho) { const int n = rho >> 4, i = rho & 15; return 8 * (i >> 2) + 4 * n + (i & 3); }

struct Unit { int pm, pn, k0, nk, part; };
struct Gemm { const bf16_t* A; const bf16_t* Bt; int M, N, K; };

struct StaticOrder {
    int nN, nwg, G, c, nt, nfull, S, nMf; bool lat;
    __host__ __device__ void init(int M, int N, int G_, int c_, int nt_, bool split, bool lat_) {
        const int nM = M / BM; nN = N / BM; nwg = nM * nN; G = G_; c = c_; nt = nt_; lat = lat_; nfull = nwg; S = 1;
        if (split) { const int rem = nwg % G; if (rem > 0 && rem * 2 <= G && ((nwg - rem) % nN) == 0) { S = G / rem; if (S > 4) S = 4; if (S > nt / 2) S = nt / 2; nfull = nwg - rem; } }
        nMf = nfull / nN;
    }
    __host__ __device__ bool next(int i, Unit& u) const {
        const long L = (long)i * G + c;
        int pm, pn, k0 = 0, nk = nt, part = -1; bool ok = true;
        if (L < nfull) {
            int wgid = (int)L;
            { const int q = nfull / NXCD, r = nfull % NXCD, xcd = wgid % NXCD, off = wgid / NXCD; wgid = (xcd < r ? xcd * (q + 1) : r * (q + 1) + (xcd - r) * q) + off; }
            const int nig = WGM * nN, gid = wgid / nig, fm = gid * WGM, gsz = (nMf - fm) < WGM ? (nMf - fm) : WGM;
            pm = fm + ((wgid % nig) % gsz); pn = (wgid % nig) / gsz;
        } else {
            const long q = L - nfull; const int t = (int)(q / S); part = (int)(q % S); ok = (nfull + t < nwg);
            pm = nMf + t / nN; pn = t % nN;
            const int pairs = nt / 2, base = pairs / S, extra = pairs % S; const int p0 = part * base + (part < extra ? part : extra), np = base + (part < extra ? 1 : 0); k0 = 2 * p0; nk = 2 * np;
        }
        if (lat) pm = (pm >> 3) * 9 + 1 + (pm & 7);
        u.pm = pm; u.pn = pn; u.k0 = k0; u.nk = nk; u.part = part;
        return ok;
    }
    __device__ __forceinline__ void a_ready(const Unit&) const {}
    __device__ __forceinline__ void done(const Unit&) const {}
};
template <class Epi, class Sched, bool ALIGN_EPI = false, bool SP2 = false>
__device__ __forceinline__ void gemm_phase(PG8_LAS unsigned char* lds, const Gemm g, const Sched& S, const Epi& E) {
    int tid_ = threadIdx.x; asm volatile("" : "+v"(tid_));
    const int tid = tid_, wid = __builtin_amdgcn_readfirstlane(tid >> 6), lane = tid & 63, wr = wid >> 2, wc = wid & 3, fr = lane & 15, fq = lane >> 4;
    const int K = g.K;
    unsigned voffA[2], voffB[2];
#pragma unroll
    for (int i = 0; i < 2; ++i) { int R, C; stage_rc(tid * 16 + i * 8192, R, C); const int Rb = Epi::PERM ? ((R & ~31) + perm32(R & 31)) : R;
        voffA[i] = (unsigned)(R * K + C) * 2u; voffB[i] = (unsigned)(Rb * K + C) * 2u; }
    const size_t kstep = (size_t)(BK * 2);
    const size_t hstep = (size_t)HALF * K * 2;
    const size_t tstep = 2 * hstep;
    const unsigned ldsw = (unsigned)wid * 1024u;
    const int aoff = lds_byte(wr * 64 + fr, fq * 8), boff = lds_byte(wc * 32 + fr, fq * 8);
#define PG8_SA(b, h) (((b) * 2 + (h)) * HTB)
#define PG8_SB(b, h) ((4 + (b) * 2 + (h)) * HTB)
#define PG8_STAGE(bufoff, gbase, voff) do { _Pragma("unroll") for (int _i = 0; _i < 2; ++_i) \
        __builtin_amdgcn_global_load_lds((const unsigned*)((const char*)(gbase) + (voff)[_i]), (PG8_LAS unsigned*)(lds + (bufoff) + ldsw + _i * 8192), 16, 0, 0); } while (0)
#define PG8_LDA(dst, b, h) do { _Pragma("unroll") for (int m = 0; m < 4; ++m) _Pragma("unroll") for (int k = 0; k < 2; ++k) dst[m][k] = *(const PG8_LAS bf16x8*)(lds + PG8_SA(b, h) + aoff + m * 2048 + k * 1024); } while (0)
#define PG8_LDB(dst, b, h) do { _Pragma("unroll") for (int n = 0; n < 2; ++n) _Pragma("unroll") for (int k = 0; k < 2; ++k) dst[n][k] = *(const PG8_LAS bf16x8*)(lds + PG8_SB(b, h) + boff + n * 2048 + k * 1024); } while (0)
#define PG8_MMA(ai, bj, At, Bt) do { __builtin_amdgcn_s_setprio(1); _Pragma("unroll") for (int m = 0; m < 4; ++m) _Pragma("unroll") for (int n = 0; n < 2; ++n) _Pragma("unroll") for (int k = 0; k < 2; ++k) \
        acc[ai][bj][m][n] = __builtin_amdgcn_mfma_f32_16x16x32_bf16(Bt[n][k], At[m][k], acc[ai][bj][m][n], 0, 0, 0); __builtin_amdgcn_s_setprio(0); } while (0)
#define PG8_WAIT_V(n) asm volatile("s_waitcnt vmcnt(" #n ")" ::: "memory")
#define PG8_WAIT_L(n) asm volatile("s_waitcnt lgkmcnt(" #n ")" ::: "memory")
#define PG8_BAR __builtin_amdgcn_s_barrier()
#define PG8_SCHED __builtin_amdgcn_sched_barrier(0)
    Unit cur, nxt; int ui = 0;
    if (!S.next(0, cur)) return;
    f32x4 acc[2][2][4][2];
#pragma unroll
    for (int a = 0; a < 2; ++a)
#pragma unroll
        for (int b = 0; b < 2; ++b)
#pragma unroll
            for (int m = 0; m < 4; ++m)
#pragma unroll
                for (int n = 0; n < 2; ++n) acc[a][b][m][n] = (f32x4){0.f, 0.f, 0.f, 0.f};
    bf16x8 At[4][2], B0[2][2], B1[2][2];
    const char* cA = (const char*)g.A + (size_t)cur.pm * tstep + (size_t)cur.k0 * kstep; const char* cB = (const char*)g.Bt + (size_t)cur.pn * tstep + (size_t)cur.k0 * kstep;
    S.a_ready(cur);
    if constexpr (SP2) {
        PG8_STAGE(PG8_SB(0, 0), cB, voffB); PG8_STAGE(PG8_SB(0, 1), cB + hstep, voffB); PG8_STAGE(PG8_SA(0, 0), cA, voffA); PG8_STAGE(PG8_SA(0, 1), cA + hstep, voffA);
        if (wr == 1) PG8_BAR;
        PG8_WAIT_V(2); PG8_BAR;
        PG8_STAGE(PG8_SB(1, 0), cB + kstep, voffB); PG8_STAGE(PG8_SA(1, 0), cA + kstep, voffA); PG8_STAGE(PG8_SB(1, 1), cB + hstep + kstep, voffB);
        PG8_WAIT_V(6); PG8_BAR;
    } else {
        PG8_STAGE(PG8_SB(0, 0), cB, voffB); PG8_STAGE(PG8_SA(0, 0), cA, voffA); PG8_STAGE(PG8_SB(0, 1), cB + hstep, voffB); PG8_STAGE(PG8_SA(0, 1), cA + hstep, voffA);
        if (wr == 1) PG8_BAR;
        PG8_WAIT_V(4); PG8_BAR;
        PG8_STAGE(PG8_SB(1, 0), cB + kstep, voffB); PG8_STAGE(PG8_SA(1, 0), cA + kstep, voffA); PG8_STAGE(PG8_SB(1, 1), cB + hstep + kstep, voffB);
        PG8_WAIT_V(6); PG8_BAR;
    }
    for (;;) {
        const bool has_next = S.next(ui + 1, nxt);
        const char* nA = has_next ? (const char*)g.A + (size_t)nxt.pm * tstep + (size_t)nxt.k0 * kstep : cA; const char* nB = has_next ? (const char*)g.Bt + (size_t)nxt.pn * tstep + (size_t)nxt.k0 * kstep : cB;
        const int nt = cur.nk;
#pragma unroll 1
        for (int t = 0; t < nt; t += 2) {
            const bool last = (t == nt - 2);
            const char* a1 = cA + (size_t)(t + 1) * kstep;
            const char* a2 = last ? nA : cA + (size_t)(t + 2) * kstep; const char* b2 = last ? nB : cB + (size_t)(t + 2) * kstep;
            const char* a3 = a2 + kstep; const char* b3 = b2 + kstep;
            if (last && has_next) S.a_ready(nxt);
            if constexpr (SP2) {
            PG8_LDB(B0, 0, 0); PG8_LDB(B1, 0, 1); PG8_SCHED; PG8_LDA(At, 0, 0); PG8_STAGE(PG8_SA(1, 1), a1 + hstep, voffA);
            PG8_WAIT_V(8); PG8_WAIT_L(0); PG8_BAR; PG8_MMA(0, 0, At, B0); PG8_MMA(0, 1, At, B1); PG8_BAR; PG8_SCHED;
            PG8_LDA(At, 0, 1); PG8_STAGE(PG8_SB(0, 0), b2, voffB); PG8_STAGE(PG8_SB(0, 1), b2 + hstep, voffB); PG8_STAGE(PG8_SA(0, 0), a2, voffA);
            PG8_WAIT_V(8); PG8_WAIT_L(0); PG8_BAR; PG8_MMA(1, 0, At, B0); PG8_MMA(1, 1, At, B1); PG8_BAR; PG8_SCHED;
            PG8_LDB(B0, 1, 0); PG8_LDB(B1, 1, 1); PG8_SCHED; PG8_LDA(At, 1, 0); PG8_STAGE(PG8_SA(0, 1), a2 + hstep, voffA);
            PG8_WAIT_V(8); PG8_WAIT_L(0); PG8_BAR; PG8_MMA(0, 0, At, B0); PG8_MMA(0, 1, At, B1); PG8_BAR; PG8_SCHED;
            PG8_LDA(At, 1, 1); PG8_STAGE(PG8_SB(1, 0), b3, voffB); PG8_STAGE(PG8_SB(1, 1), b3 + hstep, voffB); PG8_STAGE(PG8_SA(1, 0), a3, voffA);
            PG8_WAIT_V(8); PG8_WAIT_L(0); PG8_BAR; PG8_MMA(1, 0, At, B0); PG8_MMA(1, 1, At, B1); PG8_BAR; PG8_SCHED;
            } else {
            PG8_LDB(B0, 0, 0); PG8_SCHED; PG8_LDA(At, 0, 0); PG8_STAGE(PG8_SA(1, 1), a1 + hstep, voffA);
            PG8_WAIT_L(8); PG8_BAR; PG8_WAIT_L(0); PG8_MMA(0, 0, At, B0); PG8_BAR; PG8_SCHED;
            PG8_LDB(B1, 0, 1); PG8_STAGE(PG8_SB(0, 0), b2, voffB);
            PG8_BAR; PG8_WAIT_L(0); PG8_MMA(0, 1, At, B1); PG8_BAR;
            PG8_LDA(At, 0, 1); PG8_STAGE(PG8_SA(0, 0), a2, voffA);
            PG8_BAR; PG8_WAIT_L(0); PG8_MMA(1, 0, At, B0); PG8_BAR; PG8_SCHED;
            PG8_STAGE(PG8_SB(0, 1), b2 + hstep, voffB);
            PG8_WAIT_V(6); PG8_BAR; PG8_MMA(1, 1, At, B1); PG8_BAR;
            PG8_LDB(B0, 1, 0); PG8_SCHED; PG8_LDA(At, 1, 0); PG8_STAGE(PG8_SA(0, 1), a2 + hstep, voffA);
            PG8_WAIT_L(8); PG8_BAR; PG8_WAIT_L(0); PG8_MMA(0, 0, At, B0); PG8_BAR; PG8_SCHED;
            PG8_LDB(B1, 1, 1); PG8_STAGE(PG8_SB(1, 0), b3, voffB);
            PG8_BAR; PG8_WAIT_L(0); PG8_MMA(0, 1, At, B1); PG8_BAR;
            PG8_LDA(At, 1, 1); PG8_STAGE(PG8_SA(1, 0), a3, voffA);
            PG8_BAR; PG8_WAIT_L(0); PG8_MMA(1, 0, At, B0); PG8_BAR; PG8_SCHED;
            PG8_STAGE(PG8_SB(1, 1), b3 + hstep, voffB);
            PG8_WAIT_V(6); PG8_BAR; PG8_MMA(1, 1, At, B1); PG8_BAR;
            }
        }
        if constexpr (ALIGN_EPI) { if (wr == 0) PG8_BAR; }
        if constexpr (!Epi::AFTER_DRAIN) { E(acc, cur, wr, wc, fr, fq); S.done(cur); }
        if (!has_next) break;
#pragma unroll
        for (int a = 0; a < 2; ++a)
#pragma unroll
            for (int b = 0; b < 2; ++b)
#pragma unroll
                for (int m = 0; m < 4; ++m)
#pragma unroll
                    for (int n = 0; n < 2; ++n) acc[a][b][m][n] = (f32x4){0.f, 0.f, 0.f, 0.f};
        cur = nxt; cA = nA; cB = nB; ++ui;
        if constexpr (ALIGN_EPI) { if (wr == 1) PG8_BAR; }
    }
    PG8_WAIT_V(0);
    if constexpr (!ALIGN_EPI) { if (wr == 0) PG8_BAR; }
    PG8_BAR;
    if constexpr (Epi::AFTER_DRAIN) { E.fused(acc, cur, wr, wc, fr, fq, lds, wid, lane); S.done(cur); }
#undef PG8_SA
#undef PG8_SB
#undef PG8_STAGE
#undef PG8_LDA
#undef PG8_LDB
#undef PG8_MMA
#undef PG8_WAIT_V
#undef PG8_WAIT_L
#undef PG8_BAR
#undef PG8_SCHED
}
}

#define LAS __attribute__((address_space(3)))
#define GAS __attribute__((address_space(1)))
using pg8::bf16_t; using pg8::bf16x8; using pg8::f32x4; using pg8::u32x4;
typedef float f32x16 __attribute__((ext_vector_type(16)));
typedef unsigned u32x2 __attribute__((ext_vector_type(2)));
typedef float f32x2v __attribute__((ext_vector_type(2)));
typedef __bf16 bf16x2v __attribute__((ext_vector_type(2)));

constexpr int NB = 16, SQ = 2048, CL = 256, TB = SQ + CL, TT = NB * TB, DM = 1024, FF = 2816, NMODV = 9216;
constexpr int NTHR = 512, GRID = 256;
constexpr size_t MiB = (size_t)1 << 20;
constexpr size_t U72 = 72 * MiB;
constexpr size_t WS_MOD = 0;
constexpr size_t WS_ROPEH = 3 * MiB;
constexpr size_t WS_ROPEM = 3 * MiB + 512 * 1024;
constexpr size_t WS_LB = 3 * MiB + 768 * 1024;
constexpr size_t WS_LAM = WS_LB + 4096;
constexpr size_t WS_BAR = 4 * MiB - 64 * 1024;
constexpr size_t WS_HX = 4 * MiB;
constexpr size_t WS_BIG = 148 * MiB;
constexpr size_t WS_END = 508 * MiB;
constexpr size_t DO_A = 0;
constexpr size_t DO_W = 72 * MiB;
constexpr size_t W_F1GU = DO_W, W_F1D = DO_W + 11 * MiB, W_F2GU = DO_W + 33 * MiB / 2, W_F2D = DO_W + 55 * MiB / 2;
constexpr size_t W_MIN = DO_W + 33 * MiB, W_MOUT = DO_W + 43 * MiB, W_UQ = DO_W + 45 * MiB, W_UKV = DO_W + 46 * MiB;
constexpr int LDS_BYTES = 147456;
constexpr float LOG2E = 1.4426950408889634f;

struct Params {
    const float *x, *c, *ctx, *c_ctx, *ada_w, *ada_b, *norm_w, *final_norm_w, *ffn_g, *ffn_u, *ffn_d,
        *gqa_in, *gqa_out, *gqa_sinks, *diff_in, *diff_out, *diff_lambda, *diff_subln,
        *hgrn_in, *hgrn_out, *hgrn_norm, *hgrn_lb, *mla_down, *mla_qn, *mla_kvn, *mla_uq, *mla_ukv, *mla_out;
    float* out; unsigned char* ws; int ph_lo, ph_hi;
};

__device__ __forceinline__ int fresh_bid() { int t = blockIdx.x; asm volatile("" : "+s"(t)); return t; }
__device__ __forceinline__ int fresh_gdim() { int t = gridDim.x; asm volatile("" : "+s"(t)); return t; }
__device__ __forceinline__ int fresh_tid() { int t = threadIdx.x; asm volatile("" : "+v"(t)); return t; }
__device__ __forceinline__ unsigned pk2(float lo, float hi) { f32x2v v = {lo, hi}; bf16x2v b = __builtin_convertvector(v, bf16x2v); return __builtin_bit_cast(unsigned, b); }
__device__ __forceinline__ unsigned short f2bf(float f) { return (unsigned short)(pk2(f, 0.f) & 0xffffu); }
__device__ __forceinline__ float bf2f(unsigned short u) { return __uint_as_float((unsigned)u << 16); }
__device__ __forceinline__ float bflo(unsigned w) { return __uint_as_float(w << 16); }
__device__ __forceinline__ float bfhi(unsigned w) { return __uint_as_float(w & 0xffff0000u); }
__device__ __forceinline__ unsigned short f2h(float f) { _Float16 h = (_Float16)f; return __builtin_bit_cast(unsigned short, h); }
__device__ __forceinline__ float h2f(unsigned short u) { return (float)__builtin_bit_cast(_Float16, u); }
__device__ __forceinline__ float silu_f(float v) { return v * __builtin_amdgcn_rcpf(1.f + __expf(-v)); }
__device__ __forceinline__ float wave_sum(float v) {
#pragma unroll
    for (int o = 1; o < 64; o <<= 1) v += __shfl_xor(v, o);
    return v;
}
__device__ __forceinline__ int crow(int r, int hi) { return (r & 3) + 8 * (r >> 2) + 4 * hi; }
__device__ __forceinline__ void store4bf(bf16_t* p, f32x4 v) { u32x2 w; w.x = pk2(v[0], v[1]); w.y = pk2(v[2], v[3]); *(GAS u32x2*)p = w; }
__device__ __forceinline__ f32x4 ldg4(const float* p) { return *(const GAS f32x4*)p; }
__device__ __forceinline__ void stg4(float* p, f32x4 v) { *(GAS f32x4*)p = v; }

template <class F> __device__ __forceinline__ void epi_loop(const f32x4 (&acc)[2][2][4][2], const pg8::Unit& u, int wr, int wc, int fr, int fq, const F& f) {
#pragma unroll
    for (int ai = 0; ai < 2; ++ai)
#pragma unroll
        for (int m = 0; m < 4; ++m) {
            const int row = u.pm * 256 + ai * 128 + wr * 64 + m * 16 + fr;
#pragma unroll
            for (int bj = 0; bj < 2; ++bj) f.item(row, u.pn * 256 + bj * 128 + wc * 32 + 4 * fq, acc[ai][bj][m][0], acc[ai][bj][m][1]);
        }
}
struct EpiSwiglu {
    static constexpr bool PERM = true, AFTER_DRAIN = false;
    bf16_t* H;
    __device__ __forceinline__ void operator()(const f32x4 (&acc)[2][2][4][2], const pg8::Unit& u, int wr, int wc, int fr, int fq) const {
        const int row0 = u.pm * 256 + wr * 64 + fr, col0 = u.pn * 128 + wc * 32 + 8 * fq;
#pragma unroll
        for (int ai = 0; ai < 2; ++ai)
#pragma unroll
            for (int m = 0; m < 4; ++m) {
                bf16_t* rp = H + (size_t)(row0 + ai * 128 + m * 16) * FF + col0;
                const f32x4 g0 = acc[ai][0][m][0], g1 = acc[ai][0][m][1], u0 = acc[ai][1][m][0], u1 = acc[ai][1][m][1];
                u32x4 w;
                w.x = pk2(silu_f(g0[0]) * u0[0], silu_f(g0[1]) * u0[1]); w.y = pk2(silu_f(g0[2]) * u0[2], silu_f(g0[3]) * u0[3]);
                w.z = pk2(silu_f(g1[0]) * u1[0], silu_f(g1[1]) * u1[1]); w.w = pk2(silu_f(g1[2]) * u1[2], silu_f(g1[3]) * u1[3]);
                *(GAS u32x4*)rp = w;
                asm volatile("" ::: "memory");
            }
    }
};
constexpr int SPLIT_PM0 = 128, SPLIT_ROWS = 4096;
struct EpiResid {
    static constexpr bool PERM = false, AFTER_DRAIN = false;
    float* HX; const float* modl; int midx; float coef; float* P;
    __device__ __forceinline__ void operator()(const f32x4 (&acc)[2][2][4][2], const pg8::Unit& u, int wr, int wc, int fr, int fq) const {
        const int bi = u.pm / 9, mr = (u.pm - bi * 9) == 0 ? 16 : bi;
        const int col0 = u.pn * 256 + wc * 32 + 4 * fq;
        const float* g = modl + (size_t)mr * NMODV + midx * 1024 + col0;
        f32x4 gv[2][2];
#pragma unroll
        for (int bj = 0; bj < 2; ++bj)
#pragma unroll
            for (int n = 0; n < 2; ++n) gv[bj][n] = coef * ldg4(g + bj * 128 + n * 16);
        if (u.part < 0) {
#pragma unroll
            for (int ai = 0; ai < 2; ++ai)
#pragma unroll
                for (int m = 0; m < 4; ++m) {
                    float* hp = HX + (size_t)(u.pm * 256 + ai * 128 + wr * 64 + m * 16 + fr) * DM + col0;
#pragma unroll
                    for (int bj = 0; bj < 2; ++bj)
#pragma unroll
                        for (int n = 0; n < 2; ++n) { float* h = hp + bj * 128 + n * 16; stg4(h, ldg4(h) + gv[bj][n] * acc[ai][bj][m][n]); }
                }
        } else {
#pragma unroll
            for (int ai = 0; ai < 2; ++ai)
#pragma unroll
                for (int m = 0; m < 4; ++m) {
                    bf16_t* hp = (bf16_t*)P + ((size_t)u.part * SPLIT_ROWS + (size_t)((u.pm - SPLIT_PM0) * 256 + ai * 128 + wr * 64 + m * 16 + fr)) * DM + col0;
#pragma unroll
                    for (int bj = 0; bj < 2; ++bj)
#pragma unroll
                        for (int n = 0; n < 2; ++n) store4bf(hp + bj * 128 + n * 16, gv[bj][n] * acc[ai][bj][m][n]);
                    if (m & 1) asm volatile("" ::: "memory");
                }
        }
    }
};
__device__ __forceinline__ void rope64(f32x4& a, f32x4& b, const float* tab, int s, int col) {
    const int half = (col >> 5) & 1, i0 = col & 31;
    const GAS f32x4* tp = (const GAS f32x4*)(tab + ((size_t)s * 32 + half * 16 + i0) * 2);
    const f32x4 t0 = tp[0], t1 = tp[1];
    f32x4 na, nb;
    na[0] = a[0] * t0[0] - b[0] * t0[1]; nb[0] = b[0] * t0[0] + a[0] * t0[1];
    na[1] = a[1] * t0[2] - b[1] * t0[3]; nb[1] = b[1] * t0[2] + a[1] * t0[3];
    na[2] = a[2] * t1[0] - b[2] * t1[1]; nb[2] = b[2] * t1[0] + a[2] * t1[1];
    na[3] = a[3] * t1[2] - b[3] * t1[3]; nb[3] = b[3] * t1[2] + a[3] * t1[3];
    a = na; b = nb;
}
__device__ __forceinline__ void store_vt(bf16_t* vt, const f32x4& a, const f32x4& b) {
#pragma unroll
    for (int j = 0; j < 4; ++j) ((GAS bf16_t*)vt)[(size_t)j * TB] = f2bf(a[j]);
    asm volatile("" ::: "memory");
    GAS bf16_t* v2 = (GAS bf16_t*)vt + (size_t)16 * TB;
#pragma unroll
    for (int j = 0; j < 4; ++j) v2[(size_t)j * TB] = f2bf(b[j]);
    asm volatile("" ::: "memory");
}
struct EpiGqaIn {
    static constexpr bool PERM = false, AFTER_DRAIN = false;
    bf16_t *Q, *K, *Vt; const float* ropeH;
    __device__ __forceinline__ void item(int row, int col, const f32x4& a_, const f32x4& b_) const {
        f32x4 a = a_, b = b_; const int bi = row / TB, t = row - bi * TB;
        if (col < 1280) {
            if (t >= CL) rope64(a, b, ropeH, t - CL, col);
            if (col < 1024) { const float c2 = 0.125f * LOG2E; a = a * c2; b = b * c2; bf16_t* q = Q + (size_t)row * 1024 + col; store4bf(q, a); store4bf(q + 16, b); }
            else { bf16_t* k = K + (size_t)row * 256 + (col - 1024); store4bf(k, a); store4bf(k + 16, b); }
        } else { const int cv = col - 1280, head = cv >> 6, dv = cv & 63; store_vt(Vt + ((size_t)(bi * 4 + head) * 64 + dv) * TB + t, a, b); }
    }
    __device__ __forceinline__ void operator()(const f32x4 (&acc)[2][2][4][2], const pg8::Unit& u, int wr, int wc, int fr, int fq) const { epi_loop(acc, u, wr, wc, fr, fq, *this); }
};
struct EpiDiffIn {
    static constexpr bool PERM = false, AFTER_DRAIN = false;
    bf16_t *Q, *K, *Vt; const float* ropeH;
    __device__ __forceinline__ void item(int row, int col, const f32x4& a_, const f32x4& b_) const {
        f32x4 a = a_, b = b_; const int bi = row / TB, t = row - bi * TB;
        if (col < 2048) {
            if (t >= CL) rope64(a, b, ropeH, t - CL, col);
            if (col < 1024) { const float c2 = 0.125f * LOG2E; a = a * c2; b = b * c2; bf16_t* q = Q + (size_t)row * 1024 + col; store4bf(q, a); store4bf(q + 16, b); }
            else { bf16_t* k = K + (size_t)row * 1024 + (col - 1024); store4bf(k, a); store4bf(k + 16, b); }
        } else { const int cv = col - 2048, head = cv >> 7, dv = cv & 127; store_vt(Vt + ((size_t)(bi * 8 + head) * 128 + dv) * TB + t, a, b); }
    }
    __device__ __forceinline__ void operator()(const f32x4 (&acc)[2][2][4][2], const pg8::Unit& u, int wr, int wc, int fr, int fq) const { epi_loop(acc, u, wr, wc, fr, fq, *this); }
};
struct EpiHgrnIn {
    static constexpr bool PERM = false, AFTER_DRAIN = false;
    bf16_t* Qh; unsigned short *LF, *LB; bf16_t *V, *Gt; const float* lb;
    __device__ __forceinline__ void item(int row, int col, const f32x4& a, const f32x4& b) const {
        const int sec = col >> 10, cc = col & 1023; const size_t o = (size_t)row * 1024 + cc;
        if (sec == 0 || sec == 4) { f32x4 x, y;
#pragma unroll
            for (int j = 0; j < 4; ++j) { x[j] = silu_f(a[j]); y[j] = silu_f(b[j]); }
            bf16_t* d = (sec == 0 ? Qh : Gt) + o; store4bf(d, x); store4bf(d + 16, y);
        } else if (sec == 3) { store4bf(V + o, a); store4bf(V + o + 16, b); }
        else { unsigned short* d = (sec == 1 ? LF : LB) + o; const f32x4 la = ldg4(lb + cc), lbb = ldg4(lb + cc + 16);
            unsigned short ha[4], hb[4];
#pragma unroll
            for (int j = 0; j < 4; ++j) { const float fa = la[j] + (1.f - la[j]) * __builtin_amdgcn_rcpf(1.f + __expf(-a[j])), fb = lbb[j] + (1.f - lbb[j]) * __builtin_amdgcn_rcpf(1.f + __expf(-b[j]));
                ha[j] = f2h(__builtin_amdgcn_logf(fa) * 0.6931471805599453f); hb[j] = f2h(__builtin_amdgcn_logf(fb) * 0.6931471805599453f); }
            u32x2 w; w.x = ha[0] | ((unsigned)ha[1] << 16); w.y = ha[2] | ((unsigned)ha[3] << 16); *(GAS u32x2*)d = w;
            w.x = hb[0] | ((unsigned)hb[1] << 16); w.y = hb[2] | ((unsigned)hb[3] << 16); *(GAS u32x2*)(d + 16) = w; }
    }
    __device__ __forceinline__ void operator()(const f32x4 (&acc)[2][2][4][2], const pg8::Unit& u, int wr, int wc, int fr, int fq) const { epi_loop(acc, u, wr, wc, fr, fq, *this); }
};
struct EpiF32 {
    static constexpr bool PERM = false, AFTER_DRAIN = false;
    float* O; int ld;
    __device__ __forceinline__ void item(int row, int col, const f32x4& a, const f32x4& b) const { float* d = O + (size_t)row * ld + col; stg4(d, a); stg4(d + 16, b); }
    __device__ __forceinline__ void operator()(const f32x4 (&acc)[2][2][4][2], const pg8::Unit& u, int wr, int wc, int fr, int fq) const { epi_loop(acc, u, wr, wc, fr, fq, *this); }
};
struct EpiMlaUq {
    static constexpr bool PERM = false, AFTER_DRAIN = false;
    bf16_t* Q; const float* ropeM;
    __device__ __forceinline__ void half(f32x4& a, const float* tp, bool first) const {
        const f32x4 t0 = ldg4(tp), t1 = ldg4(tp + 4);
        f32x4 pa;
#pragma unroll
        for (int j = 0; j < 4; ++j) { pa[j] = __shfl_xor(a[j], 32); if (first) pa[j] = -pa[j]; }
        a[0] = a[0] * t0[0] + pa[0] * t0[1]; a[1] = a[1] * t0[2] + pa[1] * t0[3]; a[2] = a[2] * t1[0] + pa[2] * t1[1]; a[3] = a[3] * t1[2] + pa[3] * t1[3];
    }
    __device__ __forceinline__ void item(int row, int col, const f32x4& a_, const f32x4& b_) const {
        f32x4 a = a_, b = b_; const int bi = row / TB, t = row - bi * TB; const int g32 = col >> 5;
        const float c2 = 0.10206207261596577f * LOG2E;
        bf16_t* q = Q + (size_t)row * 1536 + col;
        const bool rot = (g32 % 3) == 2 && t >= CL;
        const int fq = (col & 15) >> 2; const bool first = fq < 2; const int i0 = 4 * (fq & 1);
        const float* tp = ropeM + ((size_t)(rot ? t - CL : 0) * 16 + i0) * 2;
        if (rot) half(a, tp, first);
        a = a * c2; store4bf(q, a);
        asm volatile("" ::: "memory");
        if (rot) half(b, tp + 16, first);
        b = b * c2; store4bf(q + 16, b);
        asm volatile("" ::: "memory");
    }
    __device__ __forceinline__ void operator()(const f32x4 (&acc)[2][2][4][2], const pg8::Unit& u, int wr, int wc, int fr, int fq) const { epi_loop(acc, u, wr, wc, fr, fq, *this); }
};
struct EpiMlaUkv {
    static constexpr bool PERM = false, AFTER_DRAIN = false;
    bf16_t *K, *Vt;
    __device__ __forceinline__ void item(int row, int col, const f32x4& a, const f32x4& b) const {
        const int bi = row / TB, t = row - bi * TB; const int head = col >> 7, x = col & 127;
        if (x < 64) { bf16_t* k = K + (size_t)row * 1536 + head * 96 + x; store4bf(k, a); store4bf(k + 16, b); }
        else store_vt(Vt + ((size_t)(bi * 16 + head) * 64 + (x - 64)) * TB + t, a, b);
    }
    __device__ __forceinline__ void operator()(const f32x4 (&acc)[2][2][4][2], const pg8::Unit& u, int wr, int wc, int fr, int fq) const { epi_loop(acc, u, wr, wc, fr, fq, *this); }
};

template <class Epi> __device__ __forceinline__ void run_gemm(LAS unsigned char* lds, const bf16_t* A, const bf16_t* Bt, int N, int K, const Epi& E, bool split = false, bool lat = false) {
    pg8::Gemm g{A, Bt, lat ? NB * SQ : TT, N, K}; pg8::StaticOrder S; S.init(lat ? NB * SQ : TT, N, GRID, fresh_bid(), K / 64, split, lat);
    pg8::gemm_phase<Epi, pg8::StaticOrder, true, true>(lds, g, S, E);
}

__device__ __forceinline__ void transpose_item(const float* W, int K, int N, bf16_t* WT, int mode, LAS float* scr, int item, int lane) {
    const int nblk = N / 32, kb = item / nblk, nb = item - kb * nblk, k0 = 64 * kb, n0 = 32 * nb;
    float wv[32];
#pragma unroll
    for (int i = 0; i < 32; ++i) { const int kk = 2 * i + (lane >> 5); wv[i] = *(const GAS float*)(W + (size_t)(k0 + kk) * N + n0 + (lane & 31)); }
#pragma unroll
    for (int i = 0; i < 32; ++i) { const int kk = 2 * i + (lane >> 5); scr[kk * 33 + (lane & 31)] = wv[i]; }
    asm volatile("s_waitcnt lgkmcnt(0)" ::: "memory");
    const int drow0 = mode == 0 ? n0 : (n0 >> 7) * 256 + (n0 & 127) + (mode == 2 ? 128 : 0);
    const int c = lane & 7;
#pragma unroll
    for (int j = 0; j < 4; ++j) { const int n = (lane >> 3) + 8 * j; const LAS float* s = scr + (8 * c) * 33 + n;
        u32x4 o; o.x = pk2(s[0 * 33], s[1 * 33]); o.y = pk2(s[2 * 33], s[3 * 33]); o.z = pk2(s[4 * 33], s[5 * 33]); o.w = pk2(s[6 * 33], s[7 * 33]);
        *(u32x4*)(WT + (size_t)(drow0 + n) * K + k0 + 8 * c) = o; }
    asm volatile("s_waitcnt lgkmcnt(0)" ::: "memory");
}
__device__ __forceinline__ void conv_job(const float* W, int K, int N, bf16_t* WT, int mode, LAS float* scr, int gw, int NGW, int lane, int& base) {
    const int n = (K / 64) * (N / 32);
    int it = gw - (base % NGW); if (it < 0) it += NGW;
    for (; it < n; it += NGW) transpose_item(W, K, N, WT, mode, scr, it, lane);
    base += n;
}
__device__ __forceinline__ void convert_weights(const Params& p, int layer, LAS unsigned char* lds, unsigned char* dout) {
    const int tid = fresh_tid(), lane = tid & 63, wave = tid >> 6;
    const int gw = fresh_bid() * 8 + wave, NGW = fresh_gdim() * 8;
    LAS float* scr = (LAS float*)(lds + wave * 16384);
    int base = 0;
    const size_t fgu = (size_t)DM * FF;
    for (int f = 0; f < 2; ++f) {
        const size_t off = ((size_t)layer * 2 + f) * fgu;
        bf16_t* gu = (bf16_t*)(dout + (f == 0 ? W_F1GU : W_F2GU)); bf16_t* dn = (bf16_t*)(dout + (f == 0 ? W_F1D : W_F2D));
        conv_job(p.ffn_g + off, DM, FF, gu, 1, scr, gw, NGW, lane, base);
        conv_job(p.ffn_u + off, DM, FF, gu, 2, scr, gw, NGW, lane, base);
        conv_job(p.ffn_d + off, FF, DM, dn, 0, scr, gw, NGW, lane, base);
    }
    bf16_t* win = (bf16_t*)(dout + W_MIN); bf16_t* wout = (bf16_t*)(dout + W_MOUT);
    if (layer == 0) { conv_job(p.gqa_in, DM, 1536, win, 0, scr, gw, NGW, lane, base); conv_job(p.gqa_out, DM, DM, wout, 0, scr, gw, NGW, lane, base); }
    else if (layer == 1) { conv_job(p.diff_in, DM, 3072, win, 0, scr, gw, NGW, lane, base); conv_job(p.diff_out, DM, DM, wout, 0, scr, gw, NGW, lane, base); }
    else if (layer == 2) { conv_job(p.hgrn_in, DM, 5120, win, 0, scr, gw, NGW, lane, base); conv_job(p.hgrn_out, DM, DM, wout, 0, scr, gw, NGW, lane, base); }
    else {
        conv_job(p.mla_down, DM, 544, win, 0, scr, gw, NGW, lane, base);
        conv_job(p.mla_uq, 256, 1536, (bf16_t*)(dout + W_UQ), 0, scr, gw, NGW, lane, base);
        conv_job(p.mla_ukv, 256, 2048, (bf16_t*)(dout + W_UKV), 0, scr, gw, NGW, lane, base);
        conv_job(p.mla_out, DM, DM, wout, 0, scr, gw, NGW, lane, base);
    }
}

__device__ __forceinline__ void prologue(const Params& p, LAS unsigned char* lds) {
    const int tid = fresh_tid(), G = fresh_gdim(), bid = fresh_bid();
    float* ropeH = (float*)(p.ws + WS_ROPEH); float* ropeM = (float*)(p.ws + WS_ROPEM);
    for (int i = bid * NTHR + tid; i < 2048 * 32; i += G * NTHR) { const int s = i >> 5, e = i & 31; const float pos = (e < 16) ? (float)(s >> 6) : (float)(s & 63);
        const float inv = powf(10000.f, -(float)(2 * (e & 15)) / 32.f); const float ang = pos * inv; ropeH[2 * i] = cosf(ang); ropeH[2 * i + 1] = sinf(ang); }
    for (int i = bid * NTHR + tid; i < 2048 * 16; i += G * NTHR) { const int s = i >> 4, e = i & 15; const float pos = (e < 8) ? (float)(s >> 6) : (float)(s & 63);
        const float inv = powf(10000.f, -(float)(2 * (e & 7)) / 16.f); const float ang = pos * inv; ropeM[2 * i] = cosf(ang); ropeM[2 * i + 1] = sinf(ang); }
    if (bid == 0) {
        float* lbv = (float*)(p.ws + WS_LB);
        for (int d = tid; d < 1024; d += NTHR) { const float a0 = p.hgrn_lb[d], a1 = p.hgrn_lb[1024 + d], a2 = p.hgrn_lb[2048 + d], a3 = p.hgrn_lb[3072 + d];
            const float mx = fmaxf(fmaxf(a0, a1), fmaxf(a2, a3)); const float e0 = expf(a0 - mx), e1 = expf(a1 - mx), e2 = expf(a2 - mx), e3 = expf(a3 - mx);
            lbv[d] = (e1 + e2) / (e0 + e1 + e2 + e3); }
        if (tid == 0) { float s1 = 0.f, s2 = 0.f; for (int d = 0; d < 64; ++d) { s1 += p.diff_lambda[d] * p.diff_lambda[64 + d]; s2 += p.diff_lambda[128 + d] * p.diff_lambda[192 + d]; }
            const float lambda_init = 0.8f - 0.6f * expf(-0.3f);
            ((float*)(p.ws + WS_LAM))[0] = expf(s1) - expf(s2) + lambda_init; ((float*)(p.ws + WS_LAM))[1] = lambda_init; }
    }
    LAS float* sS = (LAS float*)lds; LAS float* red = (LAS float*)(lds + 17 * 1024 * 4);
    for (int i = tid; i < 17 * 1024; i += NTHR) { const int r = i >> 10, k = i & 1023; const float v = r < 16 ? p.c[r * 1024 + k] : p.c_ctx[k]; sS[i] = v / (1.f + expf(-v)); }
    __syncthreads();
    float* mod = (float*)(p.ws + WS_MOD);
    for (int item = bid; item < 4 * 144; item += G) {
        const int l = item / 144, n0 = (item - l * 144) * 64, col4 = (tid & 15) * 4, kp = tid >> 4;
        const float* W = p.ada_w + (size_t)l * 1024 * NMODV + n0 + col4;
        f32x4 acc[17];
#pragma unroll
        for (int r = 0; r < 17; ++r) acc[r] = (f32x4){0.f, 0.f, 0.f, 0.f};
#pragma unroll 1
        for (int k = kp * 32; k < kp * 32 + 32; k += 8) {
            f32x4 w[8];
#pragma unroll
            for (int i = 0; i < 8; ++i) w[i] = ldg4(W + (size_t)(k + i) * NMODV);
#pragma unroll
            for (int i = 0; i < 8; i += 4) {
#pragma unroll
                for (int r = 0; r < 17; ++r) { const f32x4 s4 = *(const LAS f32x4*)(sS + r * 1024 + k + i); acc[r] = acc[r] + (s4[0] * w[i] + s4[1] * w[i + 1]) + (s4[2] * w[i + 2] + s4[3] * w[i + 3]); }
                asm volatile("" ::: "memory");
            }
        }
#pragma unroll
        for (int r = 0; r < 17; ++r)
#pragma unroll
            for (int c = 0; c < 4; ++c) { float v = acc[r][c]; v += __shfl_xor(v, 16); v += __shfl_xor(v, 32); acc[r][c] = v; }
        if ((tid & 63) < 16) {
#pragma unroll
            for (int r = 0; r < 17; ++r) *(LAS f32x4*)(red + ((tid >> 6) * 17 + r) * 64 + col4) = acc[r];
        }
        __syncthreads();
        for (int o = tid; o < 17 * 64; o += NTHR) { const int r = o >> 6, cc = o & 63;
            float sm = 0.f;
#pragma unroll
            for (int q = 0; q < 8; ++q) sm += red[(q * 17 + r) * 64 + cc];
            mod[((size_t)l * 17 + r) * NMODV + n0 + cc] = sm + p.ada_b[(size_t)l * NMODV + n0 + cc]; }
        __syncthreads();
    }
}

__device__ __forceinline__ void norm_phase(float* HX, const float* nw, const float* modl, int shift_idx, int scale_idx, bf16_t* A, const float* P, bool skip_ctx = false, const float* srcx = nullptr, const float* srcc = nullptr) {
    const int tid = fresh_tid(), lane = tid & 63, gw = fresh_bid() * 8 + (tid >> 6), NGW = fresh_gdim() * 8;
    f32x4 w4[4];
#pragma unroll
    for (int j = 0; j < 4; ++j) w4[j] = ldg4(nw + lane * 4 + 256 * j);
    for (int row0 = gw; row0 < TT; row0 += 2 * NGW) {
        f32x4 v[2][4]; int mr[2]; bool act[2];
#pragma unroll
        for (int q = 0; q < 2; ++q) {
            const int row = row0 + q * NGW, b = row / TB, t = row - b * TB; mr[q] = t < CL ? 16 : b; act[q] = !(skip_ctx && t < CL);
            const float* xr = srcx == nullptr ? HX + (size_t)row * DM + lane * 4 : (t < CL ? srcc + ((size_t)(b * CL + t)) * DM : srcx + ((size_t)(b * SQ + t - CL)) * DM) + lane * 4;
            if (act[q]) {
#pragma unroll
                for (int j = 0; j < 4; ++j) v[q][j] = ldg4(xr + 256 * j);
                if (srcx != nullptr) { float* hw = HX + (size_t)row * DM + lane * 4;
#pragma unroll
                    for (int j = 0; j < 4; ++j) stg4(hw + 256 * j, v[q][j]); }
            }
        }
#pragma unroll
        for (int q = 0; q < 2; ++q) {
            const int row = row0 + q * NGW;
            if (act[q] && P != nullptr && row >= SPLIT_PM0 * 256) {
                const GAS u32x2* pr = (const GAS u32x2*)((const bf16_t*)P + (size_t)(row - SPLIT_PM0 * 256) * DM) + lane;
                float* xr = HX + (size_t)row * DM + lane * 4;
#pragma unroll
                for (int j = 0; j < 4; ++j) {
                    f32x4 a = {0.f, 0.f, 0.f, 0.f};
#pragma unroll
                    for (int k = 0; k < 4; ++k) { const u32x2 w = pr[(size_t)k * SPLIT_ROWS * 256 + 64 * j]; a[0] += bflo(w.x); a[1] += bfhi(w.x); a[2] += bflo(w.y); a[3] += bfhi(w.y); }
                    v[q][j] = v[q][j] + a; stg4(xr + 256 * j, v[q][j]); }
            }
        }
#pragma unroll
        for (int q = 0; q < 2; ++q) {
            if (!act[q]) continue;
            const int row = row0 + q * NGW; float ss = 0.f;
#pragma unroll
            for (int j = 0; j < 4; ++j) ss += (v[q][j][0] * v[q][j][0] + v[q][j][1] * v[q][j][1]) + (v[q][j][2] * v[q][j][2] + v[q][j][3] * v[q][j][3]);
            const float rstd = rsqrtf(wave_sum(ss) * (1.f / 1024.f) + 1e-6f);
            const float* sh = modl + (size_t)mr[q] * NMODV + shift_idx * 1024 + lane * 4; const float* sc = modl + (size_t)mr[q] * NMODV + scale_idx * 1024 + lane * 4;
            bf16_t* ar = A + (size_t)row * DM + lane * 4;
#pragma unroll
            for (int j = 0; j < 4; ++j) { const f32x4 s4 = ldg4(sc + 256 * j), h4 = ldg4(sh + 256 * j);
                const f32x4 y = v[q][j] * rstd * w4[j] * (1.f + s4) + h4; store4bf(ar + 256 * j, y); }
        }
    }
}
__device__ __forceinline__ void final_phase(const float* HX, const float* nw, float* out) {
    const int tid = fresh_tid(), lane = tid & 63, gw = fresh_bid() * 8 + (tid >> 6), NGW = fresh_gdim() * 8;
    f32x4 w4[4];
#pragma unroll
    for (int j = 0; j < 4; ++j) w4[j] = ldg4(nw + lane * 4 + 256 * j);
    for (int r0 = gw; r0 < NB * SQ; r0 += 2 * NGW) {
        f32x4 v[2][4];
#pragma unroll
        for (int q = 0; q < 2; ++q) { const int r = r0 + q * NGW, b = r >> 11, sidx = r & 2047; const float* xr = HX + (size_t)(b * TB + CL + sidx) * DM + lane * 4;
#pragma unroll
            for (int j = 0; j < 4; ++j) v[q][j] = ldg4(xr + 256 * j); }
#pragma unroll
        for (int q = 0; q < 2; ++q) { const int r = r0 + q * NGW; float ss = 0.f;
#pragma unroll
            for (int j = 0; j < 4; ++j) ss += (v[q][j][0] * v[q][j][0] + v[q][j][1] * v[q][j][1]) + (v[q][j][2] * v[q][j][2] + v[q][j][3] * v[q][j][3]);
            const float rstd = rsqrtf(wave_sum(ss) * (1.f / 1024.f) + 1e-6f);
            float* o = out + (size_t)r * DM + lane * 4;
#pragma unroll
            for (int j = 0; j < 4; ++j) stg4(o + 256 * j, v[q][j] * rstd * w4[j]); }
    }
}
__device__ __forceinline__ void diff_combine(const bf16_t* O16, const float* subln, const float* lamp, bf16_t* A) {
    const int tid = fresh_tid(), lane = tid & 63, gw = fresh_bid() * 8 + (tid >> 6), NGW = fresh_gdim() * 8;
    const float lam = lamp[0], om = 1.f - lamp[1];
    const int h = lane >> 3, e0 = (lane & 7) * 16;
    float sw[16];
#pragma unroll
    for (int j = 0; j < 16; ++j) sw[j] = subln[e0 + j] * om;
    for (int row = gw; row < TT; row += NGW) {
        const u32x4* o1 = (const u32x4*)(O16 + (size_t)row * 2048 + (2 * h) * 128 + e0); const u32x4* o2 = (const u32x4*)(O16 + (size_t)row * 2048 + (2 * h + 1) * 128 + e0);
        float v[16]; float ss = 0.f;
#pragma unroll
        for (int q = 0; q < 2; ++q) { const u32x4 a = o1[q], b = o2[q];
#pragma unroll
            for (int k = 0; k < 4; ++k) { v[q * 8 + 2 * k] = bflo(a[k]) - lam * bflo(b[k]); v[q * 8 + 2 * k + 1] = bfhi(a[k]) - lam * bfhi(b[k]); } }
#pragma unroll
        for (int j = 0; j < 16; ++j) ss += v[j] * v[j];
        ss += __shfl_xor(ss, 1); ss += __shfl_xor(ss, 2); ss += __shfl_xor(ss, 4);
        const float rstd = rsqrtf(ss * (1.f / 128.f) + 1e-6f);
        u32x4 w0, w1;
        w0.x = pk2(v[0] * rstd * sw[0], v[1] * rstd * sw[1]); w0.y = pk2(v[2] * rstd * sw[2], v[3] * rstd * sw[3]); w0.z = pk2(v[4] * rstd * sw[4], v[5] * rstd * sw[5]); w0.w = pk2(v[6] * rstd * sw[6], v[7] * rstd * sw[7]);
        w1.x = pk2(v[8] * rstd * sw[8], v[9] * rstd * sw[9]); w1.y = pk2(v[10] * rstd * sw[10], v[11] * rstd * sw[11]); w1.z = pk2(v[12] * rstd * sw[12], v[13] * rstd * sw[13]); w1.w = pk2(v[14] * rstd * sw[14], v[15] * rstd * sw[15]);
        u32x4* d = (u32x4*)(A + (size_t)row * 1024 + h * 128 + e0); d[0] = w0; d[1] = w1;
    }
}
__device__ __forceinline__ void hgrn_combine(const bf16_t* OF, const bf16_t* OB, const bf16_t* Gt, const float* nw, bf16_t* A) {
    const int tid = fresh_tid(), lane = tid & 63, gw = fresh_bid() * 8 + (tid >> 6), NGW = fresh_gdim() * 8;
    const int e0 = (lane & 7) * 16;
    float sw[16];
#pragma unroll
    for (int j = 0; j < 16; ++j) sw[j] = nw[e0 + j];
    for (int row = gw; row < TT; row += NGW) {
        const size_t off = (size_t)row * 1024 + lane * 16;
        const u32x4* pf = (const u32x4*)(OF + off); const u32x4* pb = (const u32x4*)(OB + off); const u32x4* pg = (const u32x4*)(Gt + off);
        float v[16], g[16]; float ss = 0.f;
#pragma unroll
        for (int q = 0; q < 2; ++q) { const u32x4 a = pf[q], b = pb[q], c = pg[q];
#pragma unroll
            for (int k = 0; k < 4; ++k) { v[q * 8 + 2 * k] = bflo(a[k]) + bflo(b[k]); v[q * 8 + 2 * k + 1] = bfhi(a[k]) + bfhi(b[k]); g[q * 8 + 2 * k] = bflo(c[k]); g[q * 8 + 2 * k + 1] = bfhi(c[k]); } }
#pragma unroll
        for (int j = 0; j < 16; ++j) ss += v[j] * v[j];
        ss += __shfl_xor(ss, 1); ss += __shfl_xor(ss, 2); ss += __shfl_xor(ss, 4);
        const float rstd = rsqrtf(ss * (1.f / 128.f) + 1e-6f);
        u32x4 w0, w1;
#define HC(j) (v[j] * rstd * sw[j] * g[j])
        w0.x = pk2(HC(0), HC(1)); w0.y = pk2(HC(2), HC(3)); w0.z = pk2(HC(4), HC(5)); w0.w = pk2(HC(6), HC(7));
        w1.x = pk2(HC(8), HC(9)); w1.y = pk2(HC(10), HC(11)); w1.z = pk2(HC(12), HC(13)); w1.w = pk2(HC(14), HC(15));
#undef HC
        u32x4* d = (u32x4*)(A + off); d[0] = w0; d[1] = w1;
    }
}
__device__ __forceinline__ void mla_rows(const float* DN, const float* qn, const float* kvn, const float* ropeM, bf16_t* CQ, bf16_t* CKV, bf16_t* K) {
    const int tid = fresh_tid(), lane = tid & 63, gw = fresh_bid() * 8 + (tid >> 6), NGW = fresh_gdim() * 8;
    const f32x4 wq = ldg4(qn + lane * 4), wk = ldg4(kvn + lane * 4);
    for (int row0 = gw; row0 < TT; row0 += 3 * NGW) {
        f32x4 a3[3], c3[3]; float kr3[3];
#pragma unroll
        for (int q = 0; q < 3; ++q) { const float* dr = DN + (size_t)(row0 + q * NGW) * 768; a3[q] = ldg4(dr + lane * 4); c3[q] = ldg4(dr + 256 + lane * 4); kr3[q] = *(const GAS float*)(dr + 512 + (lane & 31)); }
#pragma unroll
        for (int q = 0; q < 3; ++q) {
        const int row = row0 + q * NGW;
        const int b = row / TB, t = row - b * TB;
        const f32x4 a = a3[q], c = c3[q]; const float kr = kr3[q];
        float sa = (a[0] * a[0] + a[1] * a[1]) + (a[2] * a[2] + a[3] * a[3]), sc = (c[0] * c[0] + c[1] * c[1]) + (c[2] * c[2] + c[3] * c[3]);
        sa = wave_sum(sa); sc = wave_sum(sc);
        const float ra = rsqrtf(sa * (1.f / 256.f) + 1e-6f), rc = rsqrtf(sc * (1.f / 256.f) + 1e-6f);
        store4bf(CQ + (size_t)row * 256 + lane * 4, a * ra * wq); store4bf(CKV + (size_t)row * 256 + lane * 4, c * rc * wk);
        const int d = lane & 31; float kv = kr;
        const float part = __shfl_xor(kr, 8);
        if (t >= CL) { const int e = (d >> 4) * 8 + (d & 7); const float cs = ropeM[((size_t)(t - CL) * 16 + e) * 2], sn = ropeM[((size_t)(t - CL) * 16 + e) * 2 + 1];
            kv = kr * cs + ((d & 8) ? part : -part) * sn; }
        float o8[8];
#pragma unroll
        for (int jj = 0; jj < 8; ++jj) o8[jj] = __shfl(kv, (lane & 3) * 8 + jj);
        u32x4 w; w.x = pk2(o8[0], o8[1]); w.y = pk2(o8[2], o8[3]); w.z = pk2(o8[4], o8[5]); w.w = pk2(o8[6], o8[7]);
        *(GAS u32x4*)(K + (size_t)row * 1536 + (lane >> 2) * 96 + 64 + (lane & 3) * 8) = w;
        }
    }
}

template <int DQK, int DV>
__device__ __forceinline__ void attn_unit(LAS unsigned char* lds, const bf16_t* Qr, int qs, const bf16_t* Kb, int ks, const bf16_t* Vtb, bf16_t* Or, int os,
                                          int lt0, int lt1, bool windowed, int qpos0, float m_init, float l_init,
                                          int dmode = 0  , float lam = 0.f, float om = 0.f, const float* subw = nullptr) {
    constexpr int KST = DQK * 2 + 16, VST = 144, KBUF = 64 * KST, VBUF = DV * VST, KCH = DQK / 8, NKC = 64 * KCH, KPT = (NKC + NTHR - 1) / NTHR, VPT = DV / 64, ND = DQK / 16, NO = DV / 32;
    const int tid = fresh_tid(), lane = tid & 63, r32 = lane & 31, hi = lane >> 5, wid = tid >> 6;
    LAS unsigned char* Kl = lds; LAS unsigned char* Vl = lds + 2 * KBUF;
    const int ntiles = 4 + (lt1 - lt0);
    const GAS bf16_t* Qg = (const GAS bf16_t*)Qr; const GAS bf16_t* Kg = (const GAS bf16_t*)Kb; const GAS bf16_t* Vg = (const GAS bf16_t*)Vtb; GAS bf16_t* Og = (GAS bf16_t*)Or;
    bf16x8 qf[ND];
#pragma unroll
    for (int d0 = 0; d0 < ND; ++d0) qf[d0] = *(const GAS bf16x8*)(Qg + (size_t)(wid * 32 + r32) * qs + d0 * 16 + hi * 8);
    f32x16 o[NO];
#pragma unroll
    for (int nb = 0; nb < NO; ++nb)
#pragma unroll
        for (int r = 0; r < 16; ++r) o[nb][r] = 0.f;
    const bool have_ref = l_init > 0.f;
    float m = have_ref ? m_init : 0.f, l = (hi == 0) ? l_init : 0.f;
    u32x4 kreg[KPT], vreg[VPT];
#define ATT_KT(tt_) ((tt_) < 4 ? (tt_) : lt0 + (tt_) - 4)
#define ATT_LOADK(tt_) do { const int kt_ = ATT_KT(tt_); \
        _Pragma("unroll") for (int i_ = 0; i_ < KPT; ++i_) { const int c_ = tid + NTHR * i_; if (c_ < NKC) { const int key_ = c_ / KCH, part_ = c_ - key_ * KCH; kreg[i_] = *(const GAS u32x4*)(Kg + (size_t)(kt_ * 64 + key_) * ks + part_ * 8); } } } while (0)
#define ATT_LOADV(tt_) do { const int kt_ = ATT_KT(tt_); \
        _Pragma("unroll") for (int i_ = 0; i_ < VPT; ++i_) { const int c_ = tid + NTHR * i_; const int dv_ = c_ >> 3, part_ = c_ & 7; vreg[i_] = *(const GAS u32x4*)(Vg + (size_t)dv_ * TB + kt_ * 64 + part_ * 8); } } while (0)
#define ATT_STOREK(buf_) do { \
        _Pragma("unroll") for (int i_ = 0; i_ < KPT; ++i_) { const int c_ = tid + NTHR * i_; if (c_ < NKC) { const int key_ = c_ / KCH, part_ = c_ - key_ * KCH; *(LAS u32x4*)(Kl + (buf_) * KBUF + key_ * KST + part_ * 16) = kreg[i_]; } } } while (0)
#define ATT_STOREV(buf_) do { \
        _Pragma("unroll") for (int i_ = 0; i_ < VPT; ++i_) { const int c_ = tid + NTHR * i_; const int dv_ = c_ >> 3, part_ = c_ & 7; LAS unsigned char* d_ = Vl + (buf_) * VBUF + dv_ * VST + (part_ >> 1) * 32 + (part_ & 1) * 8;     \
            *(LAS u32x2*)d_ = (u32x2){vreg[i_].x, vreg[i_].y}; *(LAS u32x2*)(d_ + 16) = (u32x2){vreg[i_].z, vreg[i_].w}; } } while (0)
#define SCHED_FENCE() __builtin_amdgcn_sched_barrier(0)
#define ATT_KFRAG(buf_) do { const LAS unsigned char* kb_ = Kl + (buf_) * KBUF + r32 * KST + hi * 16; \
        _Pragma("unroll") for (int d0 = 0; d0 < ND; ++d0) { kf[2 * d0] = *(const LAS bf16x8*)(kb_ + d0 * 32); kf[2 * d0 + 1] = *(const LAS bf16x8*)(kb_ + 32 * KST + d0 * 32); } } while (0)
#define ATT_QKM(P0_, P1_) do { \
        _Pragma("unroll") for (int d0 = 0; d0 < ND; ++d0) { \
            if (d0 == 0) { const f32x16 z_ = {0.f, 0.f, 0.f, 0.f, 0.f, 0.f, 0.f, 0.f, 0.f, 0.f, 0.f, 0.f, 0.f, 0.f, 0.f, 0.f}; P0_ = __builtin_amdgcn_mfma_f32_32x32x16_bf16(kf[0], qf[0], z_, 0, 0, 0); P1_ = __builtin_amdgcn_mfma_f32_32x32x16_bf16(kf[1], qf[0], z_, 0, 0, 0); } \
            else { P0_ = __builtin_amdgcn_mfma_f32_32x32x16_bf16(kf[2 * d0], qf[d0], P0_, 0, 0, 0); P1_ = __builtin_amdgcn_mfma_f32_32x32x16_bf16(kf[2 * d0 + 1], qf[d0], P1_, 0, 0, 0); } } } while (0)
#define ATT_VFRAG(dst_, nb_) do { _Pragma("unroll") for (int j_ = 0; j_ < 4; ++j_) dst_[j_] = *(const LAS u32x4*)(vb + (nb_) * 32 * VST + j_ * 32); } while (0)
    bf16x8 kf[2 * ND];
    f32x16 n0, n1;
    ATT_LOADK(0); ATT_LOADV(0); ATT_STOREK(0); ATT_STOREV(0);
    __syncthreads();
    ATT_LOADK(1); ATT_KFRAG(0); ATT_QKM(n0, n1); ATT_STOREK(1);
    __syncthreads();
    for (int tt = 0; tt < ntiles; ++tt) {
        const int cur = tt & 1;
        f32x16 p0 = n0, p1 = n1;
        if (tt + 2 < ntiles) ATT_LOADK(tt + 2);
        if (tt + 1 < ntiles) ATT_LOADV(tt + 1);
#define ATT_OUTSIDE(t_) (windowed && (t_) >= 4 && (((lt0 + (t_) - 4) * 64 - CL) > qhi_w + 128 || ((lt0 + (t_) - 4) * 64 - CL + 63) < qlo_w - 128))
        const int qlo_w = qpos0 + __builtin_amdgcn_readfirstlane(wid) * 32, qhi_w = qlo_w + 31;
        const bool skip_cur = ATT_OUTSIDE(tt), skip_next = ATT_OUTSIDE(tt + 1);
        u32x4 pw[4];
        if (!skip_cur) {
        if (windowed && tt >= 4) {
            const int kt = lt0 + tt - 4; const int kbase = kt * 64 - CL, qp = qpos0 + wid * 32 + r32;
#pragma unroll
            for (int r = 0; r < 16; ++r) { const int d0 = qp - (kbase + crow(r, hi)); if (d0 > 128 || d0 < -128) p0[r] = -1e30f; const int d1 = d0 - 32; if (d1 > 128 || d1 < -128) p1[r] = -1e30f; }
        }
        float mx = __builtin_fmaxf(__builtin_fmaxf(p0[0], p1[0]), p0[1]);
#pragma unroll
        for (int r = 1; r < 16; ++r) { if (r > 1) mx = __builtin_fmaxf(__builtin_fmaxf(mx, p0[r]), p1[r]); else mx = __builtin_fmaxf(mx, p1[1]); }
        mx = __builtin_fmaxf(mx, __shfl_xor(mx, 32)) - m;
        const bool force = (tt == 0) && !have_ref;
        if (force || __any(mx > 8.f)) {
            const float delta = force ? mx : __builtin_fmaxf(mx, 0.f);
            m += delta;
            if (!force) { const float alpha = __builtin_amdgcn_exp2f(-delta); l *= alpha;
#pragma unroll
                for (int nb = 0; nb < NO; ++nb)
#pragma unroll
                    for (int r = 0; r < 16; ++r) o[nb][r] *= alpha; }
        }
        float ls = 0.f;
#pragma unroll
        for (int r = 0; r < 16; ++r) { p0[r] = __builtin_amdgcn_exp2f(p0[r] - m); p1[r] = __builtin_amdgcn_exp2f(p1[r] - m); ls += p0[r] + p1[r]; }
        l += ls;
        pw[0] = (u32x4){pk2(p0[0], p0[1]), pk2(p0[2], p0[3]), pk2(p0[4], p0[5]), pk2(p0[6], p0[7])};
        pw[1] = (u32x4){pk2(p0[8], p0[9]), pk2(p0[10], p0[11]), pk2(p0[12], p0[13]), pk2(p0[14], p0[15])};
        pw[2] = (u32x4){pk2(p1[0], p1[1]), pk2(p1[2], p1[3]), pk2(p1[4], p1[5]), pk2(p1[6], p1[7])};
        pw[3] = (u32x4){pk2(p1[8], p1[9]), pk2(p1[10], p1[11]), pk2(p1[12], p1[13]), pk2(p1[14], p1[15])};
        SCHED_FENCE();
        }
        const LAS unsigned char* vb = Vl + cur * VBUF + r32 * VST + hi * 16;
        u32x4 vf[2][4];
        if (!skip_next) ATT_KFRAG(cur ^ 1);
        if (!skip_cur) ATT_VFRAG(vf[0], 0);
        SCHED_FENCE();
        if (!skip_next) ATT_QKM(n0, n1);
        if (!skip_cur) {
#pragma unroll
        for (int nb = 0; nb < NO; ++nb) {
            if (nb + 1 < NO) ATT_VFRAG(vf[(nb + 1) & 1], nb + 1);
            SCHED_FENCE();
#pragma unroll
            for (int j = 0; j < 4; ++j) o[nb] = __builtin_amdgcn_mfma_f32_32x32x16_bf16(__builtin_bit_cast(bf16x8, vf[nb & 1][j]), __builtin_bit_cast(bf16x8, pw[j]), o[nb], 0, 0, 0);
            SCHED_FENCE();
        }
        }
#undef ATT_OUTSIDE
        if (tt + 2 < ntiles) ATT_STOREK(cur);
        if (tt + 1 < ntiles) ATT_STOREV(cur ^ 1);
        __syncthreads();
    }
#undef SCHED_FENCE
#undef ATT_KFRAG
#undef ATT_QKM
#undef ATT_VFRAG
#undef ATT_KT
#undef ATT_LOADK
#undef ATT_LOADV
#undef ATT_STOREK
#undef ATT_STOREV
    l += __shfl_xor(l, 32);
    const float inv = 1.f / l;
    GAS bf16_t* orow = Og + (size_t)(wid * 32 + r32) * os + 4 * hi;
    LAS unsigned char* stash = lds + 2 * KBUF + 2 * VBUF + (wid * 32 + r32) * 264 + 8 * hi;
    if (DV == 128 && dmode == 1) {
#pragma unroll
        for (int nb = 0; nb < NO; ++nb)
#pragma unroll
            for (int g = 0; g < 4; ++g) { u32x2 w; w.x = pk2(o[nb][4 * g] * inv, o[nb][4 * g + 1] * inv); w.y = pk2(o[nb][4 * g + 2] * inv, o[nb][4 * g + 3] * inv); *(LAS u32x2*)(stash + nb * 64 + 16 * g) = w; }
    } else if (DV == 128 && dmode == 2) {
        const float li = lam * inv; float ss = 0.f;
#pragma unroll
        for (int nb = 0; nb < NO; ++nb)
#pragma unroll
            for (int g = 0; g < 4; ++g) { const u32x2 a = *(const LAS u32x2*)(stash + nb * 64 + 16 * g);
                const float x0 = bflo(a.x) - li * o[nb][4 * g], x1 = bfhi(a.x) - li * o[nb][4 * g + 1], x2 = bflo(a.y) - li * o[nb][4 * g + 2], x3 = bfhi(a.y) - li * o[nb][4 * g + 3];
                o[nb][4 * g] = x0; o[nb][4 * g + 1] = x1; o[nb][4 * g + 2] = x2; o[nb][4 * g + 3] = x3; ss += (x0 * x0 + x1 * x1) + (x2 * x2 + x3 * x3); }
        ss += __shfl_xor(ss, 32);
        const float rs = rsqrtf(ss * (1.f / 128.f) + 1e-6f) * om;
#pragma unroll
        for (int nb = 0; nb < NO; ++nb)
#pragma unroll
            for (int g = 0; g < 4; ++g) { const f32x4 w4 = ldg4(subw + nb * 32 + 8 * g + 4 * hi); u32x2 w;
                w.x = pk2(o[nb][4 * g] * rs * w4[0], o[nb][4 * g + 1] * rs * w4[1]); w.y = pk2(o[nb][4 * g + 2] * rs * w4[2], o[nb][4 * g + 3] * rs * w4[3]); *(GAS u32x2*)(orow + nb * 32 + 8 * g) = w; }
    } else {
#pragma unroll
    for (int nb = 0; nb < NO; ++nb)
#pragma unroll
        for (int g = 0; g < 4; ++g) { u32x2 w; w.x = pk2(o[nb][4 * g] * inv, o[nb][4 * g + 1] * inv); w.y = pk2(o[nb][4 * g + 2] * inv, o[nb][4 * g + 3] * inv); *(GAS u32x2*)(orow + nb * 32 + 8 * g) = w; }
    }
}

template <int KIND>
__device__ __forceinline__ void attn_phase(unsigned char* big, bf16_t* Abuf, const float* sinks  , const float* lamp, LAS unsigned char* lds, bool with_ctx) {
    constexpr int NHU = (KIND == 1) ? 8 : 16;
    const int NLAT = NB * NHU * 8, NU = NLAT + (with_ctx ? NB * NHU : 0);
    const int bid_ = fresh_bid(), vb_ = (bid_ & 7) * (GRID / 8) + (bid_ >> 3);
    for (int u = vb_; u < NU; u += GRID) {
        int b, head, j;
        if (u < NLAT) { j = 1 + (u & 7); head = (u >> 3) % NHU; b = (u >> 3) / NHU; } else { const int v = u - NLAT; j = 0; head = v % NHU; b = v / NHU; }
        const size_t row0 = (size_t)b * TB + j * 256;
        int lt0 = 4, lt1 = 4; const int qpos0 = (j - 1) * 256;
        if (j > 0) { if (KIND == 0) { int lo = qpos0 - 128; if (lo < 0) lo = 0; int hi = qpos0 + 255 + 128; if (hi > SQ - 1) hi = SQ - 1; lt0 = 4 + lo / 64; lt1 = 4 + hi / 64 + 1; } else { lt0 = 4; lt1 = 36; } }
        if (KIND == 0) {
            const bf16_t* Q = (const bf16_t*)big; const bf16_t* K = (const bf16_t*)(big + U72); const bf16_t* Vt = (const bf16_t*)(big + U72 + 18 * MiB);
            const float sink = sinks[head] * LOG2E;
            attn_unit<64, 64>(lds, Q + row0 * 1024 + head * 64, 1024, K + (size_t)b * TB * 256 + (head >> 2) * 64, 256, Vt + (size_t)(b * 4 + (head >> 2)) * 64 * TB,
                              Abuf + row0 * 1024 + head * 64, 1024, lt0, lt1, true, qpos0, sink, 1.f);
        } else if (KIND == 1) {
            const bf16_t* Q = (const bf16_t*)big; const bf16_t* K = (const bf16_t*)(big + U72); const bf16_t* Vt = (const bf16_t*)(big + 2 * U72);
            const float lam = lamp[0], om = 1.f - lamp[1];
            attn_unit<64, 128>(lds, Q + row0 * 1024 + (2 * head) * 64, 1024, K + (size_t)b * TB * 1024 + (2 * head) * 64, 1024, Vt + (size_t)(b * 8 + head) * 128 * TB,
                               Abuf + row0 * 1024 + head * 128, 1024, lt0, lt1, false, qpos0, -1e30f, 0.f, 1);
            attn_unit<64, 128>(lds, Q + row0 * 1024 + (2 * head + 1) * 64, 1024, K + (size_t)b * TB * 1024 + (2 * head + 1) * 64, 1024, Vt + (size_t)(b * 8 + head) * 128 * TB,
                               Abuf + row0 * 1024 + head * 128, 1024, lt0, lt1, false, qpos0, -1e30f, 0.f, 2, lam, om, sinks);
        } else {
            const bf16_t* Vt = (const bf16_t*)big; const bf16_t* Q = (const bf16_t*)(big + 2 * U72); const bf16_t* K = (const bf16_t*)(big + 2 * U72 + 108 * MiB);
            attn_unit<96, 64>(lds, Q + row0 * 1536 + head * 96, 1536, K + (size_t)b * TB * 1536 + head * 96, 1536, Vt + (size_t)(b * 16 + head) * 64 * TB,
                              Abuf + row0 * 1024 + head * 64, 1024, lt0, lt1, false, qpos0, -1e30f, 0.f);
        }
    }
}

__device__ __forceinline__ void hgrn_scan(unsigned char* big, bf16_t* OF, bf16_t* OB, LAS unsigned char* lds) {
    constexpr int GST = 132;
    constexpr int O_G = 0, O_QT = 34816, O_KT = O_QT + 17408, O_KTT = O_KT + 17408, O_VT = O_KTT + 18432, O_AB = O_VT + 18432, O_SEG = O_AB + 9216, O_GM = O_SEG + 2048, O_GL = O_GM + 512;
    const bf16_t* Qh = (const bf16_t*)big; const bf16_t* Vv = (const bf16_t*)(big + 3 * U72);
    const int tid = fresh_tid(), lane = tid & 63, r32 = lane & 31, hi = lane >> 5, wid = tid >> 6;
    LAS float* Gs = (LAS float*)(lds + O_G); LAS unsigned char* STb = lds + O_G;
    LAS unsigned char* QTb = lds + O_QT; LAS unsigned char* KTb = lds + O_KT; LAS unsigned short* KTT = (LAS unsigned short*)(lds + O_KTT); LAS unsigned short* VT = (LAS unsigned short*)(lds + O_VT);
    LAS unsigned short* AB = (LAS unsigned short*)(lds + O_AB); LAS float* SEG = (LAS float*)(lds + O_SEG); LAS float* GM = (LAS float*)(lds + O_GM); LAS float* GL = (LAS float*)(lds + O_GL);
    for (int u = fresh_bid(); u < 256; u += fresh_gdim()) {
        const int dir = u & 1, h = (u >> 1) & 7, b = u >> 4;
        const unsigned short* LFd = (const unsigned short*)(big + (dir == 0 ? U72 : 2 * U72));
        bf16_t* Od = dir == 0 ? OF : OB;
        f32x16 S[2];
#pragma unroll
        for (int nb = 0; nb < 2; ++nb)
#pragma unroll
            for (int r = 0; r < 16; ++r) S[nb][r] = 0.f;
        const int db = wid >> 1, eh = wid & 1, ti = wid >> 2, ei = wid & 3;
        u32x4 q8[2], lf8[2], v8[2];
#define HG_TOK(ci_, tp_) ((size_t)b * TB + (size_t)((dir == 0) ? (ci_) : ((ci_) < 4 ? 3 - (ci_) : 39 - (ci_))) * 64 + ((dir == 0) ? (tp_) : 63 - (tp_)))
#define HG_LOAD(ci_) do { _Pragma("unroll") for (int i_ = 0; i_ < 2; ++i_) { const int ch_ = tid + NTHR * i_; const int tp_ = ch_ & 63, dc_ = ch_ >> 6; const size_t o_ = HG_TOK(ci_, tp_) * 1024 + h * 128 + dc_ * 8; \
            q8[i_] = *(const GAS u32x4*)((const GAS bf16_t*)Qh + o_); lf8[i_] = *(const GAS u32x4*)((const GAS unsigned short*)LFd + o_); v8[i_] = *(const GAS u32x4*)((const GAS bf16_t*)Vv + o_); } } while (0)
        HG_LOAD(0);
        for (int ci = 0; ci < 36; ++ci) {
#pragma unroll
            for (int i = 0; i < 2; ++i) { const int ch = tid + NTHR * i, tp = ch & 63, dc = ch >> 6; LAS float* g = Gs + tp * GST + dc * 8;
#pragma unroll
                for (int k = 0; k < 4; ++k) { g[2 * k] = h2f((unsigned short)(lf8[i][k] & 0xffffu)); g[2 * k + 1] = h2f((unsigned short)(lf8[i][k] >> 16)); } }
            __syncthreads();
            { const int d = tid & 127, seg = tid >> 7; float run = 0.f;
#pragma unroll
              for (int t = 0; t < 16; ++t) { LAS float* g = Gs + (seg * 16 + t) * GST + d; run += *g; *g = run; }
              SEG[seg * 128 + d] = run; }
            __syncthreads();
#pragma unroll
            for (int i = 0; i < 2; ++i) { const int ch = tid + NTHR * i, tp = ch & 63, dc = ch >> 6, seg = tp >> 4;
                float qt[8], kt[8];
#pragma unroll
                for (int k = 0; k < 8; ++k) { const int d = dc * 8 + k; const float s0 = SEG[d], s1 = SEG[128 + d], s2 = SEG[256 + d];
                    const float off = (seg > 0 ? s0 : 0.f) + (seg > 1 ? s1 : 0.f) + (seg > 2 ? s2 : 0.f);
                    const float g = Gs[tp * GST + d] + off, gm = s0 + s1 + Gs[32 * GST + d];
                    const unsigned lw = lf8[i][k >> 1], qw = q8[i][k >> 1], vw = v8[i][k >> 1];
                    const float lf = h2f((unsigned short)((k & 1) ? (lw >> 16) : (lw & 0xffffu)));
                    const float qv = (k & 1) ? bfhi(qw) : bflo(qw);
                    const float kk = 1.f - __expf(lf);
                    qt[k] = qv * __expf(g - gm); kt[k] = kk * __expf(gm - g);
                    KTT[d * 72 + tp] = f2bf(kt[k]); VT[d * 72 + tp] = (unsigned short)((k & 1) ? (vw >> 16) : (vw & 0xffffu)); }
                *(LAS u32x4*)(QTb + tp * 272 + dc * 16) = (u32x4){pk2(qt[0], qt[1]), pk2(qt[2], qt[3]), pk2(qt[4], qt[5]), pk2(qt[6], qt[7])};
                *(LAS u32x4*)(KTb + tp * 272 + dc * 16) = (u32x4){pk2(kt[0], kt[1]), pk2(kt[2], kt[3]), pk2(kt[4], kt[5]), pk2(kt[6], kt[7])}; }
            if (tid < 128) { const float s0 = SEG[tid], s1 = SEG[128 + tid], s2 = SEG[256 + tid], s3 = SEG[384 + tid]; GM[tid] = s0 + s1 + Gs[32 * GST + tid]; GL[tid] = (s0 + s1) + (s2 + s3); }
            if (ci + 1 < 36) HG_LOAD(ci + 1);
            __syncthreads();
#pragma unroll
            for (int nb = 0; nb < 2; ++nb)
#pragma unroll
                for (int g4 = 0; g4 < 4; ++g4) { const int d0 = 32 * db + 8 * g4 + 4 * hi; const f32x4 gm4 = *(const LAS f32x4*)(GM + d0);
#pragma unroll
                    for (int k = 0; k < 4; ++k) S[nb][4 * g4 + k] *= __expf(gm4[k]);
                    *(LAS u32x2*)(STb + (64 * eh + 32 * nb + r32) * 272 + d0 * 2) = (u32x2){pk2(S[nb][4 * g4], S[nb][4 * g4 + 1]), pk2(S[nb][4 * g4 + 2], S[nb][4 * g4 + 3])}; }
            __syncthreads();
            f32x16 o;
#pragma unroll
            for (int r = 0; r < 16; ++r) o[r] = 0.f;
#pragma unroll
            for (int kk = 0; kk < 8; ++kk) { const bf16x8 a = *(const LAS bf16x8*)(QTb + (32 * ti + r32) * 272 + kk * 32 + hi * 16), bb = *(const LAS bf16x8*)(STb + (32 * ei + r32) * 272 + kk * 32 + hi * 16);
                o = __builtin_amdgcn_mfma_f32_32x32x16_bf16(a, bb, o, 0, 0, 0); }
            if (wid < 4) { const int ti2 = wid >> 1, si = wid & 1; f32x16 a2;
#pragma unroll
                for (int r = 0; r < 16; ++r) a2[r] = 0.f;
#pragma unroll
                for (int kk = 0; kk < 8; ++kk) { const bf16x8 a = *(const LAS bf16x8*)(QTb + (32 * ti2 + r32) * 272 + kk * 32 + hi * 16), bb = *(const LAS bf16x8*)(KTb + (32 * si + r32) * 272 + kk * 32 + hi * 16);
                    a2 = __builtin_amdgcn_mfma_f32_32x32x16_bf16(a, bb, a2, 0, 0, 0); }
#pragma unroll
                for (int r = 0; r < 16; ++r) { const int t = 32 * ti2 + crow(r, hi), s = 32 * si + r32; AB[t * 72 + s] = (t >= s) ? f2bf(a2[r]) : (unsigned short)0; } }
            __syncthreads();
#pragma unroll
            for (int kk = 0; kk < 4; ++kk) { const bf16x8 a = *(const LAS bf16x8*)((LAS unsigned char*)AB + (32 * ti + r32) * 144 + kk * 32 + hi * 16), bb = *(const LAS bf16x8*)((LAS unsigned char*)VT + (32 * ei + r32) * 144 + kk * 32 + hi * 16);
                o = __builtin_amdgcn_mfma_f32_32x32x16_bf16(a, bb, o, 0, 0, 0); }
#pragma unroll
            for (int r = 0; r < 16; ++r) { const int t = 32 * ti + crow(r, hi); ((GAS bf16_t*)Od)[HG_TOK(ci, t) * 1024 + h * 128 + 32 * ei + r32] = f2bf(o[r]); }
#pragma unroll
            for (int nb = 0; nb < 2; ++nb)
#pragma unroll
                for (int kk = 0; kk < 4; ++kk) { const bf16x8 a = *(const LAS bf16x8*)((LAS unsigned char*)KTT + (32 * db + r32) * 144 + kk * 32 + hi * 16), bb = *(const LAS bf16x8*)((LAS unsigned char*)VT + (64 * eh + 32 * nb + r32) * 144 + kk * 32 + hi * 16);
                    S[nb] = __builtin_amdgcn_mfma_f32_32x32x16_bf16(a, bb, S[nb], 0, 0, 0); }
#pragma unroll
            for (int g4 = 0; g4 < 4; ++g4) { const int d0 = 32 * db + 8 * g4 + 4 * hi; const f32x4 gm4 = *(const LAS f32x4*)(GM + d0), gl4 = *(const LAS f32x4*)(GL + d0);
#pragma unroll
                for (int k = 0; k < 4; ++k) { const float sc = __expf(gl4[k] - gm4[k]); S[0][4 * g4 + k] *= sc; S[1][4 * g4 + k] *= sc; } }
            __syncthreads();
        }
#undef HG_LOAD
#undef HG_TOK
    }
}


#define XB_TMO      128
#define XB_XCNT(j)  (256  + 64 * (j))
#define XB_XSUB(j)  (1280 + 64 * (j))
#define XB_XGEN(j)  (2304 + 64 * (j))
#define XB_TOP      3328
#define XB_TOPGEN   3392
#define XCD_BAR_WORDS 3456
#define XB_SPIN_CAP (1u << 18)

__device__ __forceinline__ unsigned xb_ld(unsigned* p)              { return __hip_atomic_load(p, __ATOMIC_RELAXED, __HIP_MEMORY_SCOPE_AGENT); }
__device__ __forceinline__ unsigned xb_add(unsigned* p, unsigned v) { return __hip_atomic_fetch_add(p, v, __ATOMIC_RELAXED, __HIP_MEMORY_SCOPE_AGENT); }
__device__ __forceinline__ unsigned xb_xcc_id() { return (unsigned)__builtin_amdgcn_s_getreg((3 << 11) | 20) & 0xFu; }
#define XB_SPIN(cond, bar) do { unsigned _sp = 0; while (cond) { __builtin_amdgcn_s_sleep(1); \
    if ((++_sp & 255u) == 0u) { if (xb_ld(&(bar)[XB_TMO])) break; if (_sp > XB_SPIN_CAP) { atomicAdd(&(bar)[XB_TMO], 1u); break; } } } } while (0)

struct XcdBarrier {
    unsigned* bar; unsigned x;
    volatile LAS unsigned* st;
};

__device__ __forceinline__ XcdBarrier xcd_barrier_post(unsigned* bar, volatile LAS unsigned* st) {
    XcdBarrier b; b.bar = bar; b.x = xb_xcc_id(); b.st = st;
    if (threadIdx.x == 0) (void)xb_add(&bar[XB_XCNT(b.x)], 1u);
    return b;
}
__device__ __forceinline__ void xcd_barrier_complete(unsigned* bar, unsigned x, unsigned& nloc, unsigned& nx) {
    const unsigned G = gridDim.x * gridDim.y * gridDim.z;
    unsigned sum, cnt, mine, sp = 0u;
    for (;;) {
        sum = 0u; cnt = 0u; mine = 0u;
#pragma unroll
        for (unsigned j = 0; j < 16; ++j) { const unsigned c = xb_ld(&bar[XB_XCNT(j)]); sum += c; cnt += (c > 0u) ? 1u : 0u; mine = (j == x) ? c : mine; }
        if (sum == G) break;
        __builtin_amdgcn_s_sleep(1);
        if ((++sp & 255u) == 0u) { if (xb_ld(&bar[XB_TMO])) break; if (sp > XB_SPIN_CAP) { atomicAdd(&bar[XB_TMO], 1u); break; } }
    }
    nloc = mine > 0u ? mine : 1u; nx = cnt > 0u ? cnt : 1u;
}

__device__ __forceinline__ void xcd_barrier(const XcdBarrier& b) {
    asm volatile("s_waitcnt vmcnt(0)" ::: "memory");
    __syncthreads();
    if (threadIdx.x == 0) {
        unsigned* bar = b.bar;
        __builtin_amdgcn_s_waitcnt(0);
        unsigned nloc = b.st[0], nx = b.st[1];
        if (nloc == 0u) { xcd_barrier_complete(bar, b.x, nloc, nx); b.st[0] = nloc; b.st[1] = nx; }
        const unsigned old = xb_add(&bar[XB_XSUB(b.x)], 1u);
        const unsigned gen = old / nloc;
        if (old + 1u == (gen + 1u) * nloc) {
            __builtin_amdgcn_fence(__ATOMIC_RELEASE, "agent");
            asm volatile("s_waitcnt vmcnt(0)" ::: "memory");
            const unsigned og = xb_add(&bar[XB_TOP], 1u);
            const unsigned tg = og / nx;
            if (og + 1u == (tg + 1u) * nx) xb_add(&bar[XB_TOPGEN], 1u);
            else XB_SPIN(xb_ld(&bar[XB_TOPGEN]) == tg, bar);
            __builtin_amdgcn_fence(__ATOMIC_ACQUIRE, "agent");
            xb_add(&bar[XB_XGEN(b.x)], 1u);
            asm volatile("s_waitcnt vmcnt(0)" ::: "memory");
        } else {
            XB_SPIN(xb_ld(&bar[XB_XGEN(b.x)]) == gen, bar);
            __builtin_amdgcn_fence(__ATOMIC_ACQUIRE, "agent");
            asm volatile("s_waitcnt vmcnt(0)" ::: "memory");
        }
    }
    __syncthreads();
}

enum { K_X = 0, K_C, K_CTX, K_CCTX, K_ADAW, K_ADAB, K_NORMW, K_FNORMW, K_FFNG, K_FFNU, K_FFND, K_GQAIN, K_GQAOUT, K_GQASINK, K_DIFFIN, K_DIFFOUT, K_DIFFLAM, K_DIFFSUB,
       K_HGRNIN, K_HGRNOUT, K_HGRNNORM, K_HGRNLB, K_MLADOWN, K_MLAQN, K_MLAKVN, K_MLAUQ, K_MLAUKV, K_MLAOUT, K_OUT, K_WS };
__device__ __forceinline__ const float* karg_ptr(int idx) {
    const __attribute__((address_space(4))) unsigned long long* ka = (const __attribute__((address_space(4))) unsigned long long*)__builtin_amdgcn_kernarg_segment_ptr();
    int i = idx; asm volatile("" : "+s"(i));
    return (const float*)ka[i];
}
__device__ __forceinline__ Params load_params() {
    Params q;
    const float** qq = (const float**)&q;
#pragma unroll
    for (int i = 0; i < 30; ++i) qq[i] = karg_ptr(i);
    q.ph_lo = 0; q.ph_hi = 0;
    return q;
}
__global__ void __launch_bounds__(NTHR, 2) fwd_megakernel(Params p) {
    extern __shared__ __attribute__((aligned(16))) unsigned char lds_raw[];
    LAS unsigned char* lds = (LAS unsigned char*)lds_raw;
    cg::grid_group grid = cg::this_grid();
    const int ph_lo = p.ph_lo, ph_hi = p.ph_hi;
    volatile LAS unsigned* bst = (volatile LAS unsigned*)(lds + LDS_BYTES - 64);
    if (threadIdx.x < 2) bst[threadIdx.x] = 0u;
    __syncthreads();
    XcdBarrier bar = xcd_barrier_post((unsigned*)((unsigned char*)karg_ptr(K_WS) + WS_BAR), bst);
    int nsync = 0;
#define GRID_SYNC() do { xcd_barrier(bar); ++nsync; } while (0)
    if (ph_lo < 0) grid.sync();
    int ph = 0;
#ifndef PH_MASK
#define PH_MASK 0xffffffffu
#endif
#define COMP(k) (((PH_MASK) >> (k)) & 1u)
#ifndef DUP_MASK
#define DUP_MASK 0u
#endif
#define NREP(k) (1 + (int)(((DUP_MASK) >> (k)) & 1u))
#define PHASE_BEGIN(k) if (ph >= ph_lo && ph < ph_hi) { unsigned char* dout = (unsigned char*)karg_ptr(K_OUT); unsigned char* ws = (unsigned char*)karg_ptr(K_WS); \
        unsigned char* big = ws + WS_BIG; float* HX = (float*)(ws + WS_HX); const float* mod = (const float*)(ws + WS_MOD); bf16_t* Abuf = (bf16_t*)(dout + DO_A); \
        const float* modl = mod + (size_t)layer * 17 * NMODV; (void)big; (void)HX; (void)modl; (void)Abuf; \
        for (int rep_ = 0; rep_ < NREP(k); ++rep_) { if (rep_) GRID_SYNC();
#define PHASE_END   } if (ph + 1 < ph_hi) GRID_SYNC(); } ++ph;
    int layer = 0;
    PHASE_BEGIN(0) if (COMP(0)) { const Params q = load_params(); prologue(q, lds); } PHASE_END
#pragma unroll 1
    for (layer = 0; layer < 4; ++layer) {
        const bool with_ctx = layer < 3;
        PHASE_BEGIN(1) if (COMP(1)) { { const Params q = load_params(); convert_weights(q, layer, lds, dout); } __syncthreads(); norm_phase(HX, karg_ptr(K_NORMW) + (size_t)layer * 3 * DM, modl, 0, 1, Abuf, (layer > 0 && rep_ == 0) ? (const float*)(big + 200 * MiB) : nullptr, false, layer == 0 ? karg_ptr(K_X) : nullptr, layer == 0 ? karg_ptr(K_CTX) : nullptr); } PHASE_END
        PHASE_BEGIN(2) if (COMP(2)) { EpiSwiglu E{(bf16_t*)big}; run_gemm(lds, Abuf, (const bf16_t*)(dout + W_F1GU), 2 * FF, DM, E); } PHASE_END
        PHASE_BEGIN(3) if (COMP(3)) { EpiResid E{HX, modl, 2, rep_ + 1 < NREP(3) ? 0.f : 0.5f, (float*)(big + 200 * MiB)}; run_gemm(lds, (const bf16_t*)big, (const bf16_t*)(dout + W_F1D), DM, FF, E, true, false); } PHASE_END
        PHASE_BEGIN(1) if (COMP(1)) norm_phase(HX, karg_ptr(K_NORMW) + (size_t)layer * 3 * DM + DM, modl, 3, 4, Abuf, rep_ == 0 ? (const float*)(big + 200 * MiB) : nullptr); PHASE_END
        if (layer == 0) {
            PHASE_BEGIN(4) if (COMP(4)) { EpiGqaIn E{(bf16_t*)big, (bf16_t*)(big + U72), (bf16_t*)(big + U72 + 18 * MiB), (const float*)(ws + WS_ROPEH)}; run_gemm(lds, Abuf, (const bf16_t*)(dout + W_MIN), 1536, DM, E); } PHASE_END
            PHASE_BEGIN(5) if (COMP(5)) attn_phase<0>(big, Abuf, karg_ptr(K_GQASINK), nullptr, lds, true); PHASE_END
        } else if (layer == 1) {
            PHASE_BEGIN(6) if (COMP(6)) { EpiDiffIn E{(bf16_t*)big, (bf16_t*)(big + U72), (bf16_t*)(big + 2 * U72), (const float*)(ws + WS_ROPEH)}; run_gemm(lds, Abuf, (const bf16_t*)(dout + W_MIN), 3072, DM, E); } PHASE_END
            PHASE_BEGIN(7) if (COMP(7)) attn_phase<1>(big, Abuf, karg_ptr(K_DIFFSUB), (const float*)(ws + WS_LAM), lds, true); PHASE_END
        } else if (layer == 2) {
            PHASE_BEGIN(9) if (COMP(9)) { EpiHgrnIn E{(bf16_t*)big, (unsigned short*)(big + U72), (unsigned short*)(big + 2 * U72), (bf16_t*)(big + 3 * U72), (bf16_t*)(big + 4 * U72), (const float*)(ws + WS_LB)};
                          run_gemm(lds, Abuf, (const bf16_t*)(dout + W_MIN), 5120, DM, E); } PHASE_END
            PHASE_BEGIN(10) if (COMP(10)) hgrn_scan(big, (bf16_t*)(ws + WS_END), Abuf, lds); PHASE_END
            PHASE_BEGIN(11) if (COMP(11)) hgrn_combine((const bf16_t*)(ws + WS_END), Abuf, (const bf16_t*)(big + 4 * U72), karg_ptr(K_HGRNNORM), Abuf); PHASE_END
        } else {
            PHASE_BEGIN(12) if (COMP(12)) { EpiF32 E{(float*)big, 768}; run_gemm(lds, Abuf, (const bf16_t*)(dout + W_MIN), 768, DM, E); } PHASE_END
            PHASE_BEGIN(13) if (COMP(13)) mla_rows((const float*)big, karg_ptr(K_MLAQN), karg_ptr(K_MLAKVN), (const float*)(ws + WS_ROPEM), (bf16_t*)(big + 108 * MiB), (bf16_t*)(big + 126 * MiB), (bf16_t*)(big + 2 * U72 + 108 * MiB)); PHASE_END
            PHASE_BEGIN(14) if (COMP(14)) { EpiMlaUq E1{(bf16_t*)(big + 2 * U72), (const float*)(ws + WS_ROPEM)}; run_gemm(lds, (const bf16_t*)(big + 108 * MiB), (const bf16_t*)(dout + W_UQ), 1536, 256, E1);
                          EpiMlaUkv E2{(bf16_t*)(big + 2 * U72 + 108 * MiB), (bf16_t*)big}; run_gemm(lds, (const bf16_t*)(big + 126 * MiB), (const bf16_t*)(dout + W_UKV), 2048, 256, E2); } PHASE_END
            PHASE_BEGIN(15) if (COMP(15)) attn_phase<3>(big, Abuf, karg_ptr(K_GQASINK), nullptr, lds, false); PHASE_END
        }
        PHASE_BEGIN(3) if (COMP(3)) { EpiResid E{HX, modl, 5, rep_ + 1 < NREP(3) ? 0.f : 1.0f, (float*)(big + 200 * MiB)}; run_gemm(lds, Abuf, (const bf16_t*)(dout + W_MOUT), DM, DM, E, true, layer == 3); } PHASE_END
        PHASE_BEGIN(1) if (COMP(1)) norm_phase(HX, karg_ptr(K_NORMW) + (size_t)layer * 3 * DM + 2 * DM, modl, 6, 7, Abuf, (layer < 3 && rep_ == 0) ? (const float*)(big + 200 * MiB) : nullptr, layer == 3); PHASE_END
        PHASE_BEGIN(2) if (COMP(2)) { EpiSwiglu E{(bf16_t*)big}; run_gemm(lds, Abuf, (const bf16_t*)(dout + W_F2GU), 2 * FF, DM, E, false, layer == 3); } PHASE_END
        PHASE_BEGIN(3) if (COMP(3)) { EpiResid E{HX, modl, 8, rep_ + 1 < NREP(3) ? 0.f : 0.5f, (float*)(big + 200 * MiB)}; run_gemm(lds, (const bf16_t*)big, (const bf16_t*)(dout + W_F2D), DM, FF, E, true, layer == 3); } PHASE_END
    }
    layer = 0;
    if (NREP(17) > 1) { for (int i = 0; i < 20; ++i) GRID_SYNC(); }
    PHASE_BEGIN(16) if (COMP(16)) final_phase(HX, karg_ptr(K_FNORMW), (float*)dout); PHASE_END
#undef PHASE_BEGIN
#undef PHASE_END
}

#ifndef MK_MULTI
#define MK_MULTI 0
#endif
constexpr int N_PHASES = 1 + (10 + 10 + 11 + 12) + 1;

extern "C" void kernel_launch(void* const* d_in, const int* in_sizes, int n_in, void* d_out, int out_size, void* d_ws, size_t ws_size, hipStream_t stream) {
    static int grid = 0;
    if (grid == 0) {
        if (n_in != 28 || ws_size < WS_END + U72 || out_size != NB * SQ * DM) { fprintf(stderr, "kernel_launch: unexpected sizes n_in %d out %d ws %zu\n", n_in, out_size, ws_size); grid = -1; return; }
        int dev = 0, cus = 0, per_cu = 0;
        hipGetDevice(&dev); hipDeviceGetAttribute(&cus, hipDeviceAttributeMultiprocessorCount, dev);
        if (hipFuncSetAttribute((const void*)fwd_megakernel, hipFuncAttributeMaxDynamicSharedMemorySize, LDS_BYTES) != hipSuccess) { fprintf(stderr, "kernel_launch: hipFuncSetAttribute failed\n"); grid = -1; return; }
        if (hipOccupancyMaxActiveBlocksPerMultiprocessor(&per_cu, (const void*)fwd_megakernel, NTHR, LDS_BYTES) != hipSuccess || per_cu < 1) { fprintf(stderr, "kernel_launch: occupancy query says %d\n", per_cu); per_cu = 1; }
        (void)hipGetLastError();
        grid = cus * (per_cu > 1 ? 1 : per_cu);
        if (grid != GRID) { fprintf(stderr, "kernel_launch: this kernel is built for a %d-workgroup cooperative grid (one per CU), device offers %d\n", GRID, grid); grid = -1; return; }
    }
    if (grid < 0) return;
    if (hipMemsetAsync((char*)d_ws + WS_BAR, 0, XCD_BAR_WORDS * 4, stream) != hipSuccess) { fprintf(stderr, "kernel_launch: memset failed\n"); return; }
    Params p{};
    const float** pp = (const float**)&p;
    for (int i = 0; i < 28; ++i) pp[i] = (const float*)d_in[i];
    p.out = (float*)d_out; p.ws = (unsigned char*)d_ws;
#if MK_MULTI
    for (int ph = 0; ph < N_PHASES; ++ph) { p.ph_lo = ph; p.ph_hi = ph + 1; hipLaunchKernelGGL(fwd_megakernel, dim3(grid), dim3(NTHR), LDS_BYTES, stream, p); }
#else
    p.ph_lo = 0; p.ph_hi = N_PHASES;
    void* args[] = {&p};
    hipError_t e = hipLaunchCooperativeKernel((const void*)fwd_megakernel, dim3(grid), dim3(NTHR), args, LDS_BYTES, stream);
    if (e != hipSuccess) fprintf(stderr, "cooperative launch failed: %s (grid %d)\n", hipGetErrorString(e), grid);
#endif
}
```
